# Optimizing an MI355X kernel written in HIP

```python
import math
import jax, jax.numpy as jnp
from jax import lax
import numpy as np

D_MODEL = 1024
BATCH = 8
SEQ = 2048
DEPTH = 1

GRID_W = 64
MIX_WIDTH = D_MODEL
FOURIER_WIDTH = MIX_WIDTH // 2
N_FOURIER_GROUPS = 4
FG_DIM = FOURIER_WIDTH // N_FOURIER_GROUPS
NA_WIDTH = MIX_WIDTH - FOURIER_WIDTH
HEAD_DIM = 64
NA_HEADS = NA_WIDTH // HEAD_DIM
WIN_R_MAX = 8
WIN_C = 16
IN_COLS = FOURIER_WIDTH + 3 * NA_WIDTH
D_FF = 2816
CONV_W = 3
N_MOD = 6
EPS = 1e-6
NEG_INF = -1e30

kernel_name = "hybrid_fourier_natten_convffn_adaln"


def rms_norm(x, g):
    xf = x.astype(jnp.float32)
    y = xf * lax.rsqrt(jnp.mean(xf * xf, axis=-1, keepdims=True) + EPS)
    return (y * g.astype(jnp.float32)).astype(x.dtype)


def modulate(h, shift, scale):
    return h * (1.0 + scale[:, None, :]) + shift[:, None, :]


def fourier_mix(u, w_four):
    B, S, _ = u.shape
    ug = u.reshape(B, S, N_FOURIER_GROUPS, FG_DIM).astype(jnp.float32)
    f = jnp.fft.fft2(ug, axes=(1, 3), norm="ortho").real.astype(u.dtype)
    y = jnp.einsum("bsgc,gcd->bsgd", f, w_four)
    return y.reshape(B, S, FOURIER_WIDTH)


def neighbourhood_attention(q, k, v, rpb):
    B, S, _ = q.shape
    rows = S // GRID_W
    kr = min(WIN_R_MAX, rows)

    def to_grid(t):
        return t.reshape(B, rows, GRID_W, NA_HEADS, HEAD_DIM).transpose(0, 3, 1, 2, 4)

    qg, kg, vg = to_grid(q), to_grid(k), to_grid(v)

    r = jnp.arange(rows)
    row_start = jnp.clip(r - kr // 2, 0, rows - kr)
    row_idx = row_start[:, None] + jnp.arange(kr)
    kb = jnp.take(kg, row_idx, axis=2)
    vb = jnp.take(vg, row_idx, axis=2)

    cols = jnp.arange(GRID_W)
    col_start = jnp.clip(cols - WIN_C // 2, 0, GRID_W - WIN_C)
    valid = (cols[None, :] >= col_start[:, None]) & (cols[None, :] < col_start[:, None] + WIN_C)

    dr = row_idx - r[:, None]
    dc = jnp.clip(cols[None, :] - cols[:, None], -(WIN_C - 1), WIN_C - 1)
    bias = rpb.astype(jnp.float32)[:, dr + (WIN_R_MAX - 1)]
    bias = bias[..., dc + (WIN_C - 1)]
    bias = jnp.where(valid, bias, NEG_INF).transpose(0, 1, 3, 2, 4)

    scale = 1.0 / math.sqrt(HEAD_DIM)
    s = jnp.einsum("bhrqd,bhrikd->bhrqik", qg, kb).astype(jnp.float32) * scale + bias[None]
    p = jax.nn.softmax(s.reshape(s.shape[:4] + (kr * GRID_W,)), axis=-1)
    p = p.reshape(s.shape).astype(v.dtype)
    o = jnp.einsum("bhrqik,bhrikd->bhrqd", p, vb)
    return o.transpose(0, 2, 3, 1, 4).reshape(B, S, NA_WIDTH)


def dwconv_centred(u, w, b):
    up = jnp.pad(u, ((0, 0), (1, 1), (0, 0)))
    return up[:, :-2] * w[0] + up[:, 1:-1] * w[1] + up[:, 2:] * w[2] + b


def setup_inputs(seed: int = 0) -> dict:
    key = jax.random.key(seed)
    ks = jax.random.split(key, 20)
    L, D = DEPTH, D_MODEL
    nrm = jax.random.normal
    return {
        "x": nrm(ks[0], (BATCH, SEQ, D), jnp.float32),
        "c": nrm(ks[1], (BATCH, D), jnp.float32),
        "w_ada": nrm(ks[2], (L, D, N_MOD * D), jnp.float32) * (0.5 * D ** -0.5),
        "b_ada": nrm(ks[3], (L, N_MOD * D), jnp.float32) * 0.02,
        "g_mix": 1.0 + 0.02 * nrm(ks[4], (L, D), jnp.float32),
        "w_in": nrm(ks[5], (L, D, IN_COLS), jnp.float32) * D ** -0.5,
        "w_four": nrm(ks[6], (L, N_FOURIER_GROUPS, FG_DIM, FG_DIM), jnp.float32) * FG_DIM ** -0.5,
        "rpb": nrm(ks[7], (L, NA_HEADS, 2 * WIN_R_MAX - 1, 2 * WIN_C - 1), jnp.float32) * 0.1,
        "g_four_out": 1.0 + 0.02 * nrm(ks[8], (L, FOURIER_WIDTH), jnp.float32),
        "g_na_out": 1.0 + 0.02 * nrm(ks[9], (L, NA_WIDTH), jnp.float32),
        "w_out": nrm(ks[10], (L, MIX_WIDTH, D), jnp.float32) * MIX_WIDTH ** -0.5,
        "g_ffn": 1.0 + 0.02 * nrm(ks[11], (L, D), jnp.float32),
        "w_up": nrm(ks[12], (L, D, 2 * D_FF), jnp.float32) * D ** -0.5,
        "conv_w": nrm(ks[13], (L, CONV_W, 2 * D_FF), jnp.float32) * CONV_W ** -0.5,
        "conv_b": nrm(ks[14], (L, 2 * D_FF), jnp.float32) * 0.02,
        "w_down": nrm(ks[15], (L, D_FF, D), jnp.float32) * D_FF ** -0.5,
        "g_final": 1.0 + 0.02 * nrm(ks[16], (D,), jnp.float32),
    }


def reference(x, c, w_ada, b_ada, g_mix, w_in, w_four, rpb, g_four_out, g_na_out, w_out,
              g_ffn, w_up, conv_w, conv_b, w_down, g_final):
    D = D_MODEL
    cs = jax.nn.silu(c)
    for l in range(DEPTH):
        mod = cs @ w_ada[l] + b_ada[l]
        sh1, sc1, gt1, sh2, sc2, gt2 = [mod[:, i * D:(i + 1) * D] for i in range(N_MOD)]

        h = modulate(rms_norm(x, g_mix[l]), sh1, sc1)
        proj = h @ w_in[l]
        u_f = proj[..., :FOURIER_WIDTH]
        q = proj[..., FOURIER_WIDTH:FOURIER_WIDTH + NA_WIDTH]
        k = proj[..., FOURIER_WIDTH + NA_WIDTH:FOURIER_WIDTH + 2 * NA_WIDTH]
        v = proj[..., FOURIER_WIDTH + 2 * NA_WIDTH:]
        y_f = rms_norm(fourier_mix(u_f, w_four[l]), g_four_out[l])
        y_na = rms_norm(neighbourhood_attention(q, k, v, rpb[l]), g_na_out[l])
        y = jnp.concatenate([y_f, y_na], axis=-1) @ w_out[l]
        x = x + gt1[:, None, :] * y

        h2 = modulate(rms_norm(x, g_ffn[l]), sh2, sc2)
        up = dwconv_centred(h2 @ w_up[l], conv_w[l], conv_b[l])
        a = jax.nn.silu(up[..., :D_FF]) * up[..., D_FF:]
        x = x + gt2[:, None, :] * (a @ w_down[l])
    return rms_norm(x, g_final)
```

```cpp
#include <hip/hip_runtime.h>
#include <hip/hip_cooperative_groups.h>
#include <cstdio>
namespace cg = cooperative_groups;

#ifndef REPEAT_MASK
#define REPEAT_MASK 0
#endif
#ifndef MK_PER_PHASE
#define MK_PER_PHASE 0
#endif

#define LAS __attribute__((address_space(3)))
typedef unsigned short bf16_t;
typedef short bf16x8 __attribute__((ext_vector_type(8)));
typedef float f32x4 __attribute__((ext_vector_type(4)));
typedef float f32x2 __attribute__((ext_vector_type(2)));
typedef unsigned u32x4 __attribute__((ext_vector_type(4)));
typedef unsigned u32x2 __attribute__((ext_vector_type(2)));

constexpr int DM = 1024, NBATCH = 8, SEQ = 2048, NTOK = NBATCH * SEQ, DFF = 2816, NMOD = 6 * DM;
constexpr float EPS = 1e-6f;
constexpr int NTHREADS = 512, NWAVES = 8;
constexpr int LDS_STAGE = 131072, LDS_EXTRA = 20480, LDS_BYTES = LDS_STAGE + LDS_EXTRA;

constexpr size_t MiB = 1u << 20;
constexpr size_t WS_MOD = 0;
constexpr size_t WS_BAR = 512 * 1024;
constexpr size_t WS_SSQ1 = 1 * MiB;
constexpr size_t WS_SSQ2 = 2 * MiB;
constexpr size_t WS_WQK = 3 * MiB;
constexpr size_t WS_WA = 5 * MiB;
constexpr size_t WS_WOUT = 8 * MiB;
constexpr size_t WS_WUP = 10 * MiB;
constexpr size_t WS_WDN = 21 * MiB;
constexpr size_t WS_CS = 27 * MiB;
constexpr size_t WS_H = 43 * MiB;
constexpr size_t WS_VT = 75 * MiB;
constexpr size_t WS_QK = 107 * MiB;
constexpr size_t WS_VTA = 139 * MiB;
constexpr size_t WS_PQ = 155 * MiB;
constexpr size_t WS_YCAT = 187 * MiB;
constexpr size_t WS_A = 75 * MiB;
constexpr size_t WS_SIDE = 163 * MiB;
constexpr size_t WS_HE = 220 * MiB;
constexpr size_t WS_HO = 236 * MiB;
constexpr size_t WS_END = 252 * MiB;

struct Params {
    const float *x, *c, *w_ada, *b_ada, *g_mix, *w_in, *w_four, *rpb, *g_four_out, *g_na_out, *w_out, *g_ffn, *w_up, *conv_w, *conv_b, *w_down, *g_final;
    float* out; unsigned char* ws;
    int ph_lo, ph_hi;
};

__device__ __forceinline__ unsigned cvt_pk_bf16(float lo, float hi) { unsigned r; asm volatile("v_cvt_pk_bf16_f32 %0, %1, %2" : "=v"(r) : "v"(lo), "v"(hi)); return r; }
__device__ __forceinline__ float bf_lo(unsigned w) { return __uint_as_float(w << 16); }
__device__ __forceinline__ float bf_hi(unsigned w) { return __uint_as_float(w & 0xffff0000u); }
__device__ __forceinline__ float wave_sum(float v) {
#pragma unroll
    for (int o = 1; o < 64; o <<= 1) v += __shfl_xor(v, o);
    return v;
}
__device__ __forceinline__ float silu_f(float v) { return v * __builtin_amdgcn_rcpf(1.0f + __expf(-v)); }
template <int CTRL> __device__ __forceinline__ float dpp_f(float v) {
    return __builtin_bit_cast(float, __builtin_amdgcn_mov_dpp(__builtin_bit_cast(int, v), CTRL, 0xF, 0xF, true));
}

#define XB_TMO      128
#define XB_XCNT(j)  (256  + 64 * (j))
#define XB_XSUB(j)  (1280 + 64 * (j))
#define XB_XGEN(j)  (2304 + 64 * (j))
#define XB_TOP      3328
#define XB_TOPGEN   3392
#define XCD_BAR_WORDS 3456
#define XB_SPIN_CAP (1u << 20)
__device__ __forceinline__ unsigned xb_ld(unsigned* p)              { return __hip_atomic_load(p, __ATOMIC_RELAXED, __HIP_MEMORY_SCOPE_AGENT); }
__device__ __forceinline__ unsigned xb_add(unsigned* p, unsigned v) { return __hip_atomic_fetch_add(p, v, __ATOMIC_RELAXED, __HIP_MEMORY_SCOPE_AGENT); }
__device__ __forceinline__ unsigned xb_xcc_id() { return (unsigned)__builtin_amdgcn_s_getreg((3 << 11) | 20) & 0xFu; }
#define XB_SPIN(cond, bar) do { unsigned _sp = 0; while (cond) { __builtin_amdgcn_s_sleep(1); \
    if ((++_sp & 255u) == 0u) { if (xb_ld(&(bar)[XB_TMO])) break; if (_sp > XB_SPIN_CAP) { atomicAdd(&(bar)[XB_TMO], 1u); break; } } } } while (0)
struct XcdBarrier { unsigned* bar; unsigned x; volatile LAS unsigned* st; };
__device__ __forceinline__ XcdBarrier xcd_barrier_post(unsigned* bar, volatile LAS unsigned* st) {
    XcdBarrier b; b.bar = bar; b.x = xb_xcc_id(); b.st = st;
    if (threadIdx.x == 0) (void)xb_add(&bar[XB_XCNT(b.x)], 1u);
    return b;
}
__device__ __forceinline__ void xcd_barrier_complete(unsigned* bar, unsigned x, unsigned& nloc, unsigned& nx) {
    const unsigned G = gridDim.x * gridDim.y * gridDim.z;
    unsigned sum, cnt, mine, sp = 0u;
    for (;;) {
        sum = 0u; cnt = 0u; mine = 0u;
#pragma unroll
        for (unsigned j = 0; j < 16; ++j) { const unsigned c = xb_ld(&bar[XB_XCNT(j)]); sum += c; cnt += (c > 0u) ? 1u : 0u; mine = (j == x) ? c : mine; }
        if (sum == G) break;
        __builtin_amdgcn_s_sleep(1);
        if ((++sp & 255u) == 0u) { if (xb_ld(&bar[XB_TMO])) break; if (sp > XB_SPIN_CAP) { atomicAdd(&bar[XB_TMO], 1u); break; } }
    }
    nloc = mine > 0u ? mine : 1u; nx = cnt > 0u ? cnt : 1u;
}
__device__ __forceinline__ void xcd_barrier(const XcdBarrier& b) {
    asm volatile("s_waitcnt vmcnt(0)" ::: "memory");
    __syncthreads();
    if (threadIdx.x == 0) {
        unsigned* bar = b.bar;
        __builtin_amdgcn_s_waitcnt(0);
        unsigned nloc = b.st[0], nx = b.st[1];
        if (nloc == 0u) { xcd_barrier_complete(bar, b.x, nloc, nx); b.st[0] = nloc; b.st[1] = nx; }
        const unsigned old = xb_add(&bar[XB_XSUB(b.x)], 1u);
        const unsigned gen = old / nloc;
        if (old + 1u == (gen + 1u) * nloc) {
            __builtin_amdgcn_fence(__ATOMIC_RELEASE, "agent");
            asm volatile("s_waitcnt vmcnt(0)" ::: "memory");
            const unsigned og = xb_add(&bar[XB_TOP], 1u);
            const unsigned tg = og / nx;
            if (og + 1u == (tg + 1u) * nx) xb_add(&bar[XB_TOPGEN], 1u);
            else XB_SPIN(xb_ld(&bar[XB_TOPGEN]) == tg, bar);
            __builtin_amdgcn_fence(__ATOMIC_ACQUIRE, "agent");
            xb_add(&bar[XB_XGEN(b.x)], 1u);
            asm volatile("s_waitcnt vmcnt(0)" ::: "memory");
        } else {
            XB_SPIN(xb_ld(&bar[XB_XGEN(b.x)]) == gen, bar);
            __builtin_amdgcn_fence(__ATOMIC_ACQUIRE, "agent");
            asm volatile("s_waitcnt vmcnt(0)" ::: "memory");
        }
    }
    __syncthreads();
}

namespace pg8 {
constexpr int BM = 256, BK = 64, HALF = 128, HTB = HALF * BK * 2, NXCD = 8, WGM = 8;
__device__ __forceinline__ int lds_byte(int r, int c) { const int st = (r >> 4) * 2 + (c >> 5), rr = r & 15, cc = c & 31, ob = rr * 64 + cc * 2; return st * 1024 + (ob ^ (((ob >> 9) & 1) << 5)); }
__device__ __forceinline__ void stage_rc(int b, int& R, int& C) { const int st = b / 1024, sb = b % 1024, swz = sb ^ (((sb >> 9) & 1) << 5); R = (st >> 1) * 16 + swz / 64; C = (st & 1) * 32 + (swz % 64) / 2; }
__device__ __forceinline__ int perm32(int rho) { const int n = rho >> 4, i = rho & 15; return 8 * (i >> 2) + 4 * n + (i & 3); }

struct Unit { const char* pa; const char* pb; char* po; float* sp; int rp, RS, CS; int pm, pn; };

__device__ __forceinline__ void tile_map(int wgid, int nM, int nN, int& pm, int& pn) {
    const int nwg = nM * nN;
    { const int q = nwg / NXCD, r = nwg % NXCD, xcd = wgid % NXCD, off = wgid / NXCD; wgid = (xcd < r ? xcd * (q + 1) : r * (q + 1) + (xcd - r) * q) + off; }
    const int nig = WGM * nN, gid = wgid / nig, fm = gid * WGM, gsz = (nM - fm) < WGM ? (nM - fm) : WGM;
    pm = fm + ((wgid % nig) % gsz); pn = (wgid % nig) / gsz;
}

template <class Epi, class Sched>
__device__ __forceinline__ void gemm_phase(LAS unsigned char* lds, const int K, const Sched& S, const Epi& E) {
    const int tid = threadIdx.x, wid = __builtin_amdgcn_readfirstlane(tid >> 6), lane = tid & 63, wr = wid >> 2, wc = wid & 3, fr = lane & 15, fq = lane >> 4;
    const int nt = K / BK;
    unsigned voffA[2], voffB[2];
#pragma unroll
    for (int i = 0; i < 2; ++i) { int R, C; stage_rc(tid * 16 + i * 8192, R, C); const int Rb = Epi::PERM ? ((R & ~31) + perm32(R & 31)) : R;
        voffA[i] = (unsigned)(R * K + C) * 2u; voffB[i] = (unsigned)(Rb * K + C) * 2u; }
    const size_t kstep = (size_t)(BK * 2);
    const size_t hstep = (size_t)HALF * K * 2;
    const unsigned ldsw = (unsigned)wid * 1024u;
    const int aoff = lds_byte(wr * 64 + fr, fq * 8), boff = lds_byte(wc * 32 + fr, fq * 8);
#define PG8_SA(b, h) (((b) * 2 + (h)) * HTB)
#define PG8_SB(b, h) ((4 + (b) * 2 + (h)) * HTB)
#define PG8_STAGE(bufoff, gbase, voff) do { _Pragma("unroll") for (int _i = 0; _i < 2; ++_i) \
        __builtin_amdgcn_global_load_lds((const unsigned*)((const char*)(gbase) + (voff)[_i]), (LAS unsigned*)(lds + (bufoff) + ldsw + _i * 8192), 16, 0, 0); } while (0)
#define PG8_LDA(dst, b, h) do { _Pragma("unroll") for (int m = 0; m < 4; ++m) _Pragma("unroll") for (int k = 0; k < 2; ++k) dst[m][k] = *(const LAS bf16x8*)(lds + PG8_SA(b, h) + aoff + m * 2048 + k * 1024); } while (0)
#define PG8_LDB(dst, b, h) do { _Pragma("unroll") for (int n = 0; n < 2; ++n) _Pragma("unroll") for (int k = 0; k < 2; ++k) dst[n][k] = *(const LAS bf16x8*)(lds + PG8_SB(b, h) + boff + n * 2048 + k * 1024); } while (0)
#define PG8_MMA(ai, bj, At, Bt) do { __builtin_amdgcn_s_setprio(1); _Pragma("unroll") for (int m = 0; m < 4; ++m) _Pragma("unroll") for (int n = 0; n < 2; ++n) _Pragma("unroll") for (int k = 0; k < 2; ++k) \
        acc[ai][bj][m][n] = __builtin_amdgcn_mfma_f32_16x16x32_bf16(Bt[n][k], At[m][k], acc[ai][bj][m][n], 0, 0, 0); __builtin_amdgcn_s_setprio(0); } while (0)
#define PG8_WAIT_V(n) asm volatile("s_waitcnt vmcnt(" #n ")" ::: "memory")
#define PG8_WAIT_L(n) asm volatile("s_waitcnt lgkmcnt(" #n ")" ::: "memory")
#define PG8_BAR __builtin_amdgcn_s_barrier()
#define PG8_SCHED __builtin_amdgcn_sched_barrier(0)
    Unit cur, nxt; int ui = 0;
    if (!S.next(0, cur)) return;
    f32x4 acc[2][2][4][2];
#pragma unroll
    for (int a = 0; a < 2; ++a)
#pragma unroll
        for (int b = 0; b < 2; ++b)
#pragma unroll
            for (int m = 0; m < 4; ++m)
#pragma unroll
                for (int n = 0; n < 2; ++n) acc[a][b][m][n] = (f32x4){0.f, 0.f, 0.f, 0.f};
    bf16x8 At[4][2], B0[2][2], B1[2][2];
    const char* cA = cur.pa; const char* cB = cur.pb;
    PG8_STAGE(PG8_SB(0, 0), cB, voffB); PG8_STAGE(PG8_SA(0, 0), cA, voffA); PG8_STAGE(PG8_SB(0, 1), cB + hstep, voffB); PG8_STAGE(PG8_SA(0, 1), cA + hstep, voffA);
    if (wr == 1) PG8_BAR;
    PG8_WAIT_V(4); PG8_BAR;
    PG8_STAGE(PG8_SB(1, 0), cB + kstep, voffB); PG8_STAGE(PG8_SA(1, 0), cA + kstep, voffA); PG8_STAGE(PG8_SB(1, 1), cB + hstep + kstep, voffB);
    PG8_WAIT_V(6); PG8_BAR;
    for (;;) {
        const bool has_next = S.next(ui + 1, nxt);
        const char* nA = has_next ? nxt.pa : cA; const char* nB = has_next ? nxt.pb : cB;
        for (int t = 0; t < nt; t += 2) {
            const bool last = (t == nt - 2);
            const char* a1 = cA + (size_t)(t + 1) * kstep;
            const char* a2 = last ? nA : cA + (size_t)(t + 2) * kstep; const char* b2 = last ? nB : cB + (size_t)(t + 2) * kstep;
            const char* a3 = a2 + kstep; const char* b3 = b2 + kstep;
            PG8_LDB(B0, 0, 0); PG8_SCHED; PG8_LDA(At, 0, 0); PG8_STAGE(PG8_SA(1, 1), a1 + hstep, voffA);
            PG8_WAIT_L(8); PG8_BAR; PG8_WAIT_L(0); PG8_MMA(0, 0, At, B0); PG8_BAR; PG8_SCHED;
            PG8_LDB(B1, 0, 1); PG8_STAGE(PG8_SB(0, 0), b2, voffB);
            PG8_BAR; PG8_WAIT_L(0); PG8_MMA(0, 1, At, B1); PG8_BAR;
            PG8_LDA(At, 0, 1); PG8_STAGE(PG8_SA(0, 0), a2, voffA);
            PG8_BAR; PG8_WAIT_L(0); PG8_MMA(1, 0, At, B0); PG8_BAR; PG8_SCHED;
            PG8_STAGE(PG8_SB(0, 1), b2 + hstep, voffB);
            PG8_WAIT_V(6); PG8_BAR; PG8_MMA(1, 1, At, B1); PG8_BAR;
            PG8_LDB(B0, 1, 0); PG8_SCHED; PG8_LDA(At, 1, 0); PG8_STAGE(PG8_SA(0, 1), a2 + hstep, voffA);
            PG8_WAIT_L(8); PG8_BAR; PG8_WAIT_L(0); PG8_MMA(0, 0, At, B0); PG8_BAR; PG8_SCHED;
            PG8_LDB(B1, 1, 1); PG8_STAGE(PG8_SB(1, 0), b3, voffB);
            PG8_BAR; PG8_WAIT_L(0); PG8_MMA(0, 1, At, B1); PG8_BAR;
            PG8_LDA(At, 1, 1); PG8_STAGE(PG8_SA(1, 0), a3, voffA);
            PG8_BAR; PG8_WAIT_L(0); PG8_MMA(1, 0, At, B0); PG8_BAR; PG8_SCHED;
            PG8_STAGE(PG8_SB(1, 1), b3 + hstep, voffB);
            PG8_WAIT_V(6); PG8_BAR; PG8_MMA(1, 1, At, B1); PG8_BAR;
        }
        if constexpr (!Epi::AFTER_DRAIN) E(acc, cur, wr, wc, fr, fq);
        if (!has_next) break;
#pragma unroll
        for (int a = 0; a < 2; ++a)
#pragma unroll
            for (int b = 0; b < 2; ++b)
#pragma unroll
                for (int m = 0; m < 4; ++m)
#pragma unroll
                    for (int n = 0; n < 2; ++n) acc[a][b][m][n] = (f32x4){0.f, 0.f, 0.f, 0.f};
        cur = nxt; cA = nA; cB = nB; ++ui;
    }
    PG8_WAIT_V(0);
    if (wr == 0) PG8_BAR;
    PG8_BAR;
    if constexpr (Epi::AFTER_DRAIN) E.fused(acc, cur, wr, wc, fr, fq, lds, wid, lane);
#undef PG8_SA
#undef PG8_SB
#undef PG8_STAGE
#undef PG8_LDA
#undef PG8_LDB
#undef PG8_MMA
#undef PG8_WAIT_V
#undef PG8_WAIT_L
#undef PG8_BAR
#undef PG8_SCHED
}

struct EpiTileBf16 {
    static constexpr bool PERM = true, AFTER_DRAIN = false;
    __device__ __forceinline__ void operator()(const f32x4 (&acc)[2][2][4][2], const Unit& u, int wr, int wc, int fr, int fq) const {
        bf16_t* base = (bf16_t*)u.po + (size_t)wr * u.RS + (size_t)fr * u.rp + (size_t)(wc >> 1) * u.CS + (wc & 1) * 32 + 8 * fq;
#pragma unroll
        for (int ai = 0; ai < 2; ++ai)
#pragma unroll
            for (int m = 0; m < 4; ++m) { bf16_t* rowp = base + (size_t)(2 * ai) * u.RS + (size_t)(m * 16) * u.rp;
#pragma unroll
                for (int bj = 0; bj < 2; ++bj) { const f32x4 v0 = acc[ai][bj][m][0], v1 = acc[ai][bj][m][1];
                    u32x4 w; w.x = cvt_pk_bf16(v0[0], v0[1]); w.y = cvt_pk_bf16(v0[2], v0[3]); w.z = cvt_pk_bf16(v1[0], v1[1]); w.w = cvt_pk_bf16(v1[2], v1[3]);
                    *(u32x4*)(rowp + (size_t)(2 * bj) * u.CS) = w; } }
        if (u.sp) {
#pragma unroll
            for (int ai = 0; ai < 2; ++ai)
#pragma unroll
                for (int m = 0; m < 4; ++m) { float s = 0.f;
#pragma unroll
                    for (int bj = 0; bj < 2; ++bj)
#pragma unroll
                        for (int n = 0; n < 2; ++n) { const f32x4 v = acc[ai][bj][m][n]; s += (v[0] - v[1]) + (v[2] - v[3]); }
                    s += __shfl_xor(s, 16); s += __shfl_xor(s, 32);
                    if (fq == 0) u.sp[(size_t)(ai * HALF + wr * 64 + m * 16 + fr) * 32 + wc] = s; }
        }
    }
};
struct EpiResid {
    static constexpr bool PERM = false, AFTER_DRAIN = false;
    const float* base; float* out; const float* gate; float* ssq;
    __device__ __forceinline__ void operator()(const f32x4 (&acc)[2][2][4][2], const Unit& u, int wr, int wc, int fr, int fq) const {
        const int row0 = u.pm * BM + wr * 64 + fr, col0 = u.pn * BM + wc * 32 + 4 * fq, b = u.pm >> 3;
        f32x4 gv[2][2];
#pragma unroll
        for (int bj = 0; bj < 2; ++bj)
#pragma unroll
            for (int n = 0; n < 2; ++n) gv[bj][n] = *(const f32x4*)(gate + (size_t)b * NMOD + col0 + bj * HALF + n * 16);
#pragma unroll
        for (int ai = 0; ai < 2; ++ai)
#pragma unroll
            for (int m = 0; m < 4; ++m) { const int row = row0 + ai * HALF + m * 16; const size_t off = (size_t)row * DM + col0; float s = 0.f;
#pragma unroll
                for (int bj = 0; bj < 2; ++bj)
#pragma unroll
                    for (int n = 0; n < 2; ++n) { const f32x4 xv = *(const f32x4*)(base + off + bj * HALF + n * 16); const f32x4 o = xv + gv[bj][n] * acc[ai][bj][m][n];
                        *(f32x4*)(out + off + bj * HALF + n * 16) = o; s += (o[0] * o[0] + o[1] * o[1]) + (o[2] * o[2] + o[3] * o[3]); }
                s += __shfl_xor(s, 16); s += __shfl_xor(s, 32);
                if (fq == 0) ssq[(size_t)row * 16 + u.pn * 4 + wc] = s; }
    }
};
struct EpiUp {
    static constexpr bool PERM = true, AFTER_DRAIN = false;
    bf16_t* A; bf16_t* side; const float* cw; const float* cb;
    __device__ __forceinline__ void operator()(f32x4 (&acc)[2][2][4][2], const Unit& u, int wr, int wc, int fr, int fq) const {
        const int J0 = u.pn * 128 + wc * 32 + fq * 8;
        if (fr < 2 || fr >= 14) {
            const int slot = fr < 2 ? fr : fr - 12;
#pragma unroll
            for (int ai = 0; ai < 2; ++ai) { const int chunk = u.pm * 4 + ai * 2 + wr;
#pragma unroll
                for (int bj = 0; bj < 2; ++bj) { const f32x4 a0 = fr < 2 ? acc[ai][bj][0][0] : acc[ai][bj][3][0], a1 = fr < 2 ? acc[ai][bj][0][1] : acc[ai][bj][3][1];
                    u32x4 w; w.x = cvt_pk_bf16(a0[0], a0[1]); w.y = cvt_pk_bf16(a0[2], a0[3]); w.z = cvt_pk_bf16(a1[0], a1[1]); w.w = cvt_pk_bf16(a1[2], a1[3]);
                    *(u32x4*)(side + (size_t)(chunk * 4 + slot) * (2 * DFF) + bj * DFF + J0) = w; } }
        }
        const bool f0 = (fr == 0), f15 = (fr == 15);
#pragma unroll
        for (int bj = 0; bj < 2; ++bj)
#pragma unroll
            for (int n = 0; n < 2; ++n) {
                const int col = bj * DFF + J0 + n * 4;
                const f32x4 k0 = *(const f32x4*)(cw + col), k1 = *(const f32x4*)(cw + 2 * DFF + col), k2 = *(const f32x4*)(cw + 4 * DFF + col), kb = *(const f32x4*)(cb + col);
#pragma unroll
                for (int ai = 0; ai < 2; ++ai) {
                    const f32x4 c0 = acc[ai][bj][0][n], c1 = acc[ai][bj][1][n], c2 = acc[ai][bj][2][n], c3 = acc[ai][bj][3][n];
                    f32x4 o0, o1, o2, o3;
#pragma unroll
                    for (int j = 0; j < 4; ++j) {
                        const float r0 = dpp_f<0x121>(c0[j]), r1 = dpp_f<0x121>(c1[j]), r2 = dpp_f<0x121>(c2[j]), r3 = dpp_f<0x121>(c3[j]);
                        const float l0 = dpp_f<0x12F>(c0[j]), l1 = dpp_f<0x12F>(c1[j]), l2 = dpp_f<0x12F>(c2[j]), l3 = dpp_f<0x12F>(c3[j]);
                        o0[j] = k0[j] * r0 + k1[j] * c0[j] + k2[j] * (f15 ? l1 : l0) + kb[j];
                        o1[j] = k0[j] * (f0 ? r0 : r1) + k1[j] * c1[j] + k2[j] * (f15 ? l2 : l1) + kb[j];
                        o2[j] = k0[j] * (f0 ? r1 : r2) + k1[j] * c2[j] + k2[j] * (f15 ? l3 : l2) + kb[j];
                        o3[j] = k0[j] * (f0 ? r2 : r3) + k1[j] * c3[j] + k2[j] * l3 + kb[j];
                    }
                    asm volatile("" : "+v"(o0), "+v"(o1), "+v"(o2), "+v"(o3));
                    acc[ai][bj][0][n] = o0; acc[ai][bj][1][n] = o1; acc[ai][bj][2][n] = o2; acc[ai][bj][3][n] = o3;
                }
            }
#pragma unroll
        for (int ai = 0; ai < 2; ++ai) { const int chunk = u.pm * 4 + ai * 2 + wr;
#pragma unroll
            for (int m = 0; m < 4; ++m) {
                const f32x4 g0 = acc[ai][0][m][0], g1 = acc[ai][0][m][1], v0 = acc[ai][1][m][0], v1 = acc[ai][1][m][1];
                u32x4 w; w.x = cvt_pk_bf16(silu_f(g0[0]) * v0[0], silu_f(g0[1]) * v0[1]); w.y = cvt_pk_bf16(silu_f(g0[2]) * v0[2], silu_f(g0[3]) * v0[3]);
                w.z = cvt_pk_bf16(silu_f(g1[0]) * v1[0], silu_f(g1[1]) * v1[1]); w.w = cvt_pk_bf16(silu_f(g1[2]) * v1[2], silu_f(g1[3]) * v1[3]);
                const bool valid = !((m == 0 && f0) || (m == 3 && f15));
                if (valid) *(u32x4*)(A + (size_t)(chunk * 64 + m * 16 + fr) * DFF + J0) = w;
            } }
    }
};
struct PanelSsq {
    float* xbuf; unsigned* cnt;
    __device__ __forceinline__ void run(const f32x4 (&v)[2][2][4][2], const Unit& u, int wr, int wc, int fr, int fq, LAS unsigned char* lds, int wid, int lane) const {
        LAS float* P = (LAS float*)lds; LAS float* S = (LAS float*)(lds + 4096);
#pragma unroll
        for (int ai = 0; ai < 2; ++ai)
#pragma unroll
            for (int m = 0; m < 4; ++m) { float s = 0.f;
#pragma unroll
                for (int bj = 0; bj < 2; ++bj)
#pragma unroll
                    for (int n = 0; n < 2; ++n) { const f32x4 x = v[ai][bj][m][n]; s += (x[0] * x[0] + x[1] * x[1]) + (x[2] * x[2] + x[3] * x[3]); }
                s += __shfl_xor(s, 16); s += __shfl_xor(s, 32);
                if (fq == 0) P[(ai * HALF + wr * 64 + m * 16 + fr) * 4 + wc] = s; }
        asm volatile("s_waitcnt lgkmcnt(0)" ::: "memory"); __builtin_amdgcn_s_barrier(); asm volatile("" ::: "memory");
        const int row = wid * 32 + (lane & 31);
        if (lane < 32) { const f32x4 a = *(const LAS f32x4*)(P + row * 4);
            __hip_atomic_store(xbuf + ((size_t)(u.pm * BM + row) * 4 + u.pn), (a[0] + a[1]) + (a[2] + a[3]), __ATOMIC_RELAXED, __HIP_MEMORY_SCOPE_AGENT); }
        asm volatile("s_waitcnt vmcnt(0)" ::: "memory");
        if (lane == 0) __hip_atomic_fetch_add(cnt + 64 * u.pm, 1u, __ATOMIC_RELAXED, __HIP_MEMORY_SCOPE_AGENT);
        if (wid == 0) { unsigned sp = 0;
            while ((unsigned)__builtin_amdgcn_readfirstlane(__hip_atomic_load(cnt + 64 * u.pm, __ATOMIC_RELAXED, __HIP_MEMORY_SCOPE_AGENT)) < 32u) { __builtin_amdgcn_s_sleep(2); if (++sp > (1u << 22)) break; }
            __builtin_amdgcn_fence(__ATOMIC_ACQUIRE, "agent"); }
        asm volatile("s_waitcnt vmcnt(0) lgkmcnt(0)" ::: "memory"); __builtin_amdgcn_s_barrier(); asm volatile("" ::: "memory");
        if (lane < 32) { const float* slot = xbuf + (size_t)(u.pm * BM + row) * 4; float t = 0.f;
#pragma unroll
            for (int k = 0; k < 4; ++k) t += __hip_atomic_load(slot + k, __ATOMIC_RELAXED, __HIP_MEMORY_SCOPE_AGENT);
            S[row] = 1.0f / sqrtf(t * (1.0f / DM) + EPS); }
        asm volatile("s_waitcnt lgkmcnt(0)" ::: "memory"); __builtin_amdgcn_s_barrier(); asm volatile("" ::: "memory");
    }
};
struct EpiResidNormMod {
    static constexpr bool PERM = false, AFTER_DRAIN = true;
    const float* base; float* out; const float* mod; int gate_off, sh_off, sc_off; const float* g; bf16_t* hn; PanelSsq st;
    __device__ __forceinline__ void fused(f32x4 (&acc)[2][2][4][2], const Unit& u, int wr, int wc, int fr, int fq, LAS unsigned char* lds, int wid, int lane) const {
        const int row0 = u.pm * BM + wr * 64 + fr, col0 = u.pn * BM + wc * 32 + 4 * fq, b = u.pm >> 3;
        const float* modb = mod + (size_t)b * NMOD + col0;
        { f32x4 gv[2][2];
#pragma unroll
          for (int bj = 0; bj < 2; ++bj)
#pragma unroll
            for (int n = 0; n < 2; ++n) gv[bj][n] = *(const f32x4*)(modb + gate_off + bj * HALF + n * 16);
#pragma unroll
          for (int ai = 0; ai < 2; ++ai)
#pragma unroll
            for (int m = 0; m < 4; ++m) { const size_t off = (size_t)(row0 + ai * HALF + m * 16) * DM + col0;
#pragma unroll
                for (int bj = 0; bj < 2; ++bj)
#pragma unroll
                    for (int n = 0; n < 2; ++n) { const f32x4 xv = *(const f32x4*)(base + off + bj * HALF + n * 16); const f32x4 o = xv + gv[bj][n] * acc[ai][bj][m][n];
                        *(f32x4*)(out + off + bj * HALF + n * 16) = o; acc[ai][bj][m][n] = o; }
                asm volatile("" ::: "memory"); } }
        st.run(acc, u, wr, wc, fr, fq, lds, wid, lane);
        const LAS float* S = (const LAS float*)(lds + 4096);
#pragma unroll
        for (int bj = 0; bj < 2; ++bj)
#pragma unroll
            for (int n = 0; n < 2; ++n) { const int co = bj * HALF + n * 16;
                const f32x4 gg = *(const f32x4*)(g + col0 + co), sh = *(const f32x4*)(modb + sh_off + co), sc = *(const f32x4*)(modb + sc_off + co);
                const f32x4 mul = gg * (1.0f + sc);
#pragma unroll
                for (int ai = 0; ai < 2; ++ai)
#pragma unroll
                    for (int m = 0; m < 4; ++m) { const int r = ai * HALF + wr * 64 + m * 16 + fr; const float rstd = S[r];
                        const f32x4 h = (acc[ai][bj][m][n] * rstd) * mul + sh;
                        u32x2 w; w.x = cvt_pk_bf16(h[0], h[1]); w.y = cvt_pk_bf16(h[2], h[3]);
                        *(u32x2*)(hn + (size_t)(u.pm * BM + r) * DM + col0 + co) = w; } }
    }
};
struct EpiResidNormOut {
    static constexpr bool PERM = false, AFTER_DRAIN = true;
    float* out; const float* mod; int gate_off; const float* g; PanelSsq st;
    __device__ __forceinline__ void fused(f32x4 (&acc)[2][2][4][2], const Unit& u, int wr, int wc, int fr, int fq, LAS unsigned char* lds, int wid, int lane) const {
        const int row0 = u.pm * BM + wr * 64 + fr, col0 = u.pn * BM + wc * 32 + 4 * fq, b = u.pm >> 3;
        const float* modb = mod + (size_t)b * NMOD + col0;
        { f32x4 gv[2][2];
#pragma unroll
          for (int bj = 0; bj < 2; ++bj)
#pragma unroll
            for (int n = 0; n < 2; ++n) gv[bj][n] = *(const f32x4*)(modb + gate_off + bj * HALF + n * 16);
#pragma unroll
          for (int ai = 0; ai < 2; ++ai)
#pragma unroll
            for (int m = 0; m < 4; ++m) { const size_t off = (size_t)(row0 + ai * HALF + m * 16) * DM + col0;
#pragma unroll
                for (int bj = 0; bj < 2; ++bj)
#pragma unroll
                    for (int n = 0; n < 2; ++n) { const f32x4 xv = *(const f32x4*)(out + off + bj * HALF + n * 16); acc[ai][bj][m][n] = xv + gv[bj][n] * acc[ai][bj][m][n]; }
                asm volatile("" : "+v"(acc[ai][0][m][0]), "+v"(acc[ai][0][m][1]), "+v"(acc[ai][1][m][0]), "+v"(acc[ai][1][m][1]));
                asm volatile("" ::: "memory"); } }
        st.run(acc, u, wr, wc, fr, fq, lds, wid, lane);
        const LAS float* S = (const LAS float*)(lds + 4096);
        f32x4 gg[2][2];
#pragma unroll
        for (int bj = 0; bj < 2; ++bj)
#pragma unroll
            for (int n = 0; n < 2; ++n) gg[bj][n] = *(const f32x4*)(g + col0 + bj * HALF + n * 16);
#pragma unroll
        for (int ai = 0; ai < 2; ++ai)
#pragma unroll
            for (int m = 0; m < 4; ++m) { const int r = ai * HALF + wr * 64 + m * 16 + fr; const float rstd = S[r]; float* rowp = out + (size_t)(u.pm * BM + r) * DM + col0;
#pragma unroll
                for (int bj = 0; bj < 2; ++bj)
#pragma unroll
                    for (int n = 0; n < 2; ++n) *(f32x4*)(rowp + bj * HALF + n * 16) = (acc[ai][bj][m][n] * rstd) * gg[bj][n];
                asm volatile("" ::: "memory"); }
    }
};
}

struct SchedP2 {
    const char *H, *HE, *HO, *WQK, *WA; char *QK, *VT, *VTA; float* SP; int G, c;
    __device__ __forceinline__ bool next(int i, pg8::Unit& u) const {
        const int L = i * G + c; if (L >= 512) return false;
        constexpr size_t tstep = (size_t)256 * DM * 2;
        u.sp = nullptr;
        if (L < 256) { int pm, pn; pg8::tile_map(L, 64, 4, pm, pn); u.pm = pm; u.pn = pn; u.pa = H + pm * tstep; u.pb = WQK + pn * tstep;
            const int b = pm >> 3, s0 = (pm & 7) * 256, head0 = (pn & 1) * 4;
            u.po = QK + (size_t)(pn >> 1) * (16u << 20) + ((size_t)((b * 8 + head0) * SEQ + s0) * 64) * 2; u.rp = 64; u.RS = 64 * 64; u.CS = SEQ * 64; }
        else if (L < 384) { int pm, pn; pg8::tile_map(L - 256, 2, 64, pm, pn); u.pm = 4 + pm; u.pn = pn; u.pa = WA + (size_t)(4 + pm) * tstep; u.pb = H + pn * tstep;
            const int b = pn >> 3;
            u.po = VTA + ((size_t)((b * 8 + 4 * pm) * 32 + 4 * (pn & 7)) * 4096) * 2; u.rp = 64; u.RS = 32 * 4096; u.CS = 4096; }
        else { const int which = (L - 384) >> 6; int pm, pn; pg8::tile_map((L - 384) & 63, 2, 32, pm, pn); u.pm = which * 2 + pm; u.pn = pn;
            u.pa = WA + (size_t)(which * 2 + pm) * tstep; u.pb = (which ? HO : HE) + pn * tstep;
            const int b = pn >> 2, st = pn & 3;
            u.po = VT + (size_t)which * (8u << 20) + ((size_t)(b * 512 + pm * 256) * 1024 + st * 256) * 2; u.rp = 1024; u.RS = 64 * 1024; u.CS = 64;
            if (!which) u.sp = SP + ((size_t)(b * 512 + pm * 256) * 32 + st * 4); }
        return true;
    }
};
struct SchedFourier {
    const char *CS, *VT; char* PQ; int G, c;
    __device__ __forceinline__ bool next(int i, pg8::Unit& u) const {
        const int L = i * G + c; if (L >= 128) return false;
        int pm, pn; pg8::tile_map(L, 8, 16, pm, pn); u.pm = pm; u.pn = pn;
        constexpr size_t tstep = (size_t)256 * 1024 * 2;
        u.pa = CS + pm * tstep; u.pb = VT + (size_t)(pm >> 2) * (8u << 20) + pn * tstep; u.po = PQ + ((size_t)pm * 256 * 4096 + pn * 256) * 2; u.rp = 4096; u.RS = 64 * 4096; u.CS = 64; u.sp = nullptr;
        return true;
    }
};
struct SchedPlain {
    const char *A, *B; int nM, nN, K, G, c;
    __device__ __forceinline__ bool next(int i, pg8::Unit& u) const {
        const int L = i * G + c; if (L >= nM * nN) return false;
        int pm, pn; pg8::tile_map(L, nM, nN, pm, pn); u.pm = pm; u.pn = pn;
        const size_t tstep = (size_t)256 * K * 2;
        u.pa = A + pm * tstep; u.pb = B + pn * tstep; u.po = nullptr; u.sp = nullptr; u.rp = 0; u.RS = 0; u.CS = 0;
        return true;
    }
};

template <int NC> __device__ __forceinline__ void p0_mod_item(const Params& p, LAS unsigned char* lds, int item) {
    LAS float* cs = (LAS float*)lds;
    LAS float* red = (LAS float*)(lds + 32768);
    const int tid = threadIdx.x;
    for (int u = tid; u < NBATCH * DM; u += NTHREADS) { const float v = p.c[u]; cs[u] = v / (1.0f + __expf(-v)); }
    __syncthreads();
    const int j0 = item * NC, l16 = tid & 15, rs = tid >> 4; const int lc = min(l16, NC / 4 - 1);
    f32x4 acc[8];
#pragma unroll
    for (int b = 0; b < 8; ++b) acc[b] = (f32x4){0.f, 0.f, 0.f, 0.f};
#pragma unroll 32
    for (int pass = 0; pass < 32; ++pass) { const int i = pass * 32 + rs; const f32x4 w = *(const f32x4*)(p.w_ada + (size_t)i * NMOD + j0 + 4 * lc);
#pragma unroll
        for (int b = 0; b < 8; ++b) acc[b] += cs[b * DM + i] * w; }
#pragma unroll
    for (int b = 0; b < 8; ++b) *(LAS f32x4*)(red + (rs * 8 + b) * 64 + 4 * l16) = acc[b];
    __syncthreads();
    { const int b = tid >> 6, col = tid & 63; if (col < NC) { float s = p.b_ada[j0 + col];
#pragma unroll 8
      for (int r = 0; r < 32; ++r) s += red[(r * 8 + b) * 64 + col];
      ((float*)(p.ws + WS_MOD))[(size_t)b * NMOD + j0 + col] = s; } }
    asm volatile("s_waitcnt vmcnt(0)" ::: "memory");
    __syncthreads();
    if (tid == 0) {
        __builtin_amdgcn_fence(__ATOMIC_RELEASE, "agent");
        asm volatile("s_waitcnt vmcnt(0)" ::: "memory");
        __hip_atomic_fetch_add((unsigned*)(p.ws + WS_BAR) + 3712, 1u, __ATOMIC_RELAXED, __HIP_MEMORY_SCOPE_AGENT);
    }
}
typedef float f32x16 __attribute__((ext_vector_type(16)));
__device__ __forceinline__ void p0_fold_item(const Params& p, LAS unsigned char* lds, int item) {
    LAS float* Wf = (LAS float*)lds;
    LAS float* Gm = (LAS float*)(lds + 65536);
    LAS float* wt = (LAS float*)(lds + 131072);
    const int tid = threadIdx.x, lane = tid & 63, w = tid >> 6, which = item >> 6, g = (item >> 4) & 3, ib = (item & 15) * 64;
    for (int u = tid; u < 4096; u += NTHREADS) *(LAS f32x4*)(Wf + 4 * u) = *(const f32x4*)(p.w_four + (size_t)g * 16384 + 4 * u);
    __syncthreads();
    {
        const int mt = w >> 1, nt0 = (w & 1) * 2, li = lane & 31, lk = lane >> 5, c = mt * 32 + li;
        f32x16 acc0, acc1;
#pragma unroll
        for (int r = 0; r < 16; ++r) { acc0[r] = 0.f; acc1[r] = 0.f; }
#pragma unroll 4
        for (int ks = 0; ks < 64; ++ks) { const int e = 2 * ks + lk; const float ang = (float)((c * e) & 127) * (1.0f / 128.0f);
            const float a = (which ? __builtin_amdgcn_sinf(ang) : __builtin_amdgcn_cosf(ang)) * 0.08838834764831845f;
            const float b0 = Wf[e * 128 + nt0 * 32 + li], b1 = Wf[e * 128 + nt0 * 32 + 32 + li];
            acc0 = __builtin_amdgcn_mfma_f32_32x32x2f32(a, b0, acc0, 0, 0, 0); acc1 = __builtin_amdgcn_mfma_f32_32x32x2f32(a, b1, acc1, 0, 0, 0); }
#pragma unroll
        for (int r = 0; r < 16; ++r) { const int row = mt * 32 + (r & 3) + 8 * (r >> 2) + 4 * lk; Gm[row * 128 + nt0 * 32 + li] = acc0[r]; Gm[row * 128 + nt0 * 32 + 32 + li] = acc1[r]; }
    }
    for (int sub = 0; sub < 2; ++sub) { const int i0 = ib + sub * 32;
    for (int u = tid; u < 4096; u += NTHREADS) { const int il = u >> 7, c = u & 127; wt[il * 129 + c] = p.w_in[(size_t)(i0 + il) * 2048 + g * 128 + c]; }
    __syncthreads();
    {
        const int li = lane & 15, lk = lane >> 4;
        f32x4 acc0 = (f32x4){0.f, 0.f, 0.f, 0.f}, acc1 = (f32x4){0.f, 0.f, 0.f, 0.f};
#pragma unroll 4
        for (int ks = 0; ks < 32; ++ks) { const int c = 4 * ks + lk; const float a = Gm[c * 128 + 16 * w + li], b0 = wt[li * 129 + c], b1 = wt[(16 + li) * 129 + c];
            acc0 = __builtin_amdgcn_mfma_f32_16x16x4f32(a, b0, acc0, 0, 0, 0); acc1 = __builtin_amdgcn_mfma_f32_16x16x4f32(a, b1, acc1, 0, 0, 0); }
        bf16_t* WA = (bf16_t*)(p.ws + WS_WA);
#pragma unroll
        for (int r = 0; r < 4; ++r) { const int d = 16 * w + lk * 4 + r; bf16_t* rowp = WA + (size_t)(which * 512 + g * 128 + d) * DM + i0;
            rowp[li] = (bf16_t)(cvt_pk_bf16(acc0[r], 0.f) & 0xffffu); rowp[16 + li] = (bf16_t)(cvt_pk_bf16(acc1[r], 0.f) & 0xffffu); }
    }
    __syncthreads();
    }
}
__device__ __forceinline__ void p0_transpose_item(const float* W, int ldw, int ncol0, int K, bf16_t* WT, int orow, const float* gk, LAS float* scr, int kb, int lane) {
    const int k0 = 64 * kb;
#pragma unroll 8
    for (int i = 0; i < 32; ++i) { const int kk = 2 * i + (lane >> 5); float v = W[(size_t)(k0 + kk) * ldw + ncol0 + (lane & 31)]; if (gk) v *= gk[k0 + kk]; scr[kk * 33 + (lane & 31)] = v; }
    asm volatile("s_waitcnt lgkmcnt(0)" ::: "memory");
    const int c = lane & 7;
#pragma unroll
    for (int j = 0; j < 4; ++j) { const int n = (lane >> 3) + 8 * j; const LAS float* s = scr + (8 * c) * 33 + n;
        u32x4 o; o.x = cvt_pk_bf16(s[0 * 33], s[1 * 33]); o.y = cvt_pk_bf16(s[2 * 33], s[3 * 33]); o.z = cvt_pk_bf16(s[4 * 33], s[5 * 33]); o.w = cvt_pk_bf16(s[6 * 33], s[7 * 33]);
        *(u32x4*)(WT + (size_t)(orow + n) * K + k0 + 8 * c) = o; }
    asm volatile("s_waitcnt lgkmcnt(0)" ::: "memory");
}
__device__ __forceinline__ void p0_prologue(const Params& p, LAS unsigned char* lds) {
    const int tid = threadIdx.x, lane = tid & 63, wave = tid >> 6, G = gridDim.x;
    if (G == 256) {
        if (blockIdx.x < 128) p0_fold_item(p, lds, blockIdx.x); else p0_mod_item<48>(p, lds, blockIdx.x - 128);
    } else { for (int it = blockIdx.x; it < 96; it += G) p0_mod_item<64>(p, lds, it);
        for (int it = blockIdx.x; it < 128; it += G) p0_fold_item(p, lds, it); }
    LAS float* scr = (LAS float*)(lds + wave * 16384);
    const int gw = blockIdx.x * NWAVES + wave, NGW = G * NWAVES;
    constexpr int I_QK = 16 * 32, I_V = 16 * 16;
    for (int it = gw; it < I_QK + I_V; it += NGW) {
        int r = it;
        if (r < I_QK) { const int kb = r >> 5, nb = r & 31; p0_transpose_item(p.w_in, 2048, 512 + nb * 32, DM, (bf16_t*)(p.ws + WS_WQK), nb * 32, nullptr, scr, kb, lane); continue; } r -= I_QK;
        { const int kb = r >> 4, nb = r & 15; p0_transpose_item(p.w_in, 2048, 1536 + nb * 32, DM, (bf16_t*)(p.ws + WS_WA), 1024 + nb * 32, nullptr, scr, kb, lane); }
    }
}
__device__ __forceinline__ void late_work(const Params& p, LAS unsigned char* lds, int hidx, int nh, int what) {
    const int tid = threadIdx.x, lane = tid & 63, wave = tid >> 6;
    LAS float* scr = (LAS float*)(lds + wave * 16384);
    const int gw = hidx * NWAVES + wave, NGW = nh * NWAVES;
    constexpr int I_O = 16 * 32, I_UP = 16 * 176, I_DN = 44 * 32;
    const int it_lo = (what & 1) ? 0 : I_O + I_UP, it_hi = (what & 2) ? I_O + I_UP + I_DN : ((what & 1) ? I_O + I_UP : it_lo);
    for (int it = it_lo + gw; it < it_hi; it += NGW) {
        int r = it;
        if (r < I_O) { const int kb = r >> 5, nb = r & 31; p0_transpose_item(p.w_out, DM, nb * 32, DM, (bf16_t*)(p.ws + WS_WOUT), nb * 32, kb < 8 ? p.g_four_out : p.g_na_out - 512, scr, kb, lane); continue; } r -= I_O;
        if (r < I_UP) { const int kb = r / 176, nb = r % 176; const int n0 = nb * 32; const int isv = n0 >= DFF, j = isv ? n0 - DFF : n0;
            p0_transpose_item(p.w_up, 2 * DFF, n0, DM, (bf16_t*)(p.ws + WS_WUP), (j >> 7) * 256 + isv * 128 + (j & 127), nullptr, scr, kb, lane); continue; } r -= I_UP;
        { const int kb = r >> 5, nb = r & 31; p0_transpose_item(p.w_down, DM, nb * 32, DFF, (bf16_t*)(p.ws + WS_WDN), nb * 32, nullptr, scr, kb, lane); }
    }
    bf16_t* CS = (bf16_t*)(p.ws + WS_CS);
    if (what & 4) for (int u = hidx * NTHREADS + tid; u < 2048 * 128; u += nh * NTHREADS) { const int kp = u >> 7, s0 = (u & 127) * 8, k = kp & 1023; float v[8];
#pragma unroll
        for (int j = 0; j < 8; ++j) { const float ang = (float)((k * (s0 + j)) & 2047) * (1.0f / 2048.0f); v[j] = (kp >= 1024 ? __builtin_amdgcn_sinf(ang) : __builtin_amdgcn_cosf(ang)) * 0.022097086912079608f; }
        u32x4 o; o.x = cvt_pk_bf16(v[0], v[1]); o.y = cvt_pk_bf16(v[2], v[3]); o.z = cvt_pk_bf16(v[4], v[5]); o.w = cvt_pk_bf16(v[6], v[7]);
        *(u32x4*)(CS + (size_t)kp * 1024 + s0) = o; }
}

__device__ __forceinline__ void pass_norm_mod(const float* src, const float* ssq, const float* g, const float* mod, int sh_off, int sc_off, bf16_t* dst) {
    constexpr int RW = 4;
    const int lane = threadIdx.x & 63, gw = blockIdx.x * NWAVES + (threadIdx.x >> 6), NGW = gridDim.x * NWAVES;
    if (!ssq && NGW == 2048) {
        const int rowb = gw * 8, b = rowb >> 11;
        f32x4 mul[4], sh[4];
#pragma unroll
        for (int j = 0; j < 4; ++j) { const f32x4 gg = ((const f32x4*)g)[lane + 64 * j], sc = ((const f32x4*)(mod + (size_t)b * NMOD + sc_off))[lane + 64 * j];
            mul[j] = gg * (1.0f + sc); sh[j] = ((const f32x4*)(mod + (size_t)b * NMOD + sh_off))[lane + 64 * j]; }
#pragma unroll
        for (int half = 0; half < 2; ++half) {
            f32x4 v[RW][4];
#pragma unroll
            for (int q = 0; q < RW; ++q) { const f32x4* xr = (const f32x4*)(src + (size_t)(rowb + half * RW + q) * DM) + lane;
#pragma unroll
                for (int j = 0; j < 4; ++j) v[q][j] = xr[64 * j]; }
#pragma unroll
            for (int q = 0; q < RW; ++q) { float t = 0.f;
#pragma unroll
                for (int j = 0; j < 4; ++j) t += (v[q][j][0] * v[q][j][0] + v[q][j][1] * v[q][j][1]) + (v[q][j][2] * v[q][j][2] + v[q][j][3] * v[q][j][3]);
                t = wave_sum(t); const float rstd = 1.0f / sqrtf(t * (1.0f / DM) + EPS);
                u32x2* o8 = (u32x2*)(dst + (size_t)(rowb + half * RW + q) * DM) + lane;
#pragma unroll
                for (int j = 0; j < 4; ++j) { const f32x4 h = (v[q][j] * rstd) * mul[j] + sh[j]; u32x2 w; w.x = cvt_pk_bf16(h[0], h[1]); w.y = cvt_pk_bf16(h[2], h[3]); o8[64 * j] = w; } }
        }
        return;
    }
    for (int row0 = gw; row0 < NTOK; row0 += RW * NGW) {
        f32x4 v[RW][4]; float s[RW];
#pragma unroll
        for (int q = 0; q < RW; ++q) { const int row = min(row0 + q * NGW, NTOK - 1); const f32x4* xr = (const f32x4*)(src + (size_t)row * DM) + lane;
#pragma unroll
            for (int j = 0; j < 4; ++j) v[q][j] = xr[64 * j]; }
#pragma unroll
        for (int q = 0; q < RW; ++q) { const int row = min(row0 + q * NGW, NTOK - 1); float t = 0.f;
#pragma unroll
            for (int j = 0; j < 4; ++j) t += (v[q][j][0] * v[q][j][0] + v[q][j][1] * v[q][j][1]) + (v[q][j][2] * v[q][j][2] + v[q][j][3] * v[q][j][3]);
            if (ssq) { t = ssq[(size_t)row * 16 + (lane & 15)]; t += __shfl_xor(t, 1); t += __shfl_xor(t, 2); t += __shfl_xor(t, 4); t += __shfl_xor(t, 8); }
            else t = wave_sum(t);
            s[q] = 1.0f / sqrtf(t * (1.0f / DM) + EPS); }
#pragma unroll
        for (int q = 0; q < RW; ++q) { const int row = row0 + q * NGW; if (row < NTOK) { const int b = row >> 11;
            const f32x4* g4 = (const f32x4*)g + lane; const f32x4* sh4 = (const f32x4*)(mod + (size_t)b * NMOD + sh_off) + lane; const f32x4* sc4 = (const f32x4*)(mod + (size_t)b * NMOD + sc_off) + lane;
            u32x2* o8 = (u32x2*)(dst + (size_t)row * DM) + lane;
#pragma unroll
            for (int j = 0; j < 4; ++j) { const f32x4 gg = g4[64 * j], sh = sh4[64 * j], sc = sc4[64 * j]; const f32x4 h = (v[q][j] * s[q] * gg) * (1.0f + sc) + sh;
                u32x2 w; w.x = cvt_pk_bf16(h[0], h[1]); w.y = cvt_pk_bf16(h[2], h[3]); o8[64 * j] = w; } } }
    }
}
__device__ __forceinline__ void pass_h_fold(const float* src, const float* g, const float* mod, bf16_t* H, bf16_t* HE, bf16_t* HO) {
    const int vb = (gridDim.x & 7) ? (int)blockIdx.x : (int)((blockIdx.x & 7) * (gridDim.x >> 3) + (blockIdx.x >> 3));
    const int lane = threadIdx.x & 63, gw = vb * NWAVES + (threadIdx.x >> 6), NGW = gridDim.x * NWAVES;
    for (int ch = gw; ch < 2048; ch += NGW) {
        const int b = ch >> 8, sb = (ch & 255) * 4;
        f32x4 mul[4], sh[4];
#pragma unroll
        for (int j = 0; j < 4; ++j) { const f32x4 gg = ((const f32x4*)g)[lane + 64 * j], sc = ((const f32x4*)(mod + (size_t)b * NMOD + DM))[lane + 64 * j];
            mul[j] = gg * (1.0f + sc); sh[j] = ((const f32x4*)(mod + (size_t)b * NMOD))[lane + 64 * j]; }
#pragma unroll
        for (int half = 0; half < 2; ++half) {
            f32x4 v[2][2][4];
#pragma unroll
            for (int q = 0; q < 2; ++q) { const int s = sb + half * 2 + q, pr = (s == 0) ? SEQ / 2 : SEQ - s;
                const f32x4* x0 = (const f32x4*)(src + (size_t)(b * SEQ + s) * DM) + lane; const f32x4* x1 = (const f32x4*)(src + (size_t)(b * SEQ + pr) * DM) + lane;
#pragma unroll
                for (int j = 0; j < 4; ++j) { v[q][0][j] = x0[64 * j]; v[q][1][j] = x1[64 * j]; } }
#pragma unroll
            for (int q = 0; q < 2; ++q) { const int s = sb + half * 2 + q, pr = (s == 0) ? SEQ / 2 : SEQ - s;
                float t0 = 0.f, t1 = 0.f;
#pragma unroll
                for (int j = 0; j < 4; ++j) { const f32x4 a = v[q][0][j], c = v[q][1][j]; t0 += (a[0] * a[0] + a[1] * a[1]) + (a[2] * a[2] + a[3] * a[3]); t1 += (c[0] * c[0] + c[1] * c[1]) + (c[2] * c[2] + c[3] * c[3]); }
                t0 = wave_sum(t0); t1 = wave_sum(t1);
                const float r0 = 1.0f / sqrtf(t0 * (1.0f / DM) + EPS), r1 = 1.0f / sqrtf(t1 * (1.0f / DM) + EPS);
                u32x2* o0 = (u32x2*)(H + (size_t)(b * SEQ + s) * DM) + lane; u32x2* o1 = (u32x2*)(H + (size_t)(b * SEQ + pr) * DM) + lane;
                u32x2* oe = (u32x2*)(HE + (size_t)(b * 1024 + s) * DM) + lane; u32x2* oo = (u32x2*)(HO + (size_t)(b * 1024 + s) * DM) + lane;
#pragma unroll
                for (int j = 0; j < 4; ++j) { const f32x4 h0 = (v[q][0][j] * r0) * mul[j] + sh[j], h1 = (v[q][1][j] * r1) * mul[j] + sh[j];
                    u32x2 w; w.x = cvt_pk_bf16(h0[0], h0[1]); w.y = cvt_pk_bf16(h0[2], h0[3]); o0[64 * j] = w;
                    w.x = cvt_pk_bf16(h1[0], h1[1]); w.y = cvt_pk_bf16(h1[2], h1[3]); o1[64 * j] = w;
                    const f32x4 e = (s == 0) ? h0 : h0 + h1, o = (s == 0) ? (f32x4){0.f, 0.f, 0.f, 0.f} : h0 - h1;
                    w.x = cvt_pk_bf16(e[0], e[1]); w.y = cvt_pk_bf16(e[2], e[3]); oe[64 * j] = w;
                    w.x = cvt_pk_bf16(o[0], o[1]); w.y = cvt_pk_bf16(o[2], o[3]); oo[64 * j] = w; } }
        }
    }
}
__device__ __forceinline__ void pass_xmid(const bf16_t* H, const bf16_t* WA, float* X) {
    const int lane = threadIdx.x & 63, gw = blockIdx.x * NWAVES + (threadIdx.x >> 6), NGW = gridDim.x * NWAVES;
    for (int t = gw; t < NBATCH * 512; t += NGW) { const int b = t >> 9, c = t & 511;
        const u32x4* hp = (const u32x4*)(H + (size_t)(b * SEQ + SEQ / 2) * DM) + lane * 2; const u32x4* wp = (const u32x4*)(WA + (size_t)c * DM) + lane * 2;
        float s = 0.f;
#pragma unroll
        for (int q = 0; q < 2; ++q) { const u32x4 hv = hp[q], wv = wp[q];
#pragma unroll
            for (int j = 0; j < 4; ++j) s += bf_lo(hv[j]) * bf_lo(wv[j]) + bf_hi(hv[j]) * bf_hi(wv[j]); }
        s = wave_sum(s);
        if (lane == 0) X[t] = s; }
}
__device__ __forceinline__ void pass_final(float* xo, const float* ssq, const float* g) {
    const int lane = threadIdx.x & 63, gw = blockIdx.x * NWAVES + (threadIdx.x >> 6), NGW = gridDim.x * NWAVES;
    for (int row = gw; row < NTOK; row += NGW) {
        f32x4* xr = (f32x4*)(xo + (size_t)row * DM) + lane;
        float s = ssq[(size_t)row * 16 + (lane & 15)]; s += __shfl_xor(s, 1); s += __shfl_xor(s, 2); s += __shfl_xor(s, 4); s += __shfl_xor(s, 8);
        const float rstd = 1.0f / sqrtf(s * (1.0f / DM) + EPS);
        const f32x4* g4 = (const f32x4*)g + lane;
#pragma unroll
        for (int j = 0; j < 4; ++j) { const f32x4 v = xr[64 * j]; xr[64 * j] = v * rstd * g4[64 * j]; }
    }
}
__device__ __forceinline__ void combine_row(int row, const float (&y)[8], const float* SSQNA, bf16_t* YCAT, int lane) {
    float s = 0.f;
#pragma unroll
    for (int j = 0; j < 8; ++j) s += y[j] * y[j];
    s = wave_sum(s);
    const float rstd = 1.0f / sqrtf(s * (1.0f / 512.0f) + EPS);
    u32x4 o; o.x = cvt_pk_bf16(y[0] * rstd, y[1] * rstd); o.y = cvt_pk_bf16(y[2] * rstd, y[3] * rstd); o.z = cvt_pk_bf16(y[4] * rstd, y[5] * rstd); o.w = cvt_pk_bf16(y[6] * rstd, y[7] * rstd);
    *(u32x4*)(YCAT + (size_t)row * DM + lane * 8) = o;
    float t = SSQNA[(size_t)row * 8 + (lane & 7)]; t += __shfl_xor(t, 1); t += __shfl_xor(t, 2); t += __shfl_xor(t, 4);
    const float rn = 1.0f / sqrtf(t * (1.0f / 512.0f) + EPS);
    u32x4* ap = (u32x4*)(YCAT + (size_t)row * DM + 512 + lane * 8); const u32x4 aw = *ap; u32x4 ow;
#pragma unroll
    for (int j = 0; j < 4; ++j) ow[j] = cvt_pk_bf16(bf_lo(aw[j]) * rn, bf_hi(aw[j]) * rn);
    *ap = ow;
}
__device__ __forceinline__ void pass_combine(const bf16_t* PQ, const float* SP, const float* XM, const float* SSQNA, bf16_t* YCAT) {
    const int vb = (gridDim.x & 7) ? (int)blockIdx.x : (int)((blockIdx.x & 7) * (gridDim.x >> 3) + (blockIdx.x >> 3));
    const int lane = threadIdx.x & 63, gw = vb * NWAVES + (threadIdx.x >> 6), NGW = gridDim.x * NWAVES;
    for (int pi0 = gw; pi0 < NBATCH * 1024; pi0 += NGW) {
        const int pi = (NGW == 2048) ? gw * 4 + (pi0 - gw) / NGW : pi0;
        const int b = pi >> 10, kk = pi & 1023;
        const u32x4 pw = *(const u32x4*)(PQ + (size_t)kk * 4096 + b * 512 + lane * 8), qw = *(const u32x4*)(PQ + (size_t)(1024 + kk) * 4096 + b * 512 + lane * 8);
        float y1[8], y2[8];
        const f32x4 xa = *(const f32x4*)(XM + b * 512 + lane * 8), xb = *(const f32x4*)(XM + b * 512 + lane * 8 + 4); const float xs = (kk & 1) ? -0.022097086912079608f : 0.022097086912079608f;
        const float xm[8] = {xa[0] * xs, xa[1] * xs, xa[2] * xs, xa[3] * xs, xb[0] * xs, xb[1] * xs, xb[2] * xs, xb[3] * xs};
#pragma unroll
        for (int j = 0; j < 4; ++j) { const float pl = bf_lo(pw[j]) + xm[2 * j], ph = bf_hi(pw[j]) + xm[2 * j + 1], ql = bf_lo(qw[j]), qh = bf_hi(qw[j]); y1[2 * j] = pl - ql; y1[2 * j + 1] = ph - qh; y2[2 * j] = pl + ql; y2[2 * j + 1] = ph + qh; }
        if (kk == 0) {
#pragma unroll
            for (int j = 0; j < 8; ++j) { const f32x4* sp = (const f32x4*)(SP + (size_t)(b * 512 + lane * 8 + j) * 32); f32x4 a = sp[0];
#pragma unroll
                for (int i = 1; i < 4; ++i) a += sp[i];
                y2[j] = ((a[0] + a[1]) + (a[2] + a[3])) * 0.022097086912079608f + xm[j]; }
        }
        combine_row(b * SEQ + kk, y1, SSQNA, YCAT, lane);
        combine_row(b * SEQ + (kk == 0 ? 1024 : SEQ - kk), y2, SSQNA, YCAT, lane);
    }
}
__device__ __forceinline__ void pass_fixup(const bf16_t* side, const float* cw, const float* cb, bf16_t* A) {
    const int total = 512 * (DFF / 4);
    for (int u = blockIdx.x * NTHREADS + threadIdx.x; u < total; u += gridDim.x * NTHREADS) {
        const int ri = u / (DFF / 4), J = (u % (DFF / 4)) * 4, chunk = ri >> 1, bot = ri & 1;
        const bf16_t* sc = side + (size_t)chunk * 4 * (2 * DFF);
        const bf16_t *pp, *pc, *pn; bool hp = true, hn = true; int tok;
        if (!bot) { hp = (chunk & 31) != 0; pp = sc - (2 * DFF); pc = sc; pn = sc + (2 * DFF); tok = chunk * 64; }
        else { hn = (chunk & 31) != 31; pp = sc + 2 * (2 * DFF); pc = sc + 3 * (2 * DFF); pn = sc + 4 * (2 * DFF); tok = chunk * 64 + 63; }
        float up[2][4];
#pragma unroll
        for (int bj = 0; bj < 2; ++bj) {
            const int col = bj * DFF + J;
            u32x2 wp = (u32x2){0u, 0u}, wn = (u32x2){0u, 0u}; if (hp) wp = *(const u32x2*)(pp + col); if (hn) wn = *(const u32x2*)(pn + col); const u32x2 wc2 = *(const u32x2*)(pc + col);
            const f32x4 k0 = *(const f32x4*)(cw + col), k1 = *(const f32x4*)(cw + 2 * DFF + col), k2 = *(const f32x4*)(cw + 4 * DFF + col), kb = *(const f32x4*)(cb + col);
            const float pv[4] = {bf_lo(wp.x), bf_hi(wp.x), bf_lo(wp.y), bf_hi(wp.y)}, cv[4] = {bf_lo(wc2.x), bf_hi(wc2.x), bf_lo(wc2.y), bf_hi(wc2.y)}, nv[4] = {bf_lo(wn.x), bf_hi(wn.x), bf_lo(wn.y), bf_hi(wn.y)};
#pragma unroll
            for (int j = 0; j < 4; ++j) up[bj][j] = k0[j] * pv[j] + k1[j] * cv[j] + k2[j] * nv[j] + kb[j];
        }
        u32x2 w; w.x = cvt_pk_bf16(silu_f(up[0][0]) * up[1][0], silu_f(up[0][1]) * up[1][1]); w.y = cvt_pk_bf16(silu_f(up[0][2]) * up[1][2], silu_f(up[0][3]) * up[1][3]);
        *(u32x2*)(A + (size_t)tok * DFF + J) = w;
    }
}

__device__ __forceinline__ void attn_phase(const Params& p, LAS unsigned char* lds) {
    const int tid = threadIdx.x, lane = tid & 63, w = __builtin_amdgcn_readfirstlane(tid >> 6), fr = lane & 15, fq = lane >> 4;
    LAS unsigned char* Ks = lds;
    LAS unsigned char* Vs = lds + 73728;
    LAS float* rp = (LAS float*)(lds + 147456);
    volatile LAS unsigned* slot = (volatile LAS unsigned*)(lds + 147456 + 2048);
    const bf16_t* QH = (const bf16_t*)(p.ws + WS_QK); const bf16_t* KH = (const bf16_t*)(p.ws + WS_QK + (16u << 20)); const bf16_t* VTA = (const bf16_t*)(p.ws + WS_VTA);
    bf16_t* YCAT = (bf16_t*)(p.ws + WS_YCAT); float* SSQNA = (float*)(p.ws + WS_SSQ1 + 512 * 1024);
    const float sc2 = 0.125f * 1.4426950408889634f;
    unsigned* ctr = (unsigned*)(p.ws + WS_BAR) + 3584;
    const int ri = w >> 2, qb = w & 3, q0 = qb * 16, kc0 = min(max(q0 - 8, 0), 32);
    const int kperm = 8 * (fr >> 2) + (fr & 3);
    for (;;) {
        __syncthreads();
        if (tid == 0) slot[0] = __hip_atomic_fetch_add(ctr, 1u, __ATOMIC_RELAXED, __HIP_MEMORY_SCOPE_AGENT);
        __syncthreads();
        const int item = (int)slot[0];
        if (item >= 1024) break;
        const int b = item >> 7, h = (item >> 4) & 7, r0 = (item & 15) * 2, R0 = min(max(r0 - 4, 0), 24);
        const int r = r0 + ri, rs = min(max(r - 4, 0), 24), j0 = rs - R0;
        const int tq = b * SEQ + r * 64 + q0 + fr;
        const bf16_t* qp = QH + ((size_t)(b * 8 + h) * SEQ + r * 64 + q0 + fr) * 64 + fq * 8;
        const bf16x8 qf0 = *(const bf16x8*)qp, qf1 = *(const bf16x8*)(qp + 32);
        for (int u = tid; u < 465; u += NTHREADS) rp[u] = p.rpb[h * 465 + u] * 1.4426950408889634f;
        { const int t = tid >> 3, c = tid & 7; const unsigned dstk = (unsigned)(t * 128 + ((c ^ (((t >> 1) & 1) | (((t >> 3) & 3) << 1))) << 4)), dstv = (unsigned)(t * 128 + ((c ^ ((t >> 1) & 7)) << 4));
          u32x4 kv[9], vv[9];
#pragma unroll
          for (int j = 0; j < 9; ++j) { const int srow = min(R0 + j, 31);
              kv[j] = *(const u32x4*)(KH + ((size_t)(b * 8 + h) * SEQ + srow * 64 + t) * 64 + c * 8);
              vv[j] = *(const u32x4*)(VTA + ((size_t)((b * 8 + h) * 32 + srow) * 64 + t) * 64 + c * 8); }
#pragma unroll
          for (int j = 0; j < 9; ++j) { *(LAS u32x4*)(Ks + j * 8192 + dstk) = kv[j]; *(LAS u32x4*)(Vs + j * 8192 + dstv) = vv[j]; } }
        __syncthreads();
        f32x4 s[8][2];
#pragma unroll
        for (int i = 0; i < 8; ++i)
#pragma unroll
            for (int t = 0; t < 2; ++t) { const int tok = kc0 + kperm + 4 * t; const LAS unsigned char* kr = Ks + (j0 + i) * 8192 + tok * 128;
                const int fk = ((tok >> 1) & 1) | (((tok >> 3) & 3) << 1);
                const bf16x8 k0 = *(const LAS bf16x8*)(kr + ((fq ^ fk) << 4)), k1 = *(const LAS bf16x8*)(kr + (((4 + fq) ^ fk) << 4));
                f32x4 a = (f32x4){0.f, 0.f, 0.f, 0.f};
                a = __builtin_amdgcn_mfma_f32_16x16x32_bf16(k0, qf0, a, 0, 0, 0); a = __builtin_amdgcn_mfma_f32_16x16x32_bf16(k1, qf1, a, 0, 0, 0); s[i][t] = a; }
        const int qc = q0 + fr, cs0 = min(max(qc - 8, 0), 48);
        float madd[2][4]; int dco[2][4];
#pragma unroll
        for (int t = 0; t < 2; ++t)
#pragma unroll
            for (int j = 0; j < 4; ++j) { const int kc = kc0 + 8 * fq + 4 * t + j; madd[t][j] = ((kc >= cs0) && (kc < cs0 + 16)) ? 0.f : -1e30f; dco[t][j] = min(max(kc - qc, -15), 15); }
        float mx = -1e30f;
#pragma unroll
        for (int i = 0; i < 8; ++i) { const int dr = rs + i - r; const LAS float* rrow = rp + (dr + 7) * 31 + 15;
#pragma unroll
            for (int t = 0; t < 2; ++t)
#pragma unroll
                for (int j = 0; j < 4; ++j) { const float v = (s[i][t][j] * sc2 + rrow[dco[t][j]]) + madd[t][j]; s[i][t][j] = v; mx = fmaxf(mx, v); } }
        mx = fmaxf(mx, __shfl_xor(mx, 16)); mx = fmaxf(mx, __shfl_xor(mx, 32));
        float sum = 0.f;
#pragma unroll
        for (int i = 0; i < 8; ++i)
#pragma unroll
            for (int t = 0; t < 2; ++t)
#pragma unroll
                for (int j = 0; j < 4; ++j) { const float e = __builtin_amdgcn_exp2f(s[i][t][j] - mx); s[i][t][j] = e; sum += e; }
        sum += __shfl_xor(sum, 16); sum += __shfl_xor(sum, 32);
        const float inv = 1.0f / sum;
        f32x4 o[4];
#pragma unroll
        for (int nb = 0; nb < 4; ++nb) o[nb] = (f32x4){0.f, 0.f, 0.f, 0.f};
        const int vc = (kc0 >> 3) + fq;
#pragma unroll
        for (int i = 0; i < 8; ++i) {
            u32x4 pw; pw.x = cvt_pk_bf16(s[i][0][0], s[i][0][1]); pw.y = cvt_pk_bf16(s[i][0][2], s[i][0][3]); pw.z = cvt_pk_bf16(s[i][1][0], s[i][1][1]); pw.w = cvt_pk_bf16(s[i][1][2], s[i][1][3]);
            const bf16x8 pf = __builtin_bit_cast(bf16x8, pw);
#pragma unroll
            for (int nb = 0; nb < 4; ++nb) { const int d = nb * 16 + fr; const bf16x8 va = *(const LAS bf16x8*)(Vs + (j0 + i) * 8192 + d * 128 + ((vc ^ ((d >> 1) & 7)) << 4));
                o[nb] = __builtin_amdgcn_mfma_f32_16x16x32_bf16(va, pf, o[nb], 0, 0, 0); } }
        float q2 = 0.f;
#pragma unroll
        for (int nb = 0; nb < 4; ++nb) { o[nb] = o[nb] * inv; q2 += (o[nb][0] * o[nb][0] + o[nb][1] * o[nb][1]) + (o[nb][2] * o[nb][2] + o[nb][3] * o[nb][3]); }
        q2 += __shfl_xor(q2, 16); q2 += __shfl_xor(q2, 32);
        if (fq == 0) SSQNA[(size_t)tq * 8 + h] = q2;
        bf16_t* op = YCAT + (size_t)tq * DM + 512 + h * 64 + 4 * fq;
#pragma unroll
        for (int nb = 0; nb < 4; ++nb) { u32x2 wv; wv.x = cvt_pk_bf16(o[nb][0], o[nb][1]); wv.y = cvt_pk_bf16(o[nb][2], o[nb][3]); *(u32x2*)(op + nb * 16) = wv; }
    }
    __syncthreads();
}

constexpr int N_PHASES = 11;
__global__ void __launch_bounds__(NTHREADS, 2) fwd_megakernel(Params p) {
    extern __shared__ __attribute__((aligned(16))) unsigned char lds_raw[];
    LAS unsigned char* lds = (LAS unsigned char*)lds_raw;
    volatile LAS unsigned* bst = (volatile LAS unsigned*)(lds + LDS_BYTES - 16);
    const int lo = p.ph_lo, hi = p.ph_hi, G = gridDim.x, cid = blockIdx.x;
    if (threadIdx.x < 4) bst[threadIdx.x] = 0u;
    __syncthreads();
    XcdBarrier bar; bar.bar = (unsigned*)(p.ws + WS_BAR); bar.x = 0; bar.st = bst;
    if (!MK_PER_PHASE) bar = xcd_barrier_post((unsigned*)(p.ws + WS_BAR), bst);
    if (lo < 0) cg::this_grid().sync();
#define IN(k) (lo <= (k) && (k) < hi)
#define REP(k) for (int rep_ = 0; rep_ < 1 + ((REPEAT_MASK >> (k)) & 1); ++rep_)
#define SEAM(k) do { if (IN(k) && IN((k) + 1)) xcd_barrier(bar); } while (0)
    unsigned char* ws = p.ws;
    const float* mod = (const float*)(ws + WS_MOD);

    if (IN(0)) REP(0) p0_prologue(p, lds);
    if (IN(0) && IN(1)) {
        if (threadIdx.x < 64) { unsigned sp = 0; unsigned* mc = (unsigned*)(ws + WS_BAR) + 3712;
            while ((unsigned)__builtin_amdgcn_readfirstlane(__hip_atomic_load(mc, __ATOMIC_RELAXED, __HIP_MEMORY_SCOPE_AGENT)) < (G == 256 ? 128u : 96u)) { __builtin_amdgcn_s_sleep(2); if (++sp > (1u << 22)) break; }
            __builtin_amdgcn_fence(__ATOMIC_ACQUIRE, "agent");
            asm volatile("s_waitcnt vmcnt(0)" ::: "memory"); }
        __syncthreads();
    }
    if (IN(1)) REP(1) pass_h_fold(p.x, p.g_mix, mod, (bf16_t*)(ws + WS_H), (bf16_t*)(ws + WS_HE), (bf16_t*)(ws + WS_HO));
    SEAM(1);
    if (IN(2)) { SchedP2 S{(const char*)(ws + WS_H), (const char*)(ws + WS_HE), (const char*)(ws + WS_HO), (const char*)(ws + WS_WQK), (const char*)(ws + WS_WA), (char*)(ws + WS_QK), (char*)(ws + WS_VT), (char*)(ws + WS_VTA), (float*)(ws + WS_SSQ2 + 512 * 1024), G, cid};
        pg8::EpiTileBf16 E; pg8::gemm_phase(lds, DM, S, E);
        late_work(p, lds, cid, G, 4); }
    SEAM(2);
    if (IN(3)) { pass_xmid((const bf16_t*)(ws + WS_H), (const bf16_t*)(ws + WS_WA), (float*)(ws + WS_SSQ2 + 256 * 1024));
        SchedFourier S{(const char*)(ws + WS_CS), (const char*)(ws + WS_VT), (char*)(ws + WS_PQ), G, cid};
        pg8::EpiTileBf16 E; pg8::gemm_phase(lds, 1024, S, E);
        if (G == 256) { if (cid >= 128) late_work(p, lds, cid - 128, 128, 1); } else late_work(p, lds, cid, G, 1);
        attn_phase(p, lds); }
    SEAM(3);
    if (IN(4)) REP(4) pass_combine((const bf16_t*)(ws + WS_PQ), (const float*)(ws + WS_SSQ2 + 512 * 1024), (const float*)(ws + WS_SSQ2 + 256 * 1024), (const float*)(ws + WS_SSQ1 + 512 * 1024), (bf16_t*)(ws + WS_YCAT));
    SEAM(4);
    const bool fuse = (G == 256);
    if (IN(5)) { SchedPlain S{(const char*)(ws + WS_YCAT), (const char*)(ws + WS_WOUT), 64, 4, DM, G, cid};
        if (fuse) { pg8::EpiResidNormMod E{p.x, p.out, mod, 2 * DM, 3 * DM, 4 * DM, p.g_ffn, (bf16_t*)(ws + WS_H), pg8::PanelSsq{(float*)(ws + WS_SSQ1), (unsigned*)(ws + WS_BAR + 16384)}}; pg8::gemm_phase(lds, DM, S, E); }
        else { pg8::EpiResid E{p.x, p.out, mod + 2 * DM, (float*)(ws + WS_SSQ1)}; pg8::gemm_phase(lds, DM, S, E); } }
    if (!fuse) SEAM(5);
    if (IN(6) && !fuse) pass_norm_mod(p.out, (const float*)(ws + WS_SSQ1), p.g_ffn, mod, 3 * DM, 4 * DM, (bf16_t*)(ws + WS_H));
    if (fuse) { if (IN(5) && IN(7)) xcd_barrier(bar); } else SEAM(6);
    if (IN(7)) REP(7) { SchedPlain S{(const char*)(ws + WS_H), (const char*)(ws + WS_WUP), 64, 22, DM, G, cid};
        pg8::EpiUp E{(bf16_t*)(ws + WS_A), (bf16_t*)(ws + WS_SIDE), p.conv_w, p.conv_b}; pg8::gemm_phase(lds, DM, S, E);
        if (G == 256) { if (cid >= 128) late_work(p, lds, cid - 128, 128, 2); } else late_work(p, lds, cid, G, 2); }
    SEAM(7);
    if (IN(8)) REP(8) pass_fixup((const bf16_t*)(ws + WS_SIDE), p.conv_w, p.conv_b, (bf16_t*)(ws + WS_A));
    SEAM(8);
    if (REPEAT_MASK & (1 << 20)) { for (int e_ = 0; e_ < 8; ++e_) xcd_barrier(bar); }
    if (IN(9)) { SchedPlain S{(const char*)(ws + WS_A), (const char*)(ws + WS_WDN), 64, 4, DFF, G, cid};
        if (fuse) { pg8::EpiResidNormOut E{p.out, mod, 5 * DM, p.g_final, pg8::PanelSsq{(float*)(ws + WS_SSQ2), (unsigned*)(ws + WS_BAR + 32768)}}; pg8::gemm_phase(lds, DFF, S, E); }
        else { pg8::EpiResid E{p.out, p.out, mod + 5 * DM, (float*)(ws + WS_SSQ2)}; pg8::gemm_phase(lds, DFF, S, E); } }
    if (!fuse) SEAM(9);
    if (IN(10) && !fuse) pass_final(p.out, (const float*)(ws + WS_SSQ2), p.g_final);
#undef IN
#undef SEAM
}

extern "C" void kernel_launch(void* const* d_in, const int* in_sizes, int n_in, void* d_out, int out_size, void* d_ws, size_t ws_size, hipStream_t stream) {
    static int grid = 0;
    if (grid == 0) {
        int dev = 0, cus = 0, per_cu = 0;
        if (n_in != 17 || ws_size < WS_END) { fprintf(stderr, "kernel_launch: unexpected inputs (n_in %d, ws %zu)\n", n_in, ws_size); grid = -1; return; }
        hipGetDevice(&dev);
        hipDeviceGetAttribute(&cus, hipDeviceAttributeMultiprocessorCount, dev);
        if (hipFuncSetAttribute((const void*)fwd_megakernel, hipFuncAttributeMaxDynamicSharedMemorySize, LDS_BYTES) != hipSuccess) { fprintf(stderr, "kernel_launch: hipFuncSetAttribute failed\n"); grid = -1; return; }
        hipOccupancyMaxActiveBlocksPerMultiprocessor(&per_cu, (const void*)fwd_megakernel, NTHREADS, LDS_BYTES);
        if (per_cu < 1) { fprintf(stderr, "kernel_launch: occupancy query says %d blocks per CU\n", per_cu); per_cu = 1; }
        (void)hipGetLastError();
        grid = cus;
    }
    if (grid < 0) return;
    Params p{};
    const float** f = (const float**)&p;
    for (int i = 0; i < 17; ++i) f[i] = (const float*)d_in[i];
    p.out = (float*)d_out; p.ws = (unsigned char*)d_ws;
    hipMemsetAsync((char*)d_ws + WS_BAR, 0, 49152, stream);
#if MK_PER_PHASE
    for (int ph = 0; ph < N_PHASES; ++ph) { p.ph_lo = ph; p.ph_hi = ph + 1; hipLaunchKernelGGL(fwd_megakernel, dim3(grid), dim3(NTHREADS), LDS_BYTES, stream, p); }
#else
    p.ph_lo = 0; p.ph_hi = N_PHASES;
    void* args[] = {&p};
    hipError_t e = hipLaunchCooperativeKernel((const void*)fwd_megakernel, dim3(grid), dim3(NTHREADS), args, LDS_BYTES, stream);
    if (e != hipSuccess) fprintf(stderr, "cooperative launch failed: %s (grid %d)\n", hipGetErrorString(e), grid);
#endif
}
```

```cpp
#include <hip/hip_runtime.h>
#include <hip/hip_cooperative_groups.h>
#include <cstdio>
namespace cg = cooperative_groups;

#ifndef REPEAT_MASK
#define REPEAT_MASK 0
#endif
#ifndef MK_PER_PHASE
#define MK_PER_PHASE 0
#endif

#define LAS __attribute__((address_space(3)))
typedef unsigned short bf16_t;
typedef short bf16x8 __attribute__((ext_vector_type(8)));
typedef float f32x4 __attribute__((ext_vector_type(4)));
typedef float f32x2 __attribute__((ext_vector_type(2)));
typedef unsigned u32x4 __attribute__((ext_vector_type(4)));
typedef unsigned u32x2 __attribute__((ext_vector_type(2)));

constexpr int DM = 1024, NBATCH = 8, SEQ = 2048, NTOK = NBATCH * SEQ, DFF = 2816, NMOD = 6 * DM;
constexpr float EPS = 1e-6f;
constexpr int NTHREADS = 512, NWAVES = 8;
constexpr int LDS_STAGE = 131072, LDS_EXTRA = 20480, LDS_BYTES = LDS_STAGE + LDS_EXTRA;

constexpr size_t MiB = 1u << 20;
constexpr size_t WS_MOD = 0;
constexpr size_t WS_BAR = 512 * 1024;
constexpr size_t WS_SSQ1 = 1 * MiB;
constexpr size_t WS_SSQ2 = 2 * MiB;
constexpr size_t WS_WQK = 3 * MiB;
constexpr size_t WS_WA = 5 * MiB;
constexpr size_t WS_WOUT = 8 * MiB;
constexpr size_t WS_WUP = 10 * MiB;
constexpr size_t WS_WDN = 21 * MiB;
constexpr size_t WS_CS = 27 * MiB;
constexpr size_t WS_H = 43 * MiB;
constexpr size_t WS_VT = 75 * MiB;
constexpr size_t WS_QK = 107 * MiB;
constexpr size_t WS_VTA = 139 * MiB;
constexpr size_t WS_PQ = 155 * MiB;
constexpr size_t WS_YCAT = 187 * MiB;
constexpr size_t WS_A = 75 * MiB;
constexpr size_t WS_SIDE = 163 * MiB;
constexpr size_t WS_HE = 220 * MiB;
constexpr size_t WS_HO = 236 * MiB;
constexpr size_t WS_END = 252 * MiB;

struct Params {
    const float *x, *c, *w_ada, *b_ada, *g_mix, *w_in, *w_four, *rpb, *g_four_out, *g_na_out, *w_out, *g_ffn, *w_up, *conv_w, *conv_b, *w_down, *g_final;
    float* out; unsigned char* ws;
    int ph_lo, ph_hi;
};

__device__ __forceinline__ unsigned cvt_pk_bf16(float lo, float hi) { unsigned r; asm volatile("v_cvt_pk_bf16_f32 %0, %1, %2" : "=v"(r) : "v"(lo), "v"(hi)); return r; }
__device__ __forceinline__ float bf_lo(unsigned w) { return __uint_as_float(w << 16); }
__device__ __forceinline__ float bf_hi(unsigned w) { return __uint_as_float(w & 0xffff0000u); }
__device__ __forceinline__ float wave_sum(float v) {
#pragma unroll
    for (int o = 1; o < 64; o <<= 1) v += __shfl_xor(v, o);
    return v;
}
__device__ __forceinline__ float silu_f(float v) { return v * __builtin_amdgcn_rcpf(1.0f + __expf(-v)); }
template <int CTRL> __device__ __forceinline__ float dpp_f(float v) {
    return __builtin_bit_cast(float, __builtin_amdgcn_mov_dpp(__builtin_bit_cast(int, v), CTRL, 0xF, 0xF, true));
}

#define XB_TMO      128
#define XB_XCNT(j)  (256  + 64 * (j))
#define XB_XSUB(j)  (1280 + 64 * (j))
#define XB_XGEN(j)  (2304 + 64 * (j))
#define XB_TOP      3328
#define XB_TOPGEN   3392
#define XCD_BAR_WORDS 3456
#define XB_SPIN_CAP (1u << 20)
__device__ __forceinline__ unsigned xb_ld(unsigned* p)              { return __hip_atomic_load(p, __ATOMIC_RELAXED, __HIP_MEMORY_SCOPE_AGENT); }
__device__ __forceinline__ unsigned xb_add(unsigned* p, unsigned v) { return __hip_atomic_fetch_add(p, v, __ATOMIC_RELAXED, __HIP_MEMORY_SCOPE_AGENT); }
__device__ __forceinline__ unsigned xb_xcc_id() { return (unsigned)__builtin_amdgcn_s_getreg((3 << 11) | 20) & 0xFu; }
#define XB_SPIN(cond, bar) do { unsigned _sp = 0; while (cond) { __builtin_amdgcn_s_sleep(1); \
    if ((++_sp & 255u) == 0u) { if (xb_ld(&(bar)[XB_TMO])) break; if (_sp > XB_SPIN_CAP) { atomicAdd(&(bar)[XB_TMO], 1u); break; } } } } while (0)
struct XcdBarrier { unsigned* bar; unsigned x; volatile LAS unsigned* st; };
__device__ __forceinline__ XcdBarrier xcd_barrier_post(unsigned* bar, volatile LAS unsigned* st) {
    XcdBarrier b; b.bar = bar; b.x = xb_xcc_id(); b.st = st;
    if (threadIdx.x == 0) (void)xb_add(&bar[XB_XCNT(b.x)], 1u);
    return b;
}
__device__ __forceinline__ void xcd_barrier_complete(unsigned* bar, unsigned x, unsigned& nloc, unsigned& nx) {
    const unsigned G = gridDim.x * gridDim.y * gridDim.z;
    unsigned sum, cnt, mine, sp = 0u;
    for (;;) {
        sum = 0u; cnt = 0u; mine = 0u;
#pragma unroll
        for (unsigned j = 0; j < 16; ++j) { const unsigned c = xb_ld(&bar[XB_XCNT(j)]); sum += c; cnt += (c > 0u) ? 1u : 0u; mine = (j == x) ? c : mine; }
        if (sum == G) break;
        __builtin_amdgcn_s_sleep(1);
        if ((++sp & 255u) == 0u) { if (xb_ld(&bar[XB_TMO])) break; if (sp > XB_SPIN_CAP) { atomicAdd(&bar[XB_TMO], 1u); break; } }
    }
    nloc = mine > 0u ? mine : 1u; nx = cnt > 0u ? cnt : 1u;
}
__device__ __forceinline__ void xcd_barrier(const XcdBarrier& b) {
    asm volatile("s_waitcnt vmcnt(0)" ::: "memory");
    __syncthreads();
    if (threadIdx.x == 0) {
        unsigned* bar = b.bar;
        __builtin_amdgcn_s_waitcnt(0);
        unsigned nloc = b.st[0], nx = b.st[1];
        if (nloc == 0u) { xcd_barrier_complete(bar, b.x, nloc, nx); b.st[0] = nloc; b.st[1] = nx; }
        const unsigned old = xb_add(&bar[XB_XSUB(b.x)], 1u);
        const unsigned gen = old / nloc;
        if (old + 1u == (gen + 1u) * nloc) {
            __builtin_amdgcn_fence(__ATOMIC_RELEASE, "agent");
            asm volatile("s_waitcnt vmcnt(0)" ::: "memory");
            const unsigned og = xb_add(&bar[XB_TOP], 1u);
            const unsigned tg = og / nx;
            if (og + 1u == (tg + 1u) * nx) xb_add(&bar[XB_TOPGEN], 1u);
            else XB_SPIN(xb_ld(&bar[XB_TOPGEN]) == tg, bar);
            __builtin_amdgcn_fence(__ATOMIC_ACQUIRE, "agent");
            xb_add(&bar[XB_XGEN(b.x)], 1u);
            asm volatile("s_waitcnt vmcnt(0)" ::: "memory");
        } else {
            XB_SPIN(xb_ld(&bar[XB_XGEN(b.x)]) == gen, bar);
            __builtin_amdgcn_fence(__ATOMIC_ACQUIRE, "agent");
            asm volatile("s_waitcnt vmcnt(0)" ::: "memory");
        }
    }
    __syncthreads();
}

namespace pg8 {
constexpr int BM = 256, BK = 64, HALF = 128, HTB = HALF * BK * 2, NXCD = 8, WGM = 8;
__device__ __forceinline__ int lds_byte(int r, int c) { const int st = (r >> 4) * 2 + (c >> 5), rr = r & 15, cc = c & 31, ob = rr * 64 + cc * 2; return st * 1024 + (ob ^ (((ob >> 9) & 1) << 5)); }
__device__ __forceinline__ void stage_rc(int b, int& R, int& C) { const int st = b / 1024, sb = b % 1024, swz = sb ^ (((sb >> 9) & 1) << 5); R = (st >> 1) * 16 + swz / 64; C = (st & 1) * 32 + (swz % 64) / 2; }
__device__ __forceinline__ int perm32(int rho) { const int n = rho >> 4, i = rho & 15; return 8 * (i >> 2) + 4 * n + (i & 3); }

struct Unit { const char* pa; const char* pb; char* po; float* sp; int rp, RS, CS; int pm, pn; };

__device__ __forceinline__ void tile_map(int wgid, int nM, int nN, int& pm, int& pn) {
    const int nwg = nM * nN;
    { const int q = nwg / NXCD, r = nwg % NXCD, xcd = wgid % NXCD, off = wgid / NXCD; wgid = (xcd < r ? xcd * (q + 1) : r * (q + 1) + (xcd - r) * q) + off; }
    const int nig = WGM * nN, gid = wgid / nig, fm = gid * WGM, gsz = (nM - fm) < WGM ? (nM - fm) : WGM;
    pm = fm + ((wgid % nig) % gsz); pn = (wgid % nig) / gsz;
}

template <class Epi, class Sched>
__device__ __forceinline__ void gemm_phase(LAS unsigned char* lds, const int K, const Sched& S, const Epi& E) {
    const int tid = threadIdx.x, wid = __builtin_amdgcn_readfirstlane(tid >> 6), lane = tid & 63, wr = wid >> 2, wc = wid & 3, fr = lane & 15, fq = lane >> 4;
    const int nt = K / BK;
    unsigned voffA[2], voffB[2];
#pragma unroll
    for (int i = 0; i < 2; ++i) { int R, C; stage_rc(tid * 16 + i * 8192, R, C); const int Rb = Epi::PERM ? ((R & ~31) + perm32(R & 31)) : R;
        voffA[i] = (unsigned)(R * K + C) * 2u; voffB[i] = (unsigned)(Rb * K + C) * 2u; }
    const size_t kstep = (size_t)(BK * 2);
    const size_t hstep = (size_t)HALF * K * 2;
    const unsigned ldsw = (unsigned)wid * 1024u;
    const int aoff = lds_byte(wr * 64 + fr, fq * 8), boff = lds_byte(wc * 32 + fr, fq * 8);
#define PG8_SA(b, h) (((b) * 2 + (h)) * HTB)
#define PG8_SB(b, h) ((4 + (b) * 2 + (h)) * HTB)
#define PG8_STAGE(bufoff, gbase, voff) do { _Pragma("unroll") for (int _i = 0; _i < 2; ++_i) \
        __builtin_amdgcn_global_load_lds((const unsigned*)((const char*)(gbase) + (voff)[_i]), (LAS unsigned*)(lds + (bufoff) + ldsw + _i * 8192), 16, 0, 0); } while (0)
#define PG8_LDA(dst, b, h) do { _Pragma("unroll") for (int m = 0; m < 4; ++m) _Pragma("unroll") for (int k = 0; k < 2; ++k) dst[m][k] = *(const LAS bf16x8*)(lds + PG8_SA(b, h) + aoff + m * 2048 + k * 1024); } while (0)
#define PG8_LDB(dst, b, h) do { _Pragma("unroll") for (int n = 0; n < 2; ++n) _Pragma("unroll") for (int k = 0; k < 2; ++k) dst[n][k] = *(const LAS bf16x8*)(lds + PG8_SB(b, h) + boff + n * 2048 + k * 1024); } while (0)
#define PG8_MMA(ai, bj, At, Bt) do { __builtin_amdgcn_s_setprio(1); _Pragma("unroll") for (int m = 0; m < 4; ++m) _Pragma("unroll") for (int n = 0; n < 2; ++n) _Pragma("unroll") for (int k = 0; k < 2; ++k) \
        acc[ai][bj][m][n] = __builtin_amdgcn_mfma_f32_16x16x32_bf16(Bt[n][k], At[m][k], acc[ai][bj][m][n], 0, 0, 0); __builtin_amdgcn_s_setprio(0); } while (0)
#define PG8_WAIT_V(n) asm volatile("s_waitcnt vmcnt(" #n ")" ::: "memory")
#define PG8_WAIT_L(n) asm volatile("s_waitcnt lgkmcnt(" #n ")" ::: "memory")
#define PG8_BAR __builtin_amdgcn_s_barrier()
#define PG8_SCHED __builtin_amdgcn_sched_barrier(0)
    Unit cur, nxt; int ui = 0;
    if (!S.next(0, cur)) return;
    f32x4 acc[2][2][4][2];
#pragma unroll
    for (int a = 0; a < 2; ++a)
#pragma unroll
        for (int b = 0; b < 2; ++b)
#pragma unroll
            for (int m = 0; m < 4; ++m)
#pragma unroll
                for (int n = 0; n < 2; ++n) acc[a][b][m][n] = (f32x4){0.f, 0.f, 0.f, 0.f};
    bf16x8 At[4][2], B0[2][2], B1[2][2];
    const char* cA = cur.pa; const char* cB = cur.pb;
    PG8_STAGE(PG8_SB(0, 0), cB, voffB); PG8_STAGE(PG8_SA(0, 0), cA, voffA); PG8_STAGE(PG8_SB(0, 1), cB + hstep, voffB); PG8_STAGE(PG8_SA(0, 1), cA + hstep, voffA);
    if (wr == 1) PG8_BAR;
    PG8_WAIT_V(4); PG8_BAR;
    PG8_STAGE(PG8_SB(1, 0), cB + kstep, voffB); PG8_STAGE(PG8_SA(1, 0), cA + kstep, voffA); PG8_STAGE(PG8_SB(1, 1), cB + hstep + kstep, voffB);
    PG8_WAIT_V(6); PG8_BAR;
    for (;;) {
        const bool has_next = S.next(ui + 1, nxt);
        const char* nA = has_next ? nxt.pa : cA; const char* nB = has_next ? nxt.pb : cB;
        for (int t = 0; t < nt; t += 2) {
            const bool last = (t == nt - 2);
            const char* a1 = cA + (size_t)(t + 1) * kstep;
            const char* a2 = last ? nA : cA + (size_t)(t + 2) * kstep; const char* b2 = last ? nB : cB + (size_t)(t + 2) * kstep;
            const char* a3 = a2 + kstep; const char* b3 = b2 + kstep;
            PG8_LDB(B0, 0, 0); PG8_SCHED; PG8_LDA(At, 0, 0); PG8_STAGE(PG8_SA(1, 1), a1 + hstep, voffA);
            PG8_WAIT_L(8); PG8_BAR; PG8_WAIT_L(0); PG8_MMA(0, 0, At, B0); PG8_BAR; PG8_SCHED;
            PG8_LDB(B1, 0, 1); PG8_STAGE(PG8_SB(0, 0), b2, voffB);
            PG8_BAR; PG8_WAIT_L(0); PG8_MMA(0, 1, At, B1); PG8_BAR;
            PG8_LDA(At, 0, 1); PG8_STAGE(PG8_SA(0, 0), a2, voffA);
            PG8_BAR; PG8_WAIT_L(0); PG8_MMA(1, 0, At, B0); PG8_BAR; PG8_SCHED;
            PG8_STAGE(PG8_SB(0, 1), b2 + hstep, voffB);
            PG8_WAIT_V(6); PG8_BAR; PG8_MMA(1, 1, At, B1); PG8_BAR;
            PG8_LDB(B0, 1, 0); PG8_SCHED; PG8_LDA(At, 1, 0); PG8_STAGE(PG8_SA(0, 1), a2 + hstep, voffA);
            PG8_WAIT_L(8); PG8_BAR; PG8_WAIT_L(0); PG8_MMA(0, 0, At, B0); PG8_BAR; PG8_SCHED;
            PG8_LDB(B1, 1, 1); PG8_STAGE(PG8_SB(1, 0), b3, voffB);
            PG8_BAR; PG8_WAIT_L(0); PG8_MMA(0, 1, At, B1); PG8_BAR;
            PG8_LDA(At, 1, 1); PG8_STAGE(PG8_SA(1, 0), a3, voffA);
            PG8_BAR; PG8_WAIT_L(0); PG8_MMA(1, 0, At, B0); PG8_BAR; PG8_SCHED;
            PG8_STAGE(PG8_SB(1, 1), b3 + hstep, voffB);
            PG8_WAIT_V(6); PG8_BAR; PG8_MMA(1, 1, At, B1); PG8_BAR;
        }
        if constexpr (!Epi::AFTER_DRAIN) E(acc, cur, wr, wc, fr, fq);
        if (!has_next) break;
#pragma unroll
        for (int a = 0; a < 2; ++a)
#pragma unroll
            for (int b = 0; b < 2; ++b)
#pragma unroll
                for (int m = 0; m < 4; ++m)
#pragma unroll
                    for (int n = 0; n < 2; ++n) acc[a][b][m][n] = (f32x4){0.f, 0.f, 0.f, 0.f};
        cur = nxt; cA = nA; cB = nB; ++ui;
    }
    PG8_WAIT_V(0);
    if (wr == 0) PG8_BAR;
    PG8_BAR;
    if constexpr (Epi::AFTER_DRAIN) E.fused(acc, cur, wr, wc, fr, fq, lds, wid, lane);
#undef PG8_SA
#undef PG8_SB
#undef PG8_STAGE
#undef PG8_LDA
#undef PG8_LDB
#undef PG8_MMA
#undef PG8_WAIT_V
#undef PG8_WAIT_L
#undef PG8_BAR
#undef PG8_SCHED
}

struct EpiTileBf16 {
    static constexpr bool PERM = true, AFTER_DRAIN = false;
    __device__ __forceinline__ void operator()(const f32x4 (&acc)[2][2][4][2], const Unit& u, int wr, int wc, int fr, int fq) const {
        bf16_t* base = (bf16_t*)u.po + (size_t)wr * u.RS + (size_t)fr * u.rp + (size_t)(wc >> 1) * u.CS + (wc & 1) * 32 + 8 * fq;
#pragma unroll
        for (int ai = 0; ai < 2; ++ai)
#pragma unroll
            for (int m = 0; m < 4; ++m) { bf16_t* rowp = base + (size_t)(2 * ai) * u.RS + (size_t)(m * 16) * u.rp;
#pragma unroll
                for (int bj = 0; bj < 2; ++bj) { const f32x4 v0 = acc[ai][bj][m][0], v1 = acc[ai][bj][m][1];
                    u32x4 w; w.x = cvt_pk_bf16(v0[0], v0[1]); w.y = cvt_pk_bf16(v0[2], v0[3]); w.z = cvt_pk_bf16(v1[0], v1[1]); w.w = cvt_pk_bf16(v1[2], v1[3]);
                    *(u32x4*)(rowp + (size_t)(2 * bj) * u.CS) = w; } }
        if (u.sp) {
#pragma unroll
            for (int ai = 0; ai < 2; ++ai)
#pragma unroll
                for (int m = 0; m < 4; ++m) { float s = 0.f;
#pragma unroll
                    for (int bj = 0; bj < 2; ++bj)
#pragma unroll
                        for (int n = 0; n < 2; ++n) { const f32x4 v = acc[ai][bj][m][n]; s += (v[0] - v[1]) + (v[2] - v[3]); }
                    s += __shfl_xor(s, 16); s += __shfl_xor(s, 32);
                    if (fq == 0) u.sp[(size_t)(ai * HALF + wr * 64 + m * 16 + fr) * 32 + wc] = s; }
        }
    }
};
struct EpiResid {
    static constexpr bool PERM = false, AFTER_DRAIN = false;
    const float* base; float* out; const float* gate; float* ssq;
    __device__ __forceinline__ void operator()(const f32x4 (&acc)[2][2][4][2], const Unit& u, int wr, int wc, int fr, int fq) const {
        const int row0 = u.pm * BM + wr * 64 + fr, col0 = u.pn * BM + wc * 32 + 4 * fq, b = u.pm >> 3;
        f32x4 gv[2][2];
#pragma unroll
        for (int bj = 0; bj < 2; ++bj)
#pragma unroll
            for (int n = 0; n < 2; ++n) gv[bj][n] = *(const f32x4*)(gate + (size_t)b * NMOD + col0 + bj * HALF + n * 16);
#pragma unroll
        for (int ai = 0; ai < 2; ++ai)
#pragma unroll
            for (int m = 0; m < 4; ++m) { const int row = row0 + ai * HALF + m * 16; const size_t off = (size_t)row * DM + col0; float s = 0.f;
#pragma unroll
                for (int bj = 0; bj < 2; ++bj)
#pragma unroll
                    for (int n = 0; n < 2; ++n) { const f32x4 xv = *(const f32x4*)(base + off + bj * HALF + n * 16); const f32x4 o = xv + gv[bj][n] * acc[ai][bj][m][n];
                        *(f32x4*)(out + off + bj * HALF + n * 16) = o; s += (o[0] * o[0] + o[1] * o[1]) + (o[2] * o[2] + o[3] * o[3]); }
                s += __shfl_xor(s, 16); s += __shfl_xor(s, 32);
                if (fq == 0) ssq[(size_t)row * 16 + u.pn * 4 + wc] = s; }
    }
};
struct EpiUp {
    static constexpr bool PERM = true, AFTER_DRAIN = false;
    bf16_t* A; bf16_t* side; const float* cw; const float* cb;
    __device__ __forceinline__ void operator()(f32x4 (&acc)[2][2][4][2], const Unit& u, int wr, int wc, int fr, int fq) const {
        const int J0 = u.pn * 128 + wc * 32 + fq * 8;
        if (fr < 2 || fr >= 14) {
            const int slot = fr < 2 ? fr : fr - 12;
#pragma unroll
            for (int ai = 0; ai < 2; ++ai) { const int chunk = u.pm * 4 + ai * 2 + wr;
#pragma unroll
                for (int bj = 0; bj < 2; ++bj) { const f32x4 a0 = fr < 2 ? acc[ai][bj][0][0] : acc[ai][bj][3][0], a1 = fr < 2 ? acc[ai][bj][0][1] : acc[ai][bj][3][1];
                    u32x4 w; w.x = cvt_pk_bf16(a0[0], a0[1]); w.y = cvt_pk_bf16(a0[2], a0[3]); w.z = cvt_pk_bf16(a1[0], a1[1]); w.w = cvt_pk_bf16(a1[2], a1[3]);
                    *(u32x4*)(side + (size_t)(chunk * 4 + slot) * (2 * DFF) + bj * DFF + J0) = w; } }
        }
        const bool f0 = (fr == 0), f15 = (fr == 15);
#pragma unroll
        for (int bj = 0; bj < 2; ++bj)
#pragma unroll
            for (int n = 0; n < 2; ++n) {
                const int col = bj * DFF + J0 + n * 4;
                const f32x4 k0 = *(const f32x4*)(cw + col), k1 = *(const f32x4*)(cw + 2 * DFF + col), k2 = *(const f32x4*)(cw + 4 * DFF + col), kb = *(const f32x4*)(cb + col);
#pragma unroll
                for (int ai = 0; ai < 2; ++ai) {
                    const f32x4 c0 = acc[ai][bj][0][n], c1 = acc[ai][bj][1][n], c2 = acc[ai][bj][2][n], c3 = acc[ai][bj][3][n];
                    f32x4 o0, o1, o2, o3;
#pragma unroll
                    for (int j = 0; j < 4; ++j) {
                        const float r0 = dpp_f<0x121>(c0[j]), r1 = dpp_f<0x121>(c1[j]), r2 = dpp_f<0x121>(c2[j]), r3 = dpp_f<0x121>(c3[j]);
                        const float l0 = dpp_f<0x12F>(c0[j]), l1 = dpp_f<0x12F>(c1[j]), l2 = dpp_f<0x12F>(c2[j]), l3 = dpp_f<0x12F>(c3[j]);
                        o0[j] = k0[j] * r0 + k1[j] * c0[j] + k2[j] * (f15 ? l1 : l0) + kb[j];
                        o1[j] = k0[j] * (f0 ? r0 : r1) + k1[j] * c1[j] + k2[j] * (f15 ? l2 : l1) + kb[j];
                        o2[j] = k0[j] * (f0 ? r1 : r2) + k1[j] * c2[j] + k2[j] * (f15 ? l3 : l2) + kb[j];
                        o3[j] = k0[j] * (f0 ? r2 : r3) + k1[j] * c3[j] + k2[j] * l3 + kb[j];
                    }
                    asm volatile("" : "+v"(o0), "+v"(o1), "+v"(o2), "+v"(o3));
                    acc[ai][bj][0][n] = o0; acc[ai][bj][1][n] = o1; acc[ai][bj][2][n] = o2; acc[ai][bj][3][n] = o3;
                }
            }
#pragma unroll
        for (int ai = 0; ai < 2; ++ai) { const int chunk = u.pm * 4 + ai * 2 + wr;
#pragma unroll
            for (int m = 0; m < 4; ++m) {
                const f32x4 g0 = acc[ai][0][m][0], g1 = acc[ai][0][m][1], v0 = acc[ai][1][m][0], v1 = acc[ai][1][m][1];
                u32x4 w; w.x = cvt_pk_bf16(silu_f(g0[0]) * v0[0], silu_f(g0[1]) * v0[1]); w.y = cvt_pk_bf16(silu_f(g0[2]) * v0[2], silu_f(g0[3]) * v0[3]);
                w.z = cvt_pk_bf16(silu_f(g1[0]) * v1[0], silu_f(g1[1]) * v1[1]); w.w = cvt_pk_bf16(silu_f(g1[2]) * v1[2], silu_f(g1[3]) * v1[3]);
                const bool valid = !((m == 0 && f0) || (m == 3 && f15));
                if (valid) *(u32x4*)(A + (size_t)(chunk * 64 + m * 16 + fr) * DFF + J0) = w;
            } }
    }
};
struct PanelSsq {
    float* xbuf; unsigned* cnt;
    __device__ __forceinline__ void run(const f32x4 (&v)[2][2][4][2], const Unit& u, int wr, int wc, int fr, int fq, LAS unsigned char* lds, int wid, int lane) const {
        LAS float* P = (LAS float*)lds; LAS float* S = (LAS float*)(lds + 4096);
#pragma unroll
        for (int ai = 0; ai < 2; ++ai)
#pragma unroll
            for (int m = 0; m < 4; ++m) { float s = 0.f;
#pragma unroll
                for (int bj = 0; bj < 2; ++bj)
#pragma unroll
                    for (int n = 0; n < 2; ++n) { const f32x4 x = v[ai][bj][m][n]; s += (x[0] * x[0] + x[1] * x[1]) + (x[2] * x[2] + x[3] * x[3]); }
                s += __shfl_xor(s, 16); s += __shfl_xor(s, 32);
                if (fq == 0) P[(ai * HALF + wr * 64 + m * 16 + fr) * 4 + wc] = s; }
        asm volatile("s_waitcnt lgkmcnt(0)" ::: "memory"); __builtin_amdgcn_s_barrier(); asm volatile("" ::: "memory");
        const int row = wid * 32 + (lane & 31);
        if (lane < 32) { const f32x4 a = *(const LAS f32x4*)(P + row * 4);
            __hip_atomic_store(xbuf + ((size_t)(u.pm * BM + row) * 4 + u.pn), (a[0] + a[1]) + (a[2] + a[3]), __ATOMIC_RELAXED, __HIP_MEMORY_SCOPE_AGENT); }
        asm volatile("s_waitcnt vmcnt(0)" ::: "memory");
        if (lane == 0) __hip_atomic_fetch_add(cnt + 64 * u.pm, 1u, __ATOMIC_RELAXED, __HIP_MEMORY_SCOPE_AGENT);
        if (wid == 0) { unsigned sp = 0;
            while ((unsigned)__builtin_amdgcn_readfirstlane(__hip_atomic_load(cnt + 64 * u.pm, __ATOMIC_RELAXED, __HIP_MEMORY_SCOPE_AGENT)) < 32u) { __builtin_amdgcn_s_sleep(2); if (++sp > (1u << 22)) break; }
            __builtin_amdgcn_fence(__ATOMIC_ACQUIRE, "agent"); }
        asm volatile("s_waitcnt vmcnt(0) lgkmcnt(0)" ::: "memory"); __builtin_amdgcn_s_barrier(); asm volatile("" ::: "memory");
        if (lane < 32) { const float* slot = xbuf + (size_t)(u.pm * BM + row) * 4; float t = 0.f;
#pragma unroll
            for (int k = 0; k < 4; ++k) t += __hip_atomic_load(slot + k, __ATOMIC_RELAXED, __HIP_MEMORY_SCOPE_AGENT);
            S[row] = 1.0f / sqrtf(t * (1.0f / DM) + EPS); }
        asm volatile("s_waitcnt lgkmcnt(0)" ::: "memory"); __builtin_amdgcn_s_barrier(); asm volatile("" ::: "memory");
    }
};
struct EpiResidNormMod {
    static constexpr bool PERM = false, AFTER_DRAIN = true;
    const float* base; bf16_t* x1b; const float* mod; int gate_off, sh_off, sc_off; const float* g; bf16_t* hn; PanelSsq st;
    __device__ __forceinline__ void fused(f32x4 (&acc)[2][2][4][2], const Unit& u, int wr, int wc, int fr, int fq, LAS unsigned char* lds, int wid, int lane) const {
        const int row0 = u.pm * BM + wr * 64 + fr, col0 = u.pn * BM + wc * 32 + 4 * fq, b = u.pm >> 3;
        const float* modb = mod + (size_t)b * NMOD + col0;
        { f32x4 gv[2][2];
#pragma unroll
          for (int bj = 0; bj < 2; ++bj)
#pragma unroll
            for (int n = 0; n < 2; ++n) gv[bj][n] = *(const f32x4*)(modb + gate_off + bj * HALF + n * 16);
#pragma unroll
          for (int ai = 0; ai < 2; ++ai)
#pragma unroll
            for (int m = 0; m < 4; ++m) { const size_t off = (size_t)(row0 + ai * HALF + m * 16) * DM + col0;
#pragma unroll
                for (int bj = 0; bj < 2; ++bj)
#pragma unroll
                    for (int n = 0; n < 2; ++n) { const f32x4 xv = *(const f32x4*)(base + off + bj * HALF + n * 16); const f32x4 o = xv + gv[bj][n] * acc[ai][bj][m][n];
                        u32x2 w; w.x = cvt_pk_bf16(o[0], o[1]); w.y = cvt_pk_bf16(o[2], o[3]); *(u32x2*)(x1b + off + bj * HALF + n * 16) = w; acc[ai][bj][m][n] = o; }
                asm volatile("" ::: "memory"); } }
        st.run(acc, u, wr, wc, fr, fq, lds, wid, lane);
        const LAS float* S = (const LAS float*)(lds + 4096);
#pragma unroll
        for (int bj = 0; bj < 2; ++bj)
#pragma unroll
            for (int n = 0; n < 2; ++n) { const int co = bj * HALF + n * 16;
                const f32x4 gg = *(const f32x4*)(g + col0 + co), sh = *(const f32x4*)(modb + sh_off + co), sc = *(const f32x4*)(modb + sc_off + co);
                const f32x4 mul = gg * (1.0f + sc);
#pragma unroll
                for (int ai = 0; ai < 2; ++ai)
#pragma unroll
                    for (int m = 0; m < 4; ++m) { const int r = ai * HALF + wr * 64 + m * 16 + fr; const float rstd = S[r];
                        const f32x4 h = (acc[ai][bj][m][n] * rstd) * mul + sh;
                        u32x2 w; w.x = cvt_pk_bf16(h[0], h[1]); w.y = cvt_pk_bf16(h[2], h[3]);
                        *(u32x2*)(hn + (size_t)(u.pm * BM + r) * DM + col0 + co) = w; } }
    }
};
struct EpiResidNormOut {
    static constexpr bool PERM = false, AFTER_DRAIN = true;
    const bf16_t* x1b; float* out; const float* mod; int gate_off; const float* g; PanelSsq st;
    __device__ __forceinline__ void fused(f32x4 (&acc)[2][2][4][2], const Unit& u, int wr, int wc, int fr, int fq, LAS unsigned char* lds, int wid, int lane) const {
        const int row0 = u.pm * BM + wr * 64 + fr, col0 = u.pn * BM + wc * 32 + 4 * fq, b = u.pm >> 3;
        const float* modb = mod + (size_t)b * NMOD + col0;
        { f32x4 gv[2][2];
#pragma unroll
          for (int bj = 0; bj < 2; ++bj)
#pragma unroll
            for (int n = 0; n < 2; ++n) gv[bj][n] = *(const f32x4*)(modb + gate_off + bj * HALF + n * 16);
#pragma unroll
          for (int ai = 0; ai < 2; ++ai)
#pragma unroll
            for (int m = 0; m < 4; ++m) { const size_t off = (size_t)(row0 + ai * HALF + m * 16) * DM + col0;
#pragma unroll
                for (int bj = 0; bj < 2; ++bj)
#pragma unroll
                    for (int n = 0; n < 2; ++n) { const u32x2 xw = *(const u32x2*)(x1b + off + bj * HALF + n * 16); const f32x4 xv = (f32x4){bf_lo(xw.x), bf_hi(xw.x), bf_lo(xw.y), bf_hi(xw.y)};
                        acc[ai][bj][m][n] = xv + gv[bj][n] * acc[ai][bj][m][n]; }
                asm volatile("" : "+v"(acc[ai][0][m][0]), "+v"(acc[ai][0][m][1]), "+v"(acc[ai][1][m][0]), "+v"(acc[ai][1][m][1]));
                asm volatile("" ::: "memory"); } }
        st.run(acc, u, wr, wc, fr, fq, lds, wid, lane);
        const LAS float* S = (const LAS float*)(lds + 4096);
        f32x4 gg[2][2];
#pragma unroll
        for (int bj = 0; bj < 2; ++bj)
#pragma unroll
            for (int n = 0; n < 2; ++n) gg[bj][n] = *(const f32x4*)(g + col0 + bj * HALF + n * 16);
#pragma unroll
        for (int ai = 0; ai < 2; ++ai)
#pragma unroll
            for (int m = 0; m < 4; ++m) { const int r = ai * HALF + wr * 64 + m * 16 + fr; const float rstd = S[r]; float* rowp = out + (size_t)(u.pm * BM + r) * DM + col0;
#pragma unroll
                for (int bj = 0; bj < 2; ++bj)
#pragma unroll
                    for (int n = 0; n < 2; ++n) *(f32x4*)(rowp + bj * HALF + n * 16) = (acc[ai][bj][m][n] * rstd) * gg[bj][n];
                asm volatile("" ::: "memory"); }
    }
};
}

struct SchedP2 {
    const char *H, *HE, *HO, *WQK, *WA; char *QK, *VT, *VTA; float* SP; int G, c;
    __device__ __forceinline__ bool next(int i, pg8::Unit& u) const {
        const int L = i * G + c; if (L >= 512) return false;
        constexpr size_t tstep = (size_t)256 * DM * 2;
        u.sp = nullptr;
        if (L < 256) { int pm, pn; pg8::tile_map(L, 64, 4, pm, pn); u.pm = pm; u.pn = pn; u.pa = H + pm * tstep; u.pb = WQK + pn * tstep;
            const int b = pm >> 3, s0 = (pm & 7) * 256, head0 = (pn & 1) * 4;
            u.po = QK + (size_t)(pn >> 1) * (16u << 20) + ((size_t)((b * 8 + head0) * SEQ + s0) * 64) * 2; u.rp = 64; u.RS = 64 * 64; u.CS = SEQ * 64; }
        else if (L < 384) { int pm, pn; pg8::tile_map(L - 256, 2, 64, pm, pn); u.pm = 4 + pm; u.pn = pn; u.pa = WA + (size_t)(4 + pm) * tstep; u.pb = H + pn * tstep;
            const int b = pn >> 3;
            u.po = VTA + ((size_t)((b * 8 + 4 * pm) * 32 + 4 * (pn & 7)) * 4096) * 2; u.rp = 64; u.RS = 32 * 4096; u.CS = 4096; }
        else { const int which = (L - 384) >> 6; int pm, pn; pg8::tile_map((L - 384) & 63, 2, 32, pm, pn); u.pm = which * 2 + pm; u.pn = pn;
            u.pa = WA + (size_t)(which * 2 + pm) * tstep; u.pb = (which ? HO : HE) + pn * tstep;
            const int b = pn >> 2, st = pn & 3;
            u.po = VT + (size_t)which * (8u << 20) + ((size_t)(b * 512 + pm * 256) * 1024 + st * 256) * 2; u.rp = 1024; u.RS = 64 * 1024; u.CS = 64;
            if (!which) u.sp = SP + ((size_t)(b * 512 + pm * 256) * 32 + st * 4); }
        return true;
    }
};
struct SchedFourier {
    const char *CS, *VT; char* PQ; int G, c;
    __device__ __forceinline__ bool next(int i, pg8::Unit& u) const {
        const int L = i * G + c; if (L >= 128) return false;
        int pm, pn; pg8::tile_map(L, 8, 16, pm, pn); u.pm = pm; u.pn = pn;
        constexpr size_t tstep = (size_t)256 * 1024 * 2;
        u.pa = CS + pm * tstep; u.pb = VT + (size_t)(pm >> 2) * (8u << 20) + pn * tstep; u.po = PQ + ((size_t)pm * 256 * 4096 + pn * 256) * 2; u.rp = 4096; u.RS = 64 * 4096; u.CS = 64; u.sp = nullptr;
        return true;
    }
};
struct SchedPlain {
    const char *A, *B; int nM, nN, K, G, c;
    __device__ __forceinline__ bool next(int i, pg8::Unit& u) const {
        const int L = i * G + c; if (L >= nM * nN) return false;
        int pm, pn; pg8::tile_map(L, nM, nN, pm, pn); u.pm = pm; u.pn = pn;
        const size_t tstep = (size_t)256 * K * 2;
        u.pa = A + pm * tstep; u.pb = B + pn * tstep; u.po = nullptr; u.sp = nullptr; u.rp = 0; u.RS = 0; u.CS = 0;
        return true;
    }
};

__device__ __forceinline__ void p0_mod_item(const Params& p, LAS unsigned char* lds, int item) {
    LAS float* cs = (LAS float*)lds;
    LAS float* red = (LAS float*)(lds + 32768);
    const int tid = threadIdx.x;
    for (int u = tid; u < NBATCH * DM; u += NTHREADS) { const float v = p.c[u]; cs[u] = v / (1.0f + __expf(-v)); }
    __syncthreads();
    const int j0 = item * 64, l16 = tid & 15, rs = tid >> 4;
    f32x4 acc[8];
#pragma unroll
    for (int b = 0; b < 8; ++b) acc[b] = (f32x4){0.f, 0.f, 0.f, 0.f};
#pragma unroll 32
    for (int pass = 0; pass < 32; ++pass) { const int i = pass * 32 + rs; const f32x4 w = *(const f32x4*)(p.w_ada + (size_t)i * NMOD + j0 + 4 * l16);
#pragma unroll
        for (int b = 0; b < 8; ++b) acc[b] += cs[b * DM + i] * w; }
#pragma unroll
    for (int b = 0; b < 8; ++b) *(LAS f32x4*)(red + (rs * 8 + b) * 64 + 4 * l16) = acc[b];
    __syncthreads();
    { const int b = tid >> 6, col = tid & 63; float s = p.b_ada[j0 + col];
#pragma unroll 8
      for (int r = 0; r < 32; ++r) s += red[(r * 8 + b) * 64 + col];
      ((float*)(p.ws + WS_MOD))[(size_t)b * NMOD + j0 + col] = s; }
    asm volatile("s_waitcnt vmcnt(0)" ::: "memory");
    __syncthreads();
    if (tid == 0) {
        __builtin_amdgcn_fence(__ATOMIC_RELEASE, "agent");
        asm volatile("s_waitcnt vmcnt(0)" ::: "memory");
        __hip_atomic_fetch_add((unsigned*)(p.ws + WS_BAR) + 3712, 1u, __ATOMIC_RELAXED, __HIP_MEMORY_SCOPE_AGENT);
    }
}
typedef float f32x16 __attribute__((ext_vector_type(16)));
__device__ __forceinline__ void p0_fold_item(const Params& p, LAS unsigned char* lds, int item) {
    LAS float* Wf = (LAS float*)lds;
    LAS float* Gm = (LAS float*)(lds + 65536);
    LAS float* wt = (LAS float*)(lds + 131072);
    const int tid = threadIdx.x, lane = tid & 63, w = tid >> 6, which = item >> 6, g = (item >> 4) & 3, ib = (item & 15) * 64;
    for (int u = tid; u < 4096; u += NTHREADS) *(LAS f32x4*)(Wf + 4 * u) = *(const f32x4*)(p.w_four + (size_t)g * 16384 + 4 * u);
    __syncthreads();
    {
        const int mt = w >> 1, nt0 = (w & 1) * 2, li = lane & 31, lk = lane >> 5, c = mt * 32 + li;
        f32x16 acc0, acc1;
#pragma unroll
        for (int r = 0; r < 16; ++r) { acc0[r] = 0.f; acc1[r] = 0.f; }
#pragma unroll 4
        for (int ks = 0; ks < 64; ++ks) { const int e = 2 * ks + lk; const float ang = (float)((c * e) & 127) * (1.0f / 128.0f);
            const float a = (which ? __builtin_amdgcn_sinf(ang) : __builtin_amdgcn_cosf(ang)) * 0.08838834764831845f;
            const float b0 = Wf[e * 128 + nt0 * 32 + li], b1 = Wf[e * 128 + nt0 * 32 + 32 + li];
            acc0 = __builtin_amdgcn_mfma_f32_32x32x2f32(a, b0, acc0, 0, 0, 0); acc1 = __builtin_amdgcn_mfma_f32_32x32x2f32(a, b1, acc1, 0, 0, 0); }
#pragma unroll
        for (int r = 0; r < 16; ++r) { const int row = mt * 32 + (r & 3) + 8 * (r >> 2) + 4 * lk; Gm[row * 128 + nt0 * 32 + li] = acc0[r]; Gm[row * 128 + nt0 * 32 + 32 + li] = acc1[r]; }
    }
    for (int sub = 0; sub < 2; ++sub) { const int i0 = ib + sub * 32;
    for (int u = tid; u < 4096; u += NTHREADS) { const int il = u >> 7, c = u & 127; wt[il * 129 + c] = p.w_in[(size_t)(i0 + il) * 2048 + g * 128 + c]; }
    __syncthreads();
    {
        const int li = lane & 15, lk = lane >> 4;
        f32x4 acc0 = (f32x4){0.f, 0.f, 0.f, 0.f}, acc1 = (f32x4){0.f, 0.f, 0.f, 0.f};
#pragma unroll 4
        for (int ks = 0; ks < 32; ++ks) { const int c = 4 * ks + lk; const float a = Gm[c * 128 + 16 * w + li], b0 = wt[li * 129 + c], b1 = wt[(16 + li) * 129 + c];
            acc0 = __builtin_amdgcn_mfma_f32_16x16x4f32(a, b0, acc0, 0, 0, 0); acc1 = __builtin_amdgcn_mfma_f32_16x16x4f32(a, b1, acc1, 0, 0, 0); }
        bf16_t* WA = (bf16_t*)(p.ws + WS_WA);
#pragma unroll
        for (int r = 0; r < 4; ++r) { const int d = 16 * w + lk * 4 + r; bf16_t* rowp = WA + (size_t)(which * 512 + g * 128 + d) * DM + i0;
            rowp[li] = (bf16_t)(cvt_pk_bf16(acc0[r], 0.f) & 0xffffu); rowp[16 + li] = (bf16_t)(cvt_pk_bf16(acc1[r], 0.f) & 0xffffu); }
    }
    __syncthreads();
    }
}
__device__ __forceinline__ void p0_transpose_item(const float* W, int ldw, int ncol0, int K, bf16_t* WT, int orow, const float* gk, LAS float* scr, int kb, int lane) {
    const int k0 = 64 * kb;
#pragma unroll 8
    for (int i = 0; i < 32; ++i) { const int kk = 2 * i + (lane >> 5); float v = W[(size_t)(k0 + kk) * ldw + ncol0 + (lane & 31)]; if (gk) v *= gk[k0 + kk]; scr[kk * 33 + (lane & 31)] = v; }
    asm volatile("s_waitcnt lgkmcnt(0)" ::: "memory");
    const int c = lane & 7;
#pragma unroll
    for (int j = 0; j < 4; ++j) { const int n = (lane >> 3) + 8 * j; const LAS float* s = scr + (8 * c) * 33 + n;
        u32x4 o; o.x = cvt_pk_bf16(s[0 * 33], s[1 * 33]); o.y = cvt_pk_bf16(s[2 * 33], s[3 * 33]); o.z = cvt_pk_bf16(s[4 * 33], s[5 * 33]); o.w = cvt_pk_bf16(s[6 * 33], s[7 * 33]);
        *(u32x4*)(WT + (size_t)(orow + n) * K + k0 + 8 * c) = o; }
    asm volatile("s_waitcnt lgkmcnt(0)" ::: "memory");
}
__device__ __forceinline__ void p0_prologue(const Params& p, LAS unsigned char* lds) {
    const int tid = threadIdx.x, lane = tid & 63, wave = tid >> 6, G = gridDim.x;
    if (G == 256) {
        if (blockIdx.x < 128) p0_fold_item(p, lds, blockIdx.x); else if (blockIdx.x < 224) p0_mod_item(p, lds, blockIdx.x - 128);
    } else { for (int it = blockIdx.x; it < 96; it += G) p0_mod_item(p, lds, it);
        for (int it = blockIdx.x; it < 128; it += G) p0_fold_item(p, lds, it); }
    LAS float* scr = (LAS float*)(lds + wave * 16384);
    const int gw = blockIdx.x * NWAVES + wave, NGW = G * NWAVES;
    constexpr int I_QK = 16 * 32, I_V = 16 * 16;
    for (int it = gw; it < I_QK + I_V; it += NGW) {
        int r = it;
        if (r < I_QK) { const int kb = r >> 5, nb = r & 31; p0_transpose_item(p.w_in, 2048, 512 + nb * 32, DM, (bf16_t*)(p.ws + WS_WQK), nb * 32, nullptr, scr, kb, lane); continue; } r -= I_QK;
        { const int kb = r >> 4, nb = r & 15; p0_transpose_item(p.w_in, 2048, 1536 + nb * 32, DM, (bf16_t*)(p.ws + WS_WA), 1024 + nb * 32, nullptr, scr, kb, lane); }
    }
}
__device__ __forceinline__ void late_work(const Params& p, LAS unsigned char* lds, int hidx, int nh, int what) {
    const int tid = threadIdx.x, lane = tid & 63, wave = tid >> 6;
    LAS float* scr = (LAS float*)(lds + wave * 16384);
    const int gw = hidx * NWAVES + wave, NGW = nh * NWAVES;
    constexpr int I_O = 16 * 32, I_UP = 16 * 176, I_DN = 44 * 32;
    const int it_lo = (what & 1) ? 0 : I_O + I_UP, it_hi = (what & 2) ? I_O + I_UP + I_DN : ((what & 1) ? I_O + I_UP : it_lo);
    for (int it = it_lo + gw; it < it_hi; it += NGW) {
        int r = it;
        if (r < I_O) { const int kb = r >> 5, nb = r & 31; p0_transpose_item(p.w_out, DM, nb * 32, DM, (bf16_t*)(p.ws + WS_WOUT), nb * 32, kb < 8 ? p.g_four_out : p.g_na_out - 512, scr, kb, lane); continue; } r -= I_O;
        if (r < I_UP) { const int kb = r / 176, nb = r % 176; const int n0 = nb * 32; const int isv = n0 >= DFF, j = isv ? n0 - DFF : n0;
            p0_transpose_item(p.w_up, 2 * DFF, n0, DM, (bf16_t*)(p.ws + WS_WUP), (j >> 7) * 256 + isv * 128 + (j & 127), nullptr, scr, kb, lane); continue; } r -= I_UP;
        { const int kb = r >> 5, nb = r & 31; p0_transpose_item(p.w_down, DM, nb * 32, DFF, (bf16_t*)(p.ws + WS_WDN), nb * 32, nullptr, scr, kb, lane); }
    }
    bf16_t* CS = (bf16_t*)(p.ws + WS_CS);
    if (what & 4) for (int u = hidx * NTHREADS + tid; u < 2048 * 128; u += nh * NTHREADS) { const int kp = u >> 7, s0 = (u & 127) * 8, k = kp & 1023; float v[8];
#pragma unroll
        for (int j = 0; j < 8; ++j) { const float ang = (float)((k * (s0 + j)) & 2047) * (1.0f / 2048.0f); v[j] = (kp >= 1024 ? __builtin_amdgcn_sinf(ang) : __builtin_amdgcn_cosf(ang)) * 0.022097086912079608f; }
        u32x4 o; o.x = cvt_pk_bf16(v[0], v[1]); o.y = cvt_pk_bf16(v[2], v[3]); o.z = cvt_pk_bf16(v[4], v[5]); o.w = cvt_pk_bf16(v[6], v[7]);
        *(u32x4*)(CS + (size_t)kp * 1024 + s0) = o; }
}

__device__ __forceinline__ void pass_norm_mod(const float* src, const float* ssq, const float* g, const float* mod, int sh_off, int sc_off, bf16_t* dst) {
    constexpr int RW = 4;
    const int lane = threadIdx.x & 63, gw = blockIdx.x * NWAVES + (threadIdx.x >> 6), NGW = gridDim.x * NWAVES;
    if (!ssq && NGW == 2048) {
        const int rowb = gw * 8, b = rowb >> 11;
        f32x4 mul[4], sh[4];
#pragma unroll
        for (int j = 0; j < 4; ++j) { const f32x4 gg = ((const f32x4*)g)[lane + 64 * j], sc = ((const f32x4*)(mod + (size_t)b * NMOD + sc_off))[lane + 64 * j];
            mul[j] = gg * (1.0f + sc); sh[j] = ((const f32x4*)(mod + (size_t)b * NMOD + sh_off))[lane + 64 * j]; }
#pragma unroll
        for (int half = 0; half < 2; ++half) {
            f32x4 v[RW][4];
#pragma unroll
            for (int q = 0; q < RW; ++q) { const f32x4* xr = (const f32x4*)(src + (size_t)(rowb + half * RW + q) * DM) + lane;
#pragma unroll
                for (int j = 0; j < 4; ++j) v[q][j] = xr[64 * j]; }
#pragma unroll
            for (int q = 0; q < RW; ++q) { float t = 0.f;
#pragma unroll
                for (int j = 0; j < 4; ++j) t += (v[q][j][0] * v[q][j][0] + v[q][j][1] * v[q][j][1]) + (v[q][j][2] * v[q][j][2] + v[q][j][3] * v[q][j][3]);
                t = wave_sum(t); const float rstd = 1.0f / sqrtf(t * (1.0f / DM) + EPS);
                u32x2* o8 = (u32x2*)(dst + (size_t)(rowb + half * RW + q) * DM) + lane;
#pragma unroll
                for (int j = 0; j < 4; ++j) { const f32x4 h = (v[q][j] * rstd) * mul[j] + sh[j]; u32x2 w; w.x = cvt_pk_bf16(h[0], h[1]); w.y = cvt_pk_bf16(h[2], h[3]); o8[64 * j] = w; } }
        }
        return;
    }
    for (int row0 = gw; row0 < NTOK; row0 += RW * NGW) {
        f32x4 v[RW][4]; float s[RW];
#pragma unroll
        for (int q = 0; q < RW; ++q) { const int row = min(row0 + q * NGW, NTOK - 1); const f32x4* xr = (const f32x4*)(src + (size_t)row * DM) + lane;
#pragma unroll
            for (int j = 0; j < 4; ++j) v[q][j] = xr[64 * j]; }
#pragma unroll
        for (int q = 0; q < RW; ++q) { const int row = min(row0 + q * NGW, NTOK - 1); float t = 0.f;
#pragma unroll
            for (int j = 0; j < 4; ++j) t += (v[q][j][0] * v[q][j][0] + v[q][j][1] * v[q][j][1]) + (v[q][j][2] * v[q][j][2] + v[q][j][3] * v[q][j][3]);
            if (ssq) { t = ssq[(size_t)row * 16 + (lane & 15)]; t += __shfl_xor(t, 1); t += __shfl_xor(t, 2); t += __shfl_xor(t, 4); t += __shfl_xor(t, 8); }
            else t = wave_sum(t);
            s[q] = 1.0f / sqrtf(t * (1.0f / DM) + EPS); }
#pragma unroll
        for (int q = 0; q < RW; ++q) { const int row = row0 + q * NGW; if (row < NTOK) { const int b = row >> 11;
            const f32x4* g4 = (const f32x4*)g + lane; const f32x4* sh4 = (const f32x4*)(mod + (size_t)b * NMOD + sh_off) + lane; const f32x4* sc4 = (const f32x4*)(mod + (size_t)b * NMOD + sc_off) + lane;
            u32x2* o8 = (u32x2*)(dst + (size_t)row * DM) + lane;
#pragma unroll
            for (int j = 0; j < 4; ++j) { const f32x4 gg = g4[64 * j], sh = sh4[64 * j], sc = sc4[64 * j]; const f32x4 h = (v[q][j] * s[q] * gg) * (1.0f + sc) + sh;
                u32x2 w; w.x = cvt_pk_bf16(h[0], h[1]); w.y = cvt_pk_bf16(h[2], h[3]); o8[64 * j] = w; } } }
    }
}
__device__ __forceinline__ void pass_h_fold(const float* src, const float* g, const float* mod, bf16_t* H, bf16_t* HE, bf16_t* HO) {
    const int vb = (gridDim.x & 7) ? (int)blockIdx.x : (int)((blockIdx.x & 7) * (gridDim.x >> 3) + (blockIdx.x >> 3));
    const int lane = threadIdx.x & 63, gw = vb * NWAVES + (threadIdx.x >> 6), NGW = gridDim.x * NWAVES;
    for (int ch = gw; ch < 2048; ch += NGW) {
        const int b = ch >> 8, sb = (ch & 255) * 4;
        f32x4 mul[4], sh[4];
#pragma unroll
        for (int j = 0; j < 4; ++j) { const f32x4 gg = ((const f32x4*)g)[lane + 64 * j], sc = ((const f32x4*)(mod + (size_t)b * NMOD + DM))[lane + 64 * j];
            mul[j] = gg * (1.0f + sc); sh[j] = ((const f32x4*)(mod + (size_t)b * NMOD))[lane + 64 * j]; }
#pragma unroll
        for (int half = 0; half < 2; ++half) {
            f32x4 v[2][2][4];
#pragma unroll
            for (int q = 0; q < 2; ++q) { const int s = sb + half * 2 + q, pr = (s == 0) ? SEQ / 2 : SEQ - s;
                const f32x4* x0 = (const f32x4*)(src + (size_t)(b * SEQ + s) * DM) + lane; const f32x4* x1 = (const f32x4*)(src + (size_t)(b * SEQ + pr) * DM) + lane;
#pragma unroll
                for (int j = 0; j < 4; ++j) { v[q][0][j] = x0[64 * j]; v[q][1][j] = x1[64 * j]; } }
#pragma unroll
            for (int q = 0; q < 2; ++q) { const int s = sb + half * 2 + q, pr = (s == 0) ? SEQ / 2 : SEQ - s;
                float t0 = 0.f, t1 = 0.f;
#pragma unroll
                for (int j = 0; j < 4; ++j) { const f32x4 a = v[q][0][j], c = v[q][1][j]; t0 += (a[0] * a[0] + a[1] * a[1]) + (a[2] * a[2] + a[3] * a[3]); t1 += (c[0] * c[0] + c[1] * c[1]) + (c[2] * c[2] + c[3] * c[3]); }
                t0 = wave_sum(t0); t1 = wave_sum(t1);
                const float r0 = 1.0f / sqrtf(t0 * (1.0f / DM) + EPS), r1 = 1.0f / sqrtf(t1 * (1.0f / DM) + EPS);
                u32x2* o0 = (u32x2*)(H + (size_t)(b * SEQ + s) * DM) + lane; u32x2* o1 = (u32x2*)(H + (size_t)(b * SEQ + pr) * DM) + lane;
                u32x2* oe = (u32x2*)(HE + (size_t)(b * 1024 + s) * DM) + lane; u32x2* oo = (u32x2*)(HO + (size_t)(b * 1024 + s) * DM) + lane;
#pragma unroll
                for (int j = 0; j < 4; ++j) { const f32x4 h0 = (v[q][0][j] * r0) * mul[j] + sh[j], h1 = (v[q][1][j] * r1) * mul[j] + sh[j];
                    u32x2 w; w.x = cvt_pk_bf16(h0[0], h0[1]); w.y = cvt_pk_bf16(h0[2], h0[3]); o0[64 * j] = w;
                    w.x = cvt_pk_bf16(h1[0], h1[1]); w.y = cvt_pk_bf16(h1[2], h1[3]); o1[64 * j] = w;
                    const f32x4 e = (s == 0) ? h0 : h0 + h1, o = (s == 0) ? (f32x4){0.f, 0.f, 0.f, 0.f} : h0 - h1;
                    w.x = cvt_pk_bf16(e[0], e[1]); w.y = cvt_pk_bf16(e[2], e[3]); oe[64 * j] = w;
                    w.x = cvt_pk_bf16(o[0], o[1]); w.y = cvt_pk_bf16(o[2], o[3]); oo[64 * j] = w; } }
        }
    }
}
__device__ __forceinline__ void pass_xmid(const bf16_t* H, const bf16_t* WA, float* X) {
    const int lane = threadIdx.x & 63, gw = blockIdx.x * NWAVES + (threadIdx.x >> 6), NGW = gridDim.x * NWAVES;
    for (int t = gw; t < NBATCH * 512; t += NGW) { const int b = t >> 9, c = t & 511;
        const u32x4* hp = (const u32x4*)(H + (size_t)(b * SEQ + SEQ / 2) * DM) + lane * 2; const u32x4* wp = (const u32x4*)(WA + (size_t)c * DM) + lane * 2;
        float s = 0.f;
#pragma unroll
        for (int q = 0; q < 2; ++q) { const u32x4 hv = hp[q], wv = wp[q];
#pragma unroll
            for (int j = 0; j < 4; ++j) s += bf_lo(hv[j]) * bf_lo(wv[j]) + bf_hi(hv[j]) * bf_hi(wv[j]); }
        s = wave_sum(s);
        if (lane == 0) X[t] = s; }
}
__device__ __forceinline__ void pass_final(float* xo, const float* ssq, const float* g) {
    const int lane = threadIdx.x & 63, gw = blockIdx.x * NWAVES + (threadIdx.x >> 6), NGW = gridDim.x * NWAVES;
    for (int row = gw; row < NTOK; row += NGW) {
        f32x4* xr = (f32x4*)(xo + (size_t)row * DM) + lane;
        float s = ssq[(size_t)row * 16 + (lane & 15)]; s += __shfl_xor(s, 1); s += __shfl_xor(s, 2); s += __shfl_xor(s, 4); s += __shfl_xor(s, 8);
        const float rstd = 1.0f / sqrtf(s * (1.0f / DM) + EPS);
        const f32x4* g4 = (const f32x4*)g + lane;
#pragma unroll
        for (int j = 0; j < 4; ++j) { const f32x4 v = xr[64 * j]; xr[64 * j] = v * rstd * g4[64 * j]; }
    }
}
__device__ __forceinline__ void combine_row(int row, const float (&y)[8], const float* SSQNA, bf16_t* YCAT, int lane) {
    float s = 0.f;
#pragma unroll
    for (int j = 0; j < 8; ++j) s += y[j] * y[j];
    s = wave_sum(s);
    const float rstd = 1.0f / sqrtf(s * (1.0f / 512.0f) + EPS);
    u32x4 o; o.x = cvt_pk_bf16(y[0] * rstd, y[1] * rstd); o.y = cvt_pk_bf16(y[2] * rstd, y[3] * rstd); o.z = cvt_pk_bf16(y[4] * rstd, y[5] * rstd); o.w = cvt_pk_bf16(y[6] * rstd, y[7] * rstd);
    *(u32x4*)(YCAT + (size_t)row * DM + lane * 8) = o;
    float t = SSQNA[(size_t)row * 8 + (lane & 7)]; t += __shfl_xor(t, 1); t += __shfl_xor(t, 2); t += __shfl_xor(t, 4);
    const float rn = 1.0f / sqrtf(t * (1.0f / 512.0f) + EPS);
    u32x4* ap = (u32x4*)(YCAT + (size_t)row * DM + 512 + lane * 8); const u32x4 aw = *ap; u32x4 ow;
#pragma unroll
    for (int j = 0; j < 4; ++j) ow[j] = cvt_pk_bf16(bf_lo(aw[j]) * rn, bf_hi(aw[j]) * rn);
    *ap = ow;
}
__device__ __forceinline__ void pass_combine(const bf16_t* PQ, const float* SP, const float* XM, const float* SSQNA, bf16_t* YCAT) {
    const int vb = (gridDim.x & 7) ? (int)blockIdx.x : (int)((blockIdx.x & 7) * (gridDim.x >> 3) + (blockIdx.x >> 3));
    const int lane = threadIdx.x & 63, gw = vb * NWAVES + (threadIdx.x >> 6), NGW = gridDim.x * NWAVES;
    for (int pi0 = gw; pi0 < NBATCH * 1024; pi0 += NGW) {
        const int pi = (NGW == 2048) ? gw * 4 + (pi0 - gw) / NGW : pi0;
        const int b = pi >> 10, kk = pi & 1023;
        const u32x4 pw = *(const u32x4*)(PQ + (size_t)kk * 4096 + b * 512 + lane * 8), qw = *(const u32x4*)(PQ + (size_t)(1024 + kk) * 4096 + b * 512 + lane * 8);
        float y1[8], y2[8];
        const f32x4 xa = *(const f32x4*)(XM + b * 512 + lane * 8), xb = *(const f32x4*)(XM + b * 512 + lane * 8 + 4); const float xs = (kk & 1) ? -0.022097086912079608f : 0.022097086912079608f;
        const float xm[8] = {xa[0] * xs, xa[1] * xs, xa[2] * xs, xa[3] * xs, xb[0] * xs, xb[1] * xs, xb[2] * xs, xb[3] * xs};
#pragma unroll
        for (int j = 0; j < 4; ++j) { const float pl = bf_lo(pw[j]) + xm[2 * j], ph = bf_hi(pw[j]) + xm[2 * j + 1], ql = bf_lo(qw[j]), qh = bf_hi(qw[j]); y1[2 * j] = pl - ql; y1[2 * j + 1] = ph - qh; y2[2 * j] = pl + ql; y2[2 * j + 1] = ph + qh; }
        if (kk == 0) {
#pragma unroll
            for (int j = 0; j < 8; ++j) { const f32x4* sp = (const f32x4*)(SP + (size_t)(b * 512 + lane * 8 + j) * 32); f32x4 a = sp[0];
#pragma unroll
                for (int i = 1; i < 4; ++i) a += sp[i];
                y2[j] = ((a[0] + a[1]) + (a[2] + a[3])) * 0.022097086912079608f + xm[j]; }
        }
        combine_row(b * SEQ + kk, y1, SSQNA, YCAT, lane);
        combine_row(b * SEQ + (kk == 0 ? 1024 : SEQ - kk), y2, SSQNA, YCAT, lane);
    }
}
__device__ __forceinline__ void pass_fixup(const bf16_t* side, const float* cw, const float* cb, bf16_t* A) {
    const int total = 512 * (DFF / 4);
    for (int u = blockIdx.x * NTHREADS + threadIdx.x; u < total; u += gridDim.x * NTHREADS) {
        const int ri = u / (DFF / 4), J = (u % (DFF / 4)) * 4, chunk = ri >> 1, bot = ri & 1;
        const bf16_t* sc = side + (size_t)chunk * 4 * (2 * DFF);
        const bf16_t *pp, *pc, *pn; bool hp = true, hn = true; int tok;
        if (!bot) { hp = (chunk & 31) != 0; pp = sc - (2 * DFF); pc = sc; pn = sc + (2 * DFF); tok = chunk * 64; }
        else { hn = (chunk & 31) != 31; pp = sc + 2 * (2 * DFF); pc = sc + 3 * (2 * DFF); pn = sc + 4 * (2 * DFF); tok = chunk * 64 + 63; }
        float up[2][4];
#pragma unroll
        for (int bj = 0; bj < 2; ++bj) {
            const int col = bj * DFF + J;
            u32x2 wp = (u32x2){0u, 0u}, wn = (u32x2){0u, 0u}; if (hp) wp = *(const u32x2*)(pp + col); if (hn) wn = *(const u32x2*)(pn + col); const u32x2 wc2 = *(const u32x2*)(pc + col);
            const f32x4 k0 = *(const f32x4*)(cw + col), k1 = *(const f32x4*)(cw + 2 * DFF + col), k2 = *(const f32x4*)(cw + 4 * DFF + col), kb = *(const f32x4*)(cb + col);
            const float pv[4] = {bf_lo(wp.x), bf_hi(wp.x), bf_lo(wp.y), bf_hi(wp.y)}, cv[4] = {bf_lo(wc2.x), bf_hi(wc2.x), bf_lo(wc2.y), bf_hi(wc2.y)}, nv[4] = {bf_lo(wn.x), bf_hi(wn.x), bf_lo(wn.y), bf_hi(wn.y)};
#pragma unroll
            for (int j = 0; j < 4; ++j) up[bj][j] = k0[j] * pv[j] + k1[j] * cv[j] + k2[j] * nv[j] + kb[j];
        }
        u32x2 w; w.x = cvt_pk_bf16(silu_f(up[0][0]) * up[1][0], silu_f(up[0][1]) * up[1][1]); w.y = cvt_pk_bf16(silu_f(up[0][2]) * up[1][2], silu_f(up[0][3]) * up[1][3]);
        *(u32x2*)(A + (size_t)tok * DFF + J) = w;
    }
}

__device__ __forceinline__ void attn_phase(const Params& p, LAS unsigned char* lds) {
    const int tid = threadIdx.x, lane = tid & 63, w = __builtin_amdgcn_readfirstlane(tid >> 6), fr = lane & 15, fq = lane >> 4;
    LAS unsigned char* Ks = lds;
    LAS unsigned char* Vs = lds + 73728;
    LAS float* rp = (LAS float*)(lds + 147456);
    volatile LAS unsigned* slot = (volatile LAS unsigned*)(lds + 147456 + 2048);
    const bf16_t* QH = (const bf16_t*)(p.ws + WS_QK); const bf16_t* KH = (const bf16_t*)(p.ws + WS_QK + (16u << 20)); const bf16_t* VTA = (const bf16_t*)(p.ws + WS_VTA);
    bf16_t* YCAT = (bf16_t*)(p.ws + WS_YCAT); float* SSQNA = (float*)(p.ws + WS_SSQ1 + 512 * 1024);
    const float sc2 = 0.125f * 1.4426950408889634f;
    unsigned* ctr = (unsigned*)(p.ws + WS_BAR) + 3584;
    const int ri = w >> 2, qb = w & 3, q0 = qb * 16, kc0 = min(max(q0 - 8, 0), 32);
    const int kperm = 8 * (fr >> 2) + (fr & 3);
    for (;;) {
        __syncthreads();
        if (tid == 0) slot[0] = __hip_atomic_fetch_add(ctr, 1u, __ATOMIC_RELAXED, __HIP_MEMORY_SCOPE_AGENT);
        __syncthreads();
        const int item = (int)slot[0];
        if (item >= 1024) break;
        const int b = item >> 7, h = (item >> 4) & 7, r0 = (item & 15) * 2, R0 = min(max(r0 - 4, 0), 24);
        const int r = r0 + ri, rs = min(max(r - 4, 0), 24), j0 = rs - R0;
        const int tq = b * SEQ + r * 64 + q0 + fr;
        const bf16_t* qp = QH + ((size_t)(b * 8 + h) * SEQ + r * 64 + q0 + fr) * 64 + fq * 8;
        const bf16x8 qf0 = *(const bf16x8*)qp, qf1 = *(const bf16x8*)(qp + 32);
        for (int u = tid; u < 465; u += NTHREADS) rp[u] = p.rpb[h * 465 + u] * 1.4426950408889634f;
        { const int t = tid >> 3, c = tid & 7; const unsigned dstk = (unsigned)(t * 128 + ((c ^ (((t >> 1) & 1) | (((t >> 3) & 3) << 1))) << 4)), dstv = (unsigned)(t * 128 + ((c ^ ((t >> 1) & 7)) << 4));
          u32x4 kv[9], vv[9];
#pragma unroll
          for (int j = 0; j < 9; ++j) { const int srow = min(R0 + j, 31);
              kv[j] = *(const u32x4*)(KH + ((size_t)(b * 8 + h) * SEQ + srow * 64 + t) * 64 + c * 8);
              vv[j] = *(const u32x4*)(VTA + ((size_t)((b * 8 + h) * 32 + srow) * 64 + t) * 64 + c * 8); }
#pragma unroll
          for (int j = 0; j < 9; ++j) { *(LAS u32x4*)(Ks + j * 8192 + dstk) = kv[j]; *(LAS u32x4*)(Vs + j * 8192 + dstv) = vv[j]; } }
        __syncthreads();
        f32x4 s[8][2];
#pragma unroll
        for (int i = 0; i < 8; ++i)
#pragma unroll
            for (int t = 0; t < 2; ++t) { const int tok = kc0 + kperm + 4 * t; const LAS unsigned char* kr = Ks + (j0 + i) * 8192 + tok * 128;
                const int fk = ((tok >> 1) & 1) | (((tok >> 3) & 3) << 1);
                const bf16x8 k0 = *(const LAS bf16x8*)(kr + ((fq ^ fk) << 4)), k1 = *(const LAS bf16x8*)(kr + (((4 + fq) ^ fk) << 4));
                f32x4 a = (f32x4){0.f, 0.f, 0.f, 0.f};
                a = __builtin_amdgcn_mfma_f32_16x16x32_bf16(k0, qf0, a, 0, 0, 0); a = __builtin_amdgcn_mfma_f32_16x16x32_bf16(k1, qf1, a, 0, 0, 0); s[i][t] = a; }
        const int qc = q0 + fr, cs0 = min(max(qc - 8, 0), 48);
        float madd[2][4]; int dco[2][4];
#pragma unroll
        for (int t = 0; t < 2; ++t)
#pragma unroll
            for (int j = 0; j < 4; ++j) { const int kc = kc0 + 8 * fq + 4 * t + j; madd[t][j] = ((kc >= cs0) && (kc < cs0 + 16)) ? 0.f : -1e30f; dco[t][j] = min(max(kc - qc, -15), 15); }
        float mx = -1e30f;
#pragma unroll
        for (int i = 0; i < 8; ++i) { const int dr = rs + i - r; const LAS float* rrow = rp + (dr + 7) * 31 + 15;
#pragma unroll
            for (int t = 0; t < 2; ++t)
#pragma unroll
                for (int j = 0; j < 4; ++j) { const float v = (s[i][t][j] * sc2 + rrow[dco[t][j]]) + madd[t][j]; s[i][t][j] = v; mx = fmaxf(mx, v); } }
        mx = fmaxf(mx, __shfl_xor(mx, 16)); mx = fmaxf(mx, __shfl_xor(mx, 32));
        float sum = 0.f;
#pragma unroll
        for (int i = 0; i < 8; ++i)
#pragma unroll
            for (int t = 0; t < 2; ++t)
#pragma unroll
                for (int j = 0; j < 4; ++j) { const float e = __builtin_amdgcn_exp2f(s[i][t][j] - mx); s[i][t][j] = e; sum += e; }
        sum += __shfl_xor(sum, 16); sum += __shfl_xor(sum, 32);
        const float inv = 1.0f / sum;
        f32x4 o[4];
#pragma unroll
        for (int nb = 0; nb < 4; ++nb) o[nb] = (f32x4){0.f, 0.f, 0.f, 0.f};
        const int vc = (kc0 >> 3) + fq;
#pragma unroll
        for (int i = 0; i < 8; ++i) {
            u32x4 pw; pw.x = cvt_pk_bf16(s[i][0][0], s[i][0][1]); pw.y = cvt_pk_bf16(s[i][0][2], s[i][0][3]); pw.z = cvt_pk_bf16(s[i][1][0], s[i][1][1]); pw.w = cvt_pk_bf16(s[i][1][2], s[i][1][3]);
            const bf16x8 pf = __builtin_bit_cast(bf16x8, pw);
#pragma unroll
            for (int nb = 0; nb < 4; ++nb) { const int d = nb * 16 + fr; const bf16x8 va = *(const LAS bf16x8*)(Vs + (j0 + i) * 8192 + d * 128 + ((vc ^ ((d >> 1) & 7)) << 4));
                o[nb] = __builtin_amdgcn_mfma_f32_16x16x32_bf16(va, pf, o[nb], 0, 0, 0); } }
        float q2 = 0.f;
#pragma unroll
        for (int nb = 0; nb < 4; ++nb) { o[nb] = o[nb] * inv; q2 += (o[nb][0] * o[nb][0] + o[nb][1] * o[nb][1]) + (o[nb][2] * o[nb][2] + o[nb][3] * o[nb][3]); }
        q2 += __shfl_xor(q2, 16); q2 += __shfl_xor(q2, 32);
        if (fq == 0) SSQNA[(size_t)tq * 8 + h] = q2;
        bf16_t* op = YCAT + (size_t)tq * DM + 512 + h * 64 + 4 * fq;
#pragma unroll
        for (int nb = 0; nb < 4; ++nb) { u32x2 wv; wv.x = cvt_pk_bf16(o[nb][0], o[nb][1]); wv.y = cvt_pk_bf16(o[nb][2], o[nb][3]); *(u32x2*)(op + nb * 16) = wv; }
    }
    __syncthreads();
}

constexpr int N_PHASES = 11;
__global__ void __launch_bounds__(NTHREADS, 2) fwd_megakernel(Params p) {
    extern __shared__ __attribute__((aligned(16))) unsigned char lds_raw[];
    LAS unsigned char* lds = (LAS unsigned char*)lds_raw;
    volatile LAS unsigned* bst = (volatile LAS unsigned*)(lds + LDS_BYTES - 16);
    const int lo = p.ph_lo, hi = p.ph_hi, G = gridDim.x, cid = blockIdx.x;
    if (threadIdx.x < 4) bst[threadIdx.x] = 0u;
    __syncthreads();
    XcdBarrier bar; bar.bar = (unsigned*)(p.ws + WS_BAR); bar.x = 0; bar.st = bst;
    if (!MK_PER_PHASE) bar = xcd_barrier_post((unsigned*)(p.ws + WS_BAR), bst);
    if (lo < 0) cg::this_grid().sync();
#define IN(k) (lo <= (k) && (k) < hi)
#define REP(k) for (int rep_ = 0; rep_ < 1 + ((REPEAT_MASK >> (k)) & 1); ++rep_)
#define SEAM(k) do { if (IN(k) && IN((k) + 1)) xcd_barrier(bar); } while (0)
    unsigned char* ws = p.ws;
    const float* mod = (const float*)(ws + WS_MOD);

    if (IN(0)) REP(0) p0_prologue(p, lds);
    if (IN(0) && IN(1)) {
        if (threadIdx.x < 64) { unsigned sp = 0; unsigned* mc = (unsigned*)(ws + WS_BAR) + 3712;
            while ((unsigned)__builtin_amdgcn_readfirstlane(__hip_atomic_load(mc, __ATOMIC_RELAXED, __HIP_MEMORY_SCOPE_AGENT)) < 96u) { __builtin_amdgcn_s_sleep(2); if (++sp > (1u << 22)) break; }
            __builtin_amdgcn_fence(__ATOMIC_ACQUIRE, "agent");
            asm volatile("s_waitcnt vmcnt(0)" ::: "memory"); }
        __syncthreads();
    }
    if (IN(1)) REP(1) pass_h_fold(p.x, p.g_mix, mod, (bf16_t*)(ws + WS_H), (bf16_t*)(ws + WS_HE), (bf16_t*)(ws + WS_HO));
    SEAM(1);
    if (IN(2)) { SchedP2 S{(const char*)(ws + WS_H), (const char*)(ws + WS_HE), (const char*)(ws + WS_HO), (const char*)(ws + WS_WQK), (const char*)(ws + WS_WA), (char*)(ws + WS_QK), (char*)(ws + WS_VT), (char*)(ws + WS_VTA), (float*)(ws + WS_SSQ2 + 512 * 1024), G, cid};
        pg8::EpiTileBf16 E; pg8::gemm_phase(lds, DM, S, E);
        late_work(p, lds, cid, G, 4); }
    SEAM(2);
    if (IN(3)) { pass_xmid((const bf16_t*)(ws + WS_H), (const bf16_t*)(ws + WS_WA), (float*)(ws + WS_SSQ2 + 256 * 1024));
        SchedFourier S{(const char*)(ws + WS_CS), (const char*)(ws + WS_VT), (char*)(ws + WS_PQ), G, cid};
        pg8::EpiTileBf16 E; pg8::gemm_phase(lds, 1024, S, E);
        if (G == 256) { if (cid >= 128) late_work(p, lds, cid - 128, 128, 1); } else late_work(p, lds, cid, G, 1);
        attn_phase(p, lds); }
    SEAM(3);
    if (IN(4)) REP(4) pass_combine((const bf16_t*)(ws + WS_PQ), (const float*)(ws + WS_SSQ2 + 512 * 1024), (const float*)(ws + WS_SSQ2 + 256 * 1024), (const float*)(ws + WS_SSQ1 + 512 * 1024), (bf16_t*)(ws + WS_YCAT));
    SEAM(4);
    const bool fuse = (G == 256);
    if (IN(5)) { SchedPlain S{(const char*)(ws + WS_YCAT), (const char*)(ws + WS_WOUT), 64, 4, DM, G, cid};
        if (fuse) { pg8::EpiResidNormMod E{p.x, (bf16_t*)(ws + WS_HE), mod, 2 * DM, 3 * DM, 4 * DM, p.g_ffn, (bf16_t*)(ws + WS_H), pg8::PanelSsq{(float*)(ws + WS_SSQ1), (unsigned*)(ws + WS_BAR + 16384)}}; pg8::gemm_phase(lds, DM, S, E); }
        else { pg8::EpiResid E{p.x, p.out, mod + 2 * DM, (float*)(ws + WS_SSQ1)}; pg8::gemm_phase(lds, DM, S, E); } }
    if (!fuse) SEAM(5);
    if (IN(6) && !fuse) pass_norm_mod(p.out, (const float*)(ws + WS_SSQ1), p.g_ffn, mod, 3 * DM, 4 * DM, (bf16_t*)(ws + WS_H));
    if (fuse) { if (IN(5) && IN(7)) xcd_barrier(bar); } else SEAM(6);
    if (IN(7)) REP(7) { SchedPlain S{(const char*)(ws + WS_H), (const char*)(ws + WS_WUP), 64, 22, DM, G, cid};
        pg8::EpiUp E{(bf16_t*)(ws + WS_A), (bf16_t*)(ws + WS_SIDE), p.conv_w, p.conv_b}; pg8::gemm_phase(lds, DM, S, E);
        if (G == 256) { if (cid >= 128) late_work(p, lds, cid - 128, 128, 2); } else late_work(p, lds, cid, G, 2); }
    SEAM(7);
    if (IN(8)) REP(8) pass_fixup((const bf16_t*)(ws + WS_SIDE), p.conv_w, p.conv_b, (bf16_t*)(ws + WS_A));
    SEAM(8);
    if (REPEAT_MASK & (1 << 20)) { for (int e_ = 0; e_ < 8; ++e_) xcd_barrier(bar); }
    if (IN(9)) { SchedPlain S{(const char*)(ws + WS_A), (const char*)(ws + WS_WDN), 64, 4, DFF, G, cid};
        if (fuse) { pg8::EpiResidNormOut E{(const bf16_t*)(ws + WS_HE), p.out, mod, 5 * DM, p.g_final, pg8::PanelSsq{(float*)(ws + WS_SSQ2), (unsigned*)(ws + WS_BAR + 32768)}}; pg8::gemm_phase(lds, DFF, S, E); }
        else { pg8::EpiResid E{p.out, p.out, mod + 5 * DM, (float*)(ws + WS_SSQ2)}; pg8::gemm_phase(lds, DFF, S, E); } }
    if (!fuse) SEAM(9);
    if (IN(10) && !fuse) pass_final(p.out, (const float*)(ws + WS_SSQ2), p.g_final);
#undef IN
#undef SEAM
}

extern "C" void kernel_launch(void* const* d_in, const int* in_sizes, int n_in, void* d_out, int out_size, void* d_ws, size_t ws_size, hipStream_t stream) {
    static int grid = 0;
    if (grid == 0) {
        int dev = 0, cus = 0, per_cu = 0;
        if (n_in != 17 || ws_size < WS_END) { fprintf(stderr, "kernel_launch: unexpected inputs (n_in %d, ws %zu)\n", n_in, ws_size); grid = -1; return; }
        hipGetDevice(&dev);
        hipDeviceGetAttribute(&cus, hipDeviceAttributeMultiprocessorCount, dev);
        if (hipFuncSetAttribute((const void*)fwd_megakernel, hipFuncAttributeMaxDynamicSharedMemorySize, LDS_BYTES) != hipSuccess) { fprintf(stderr, "kernel_launch: hipFuncSetAttribute failed\n"); grid = -1; return; }
        hipOccupancyMaxActiveBlocksPerMultiprocessor(&per_cu, (const void*)fwd_megakernel, NTHREADS, LDS_BYTES);
        if (per_cu < 1) { fprintf(stderr, "kernel_launch: occupancy query says %d blocks per CU\n", per_cu); per_cu = 1; }
        (void)hipGetLastError();
        grid = cus;
    }
    if (grid < 0) return;
    Params p{};
    const float** f = (const float**)&p;
    for (int i = 0; i < 17; ++i) f[i] = (const float*)d_in[i];
    p.out = (float*)d_out; p.ws = (unsigned char*)d_ws;
    hipMemsetAsync((char*)d_ws + WS_BAR, 0, 49152, stream);
#if MK_PER_PHASE
    for (int ph = 0; ph < N_PHASES; ++ph) { p.ph_lo = ph; p.ph_hi = ph + 1; hipLaunchKernelGGL(fwd_megakernel, dim3(grid), dim3(NTHREADS), LDS_BYTES, stream, p); }
#else
    p.ph_lo = 0; p.ph_hi = N_PHASES;
    void* args[] = {&p};
    hipError_t e = hipLaunchCooperativeKernel((const void*)fwd_megakernel, dim3(grid), dim3(NTHREADS), args, LDS_BYTES, stream);
    if (e != hipSuccess) fprintf(stderr, "cooperative launch failed: %s (grid %d)\n", hipGetErrorString(e), grid);
#endif
}
```

```cpp
#include <hip/hip_runtime.h>
#include <hip/hip_cooperative_groups.h>
#include <cstdio>
namespace cg = cooperative_groups;

#ifndef REPEAT_MASK
#define REPEAT_MASK 0
#endif
#ifndef MK_PER_PHASE
#define MK_PER_PHASE 0
#endif

#define LAS __attribute__((address_space(3)))
typedef unsigned short bf16_t;
typedef short bf16x8 __attribute__((ext_vector_type(8)));
typedef float f32x4 __attribute__((ext_vector_type(4)));
typedef float f32x2 __attribute__((ext_vector_type(2)));
typedef unsigned u32x4 __attribute__((ext_vector_type(4)));
typedef unsigned u32x2 __attribute__((ext_vector_type(2)));

constexpr int DM = 1024, NBATCH = 8, SEQ = 2048, NTOK = NBATCH * SEQ, DFF = 2816, NMOD = 6 * DM;
constexpr float EPS = 1e-6f;
constexpr int NTHREADS = 512, NWAVES = 8;
constexpr int LDS_STAGE = 131072, LDS_EXTRA = 20480, LDS_BYTES = LDS_STAGE + LDS_EXTRA;

constexpr size_t MiB = 1u << 20;
constexpr size_t WS_MOD = 0;
constexpr size_t WS_BAR = 512 * 1024;
constexpr size_t WS_SSQ1 = 1 * MiB;
constexpr size_t WS_SSQ2 = 2 * MiB;
constexpr size_t WS_WQK = 3 * MiB;
constexpr size_t WS_WA = 5 * MiB;
constexpr size_t WS_WOUT = 8 * MiB;
constexpr size_t WS_WUP = 10 * MiB;
constexpr size_t WS_WDN = 21 * MiB;
constexpr size_t WS_CS = 27 * MiB;
constexpr size_t WS_H = 43 * MiB;
constexpr size_t WS_VT = 75 * MiB;
constexpr size_t WS_QK = 107 * MiB;
constexpr size_t WS_VTA = 139 * MiB;
constexpr size_t WS_PQ = 236 * MiB;
constexpr size_t WS_YCAT = 187 * MiB;
constexpr size_t WS_A = 75 * MiB;
constexpr size_t WS_SIDE = 163 * MiB;
constexpr size_t WS_HE = 220 * MiB;
constexpr size_t WS_HO = 236 * MiB;
constexpr size_t WS_END = 252 * MiB;

struct Params {
    const float *x, *c, *w_ada, *b_ada, *g_mix, *w_in, *w_four, *rpb, *g_four_out, *g_na_out, *w_out, *g_ffn, *w_up, *conv_w, *conv_b, *w_down, *g_final;
    float* out; unsigned char* ws;
    int ph_lo, ph_hi;
};

__device__ __forceinline__ unsigned cvt_pk_bf16(float lo, float hi) { unsigned r; asm volatile("v_cvt_pk_bf16_f32 %0, %1, %2" : "=v"(r) : "v"(lo), "v"(hi)); return r; }
__device__ __forceinline__ float bf_lo(unsigned w) { return __uint_as_float(w << 16); }
__device__ __forceinline__ float bf_hi(unsigned w) { return __uint_as_float(w & 0xffff0000u); }
__device__ __forceinline__ float wave_sum(float v) {
#pragma unroll
    for (int o = 1; o < 64; o <<= 1) v += __shfl_xor(v, o);
    return v;
}
__device__ __forceinline__ float silu_f(float v) { return v * __builtin_amdgcn_rcpf(1.0f + __expf(-v)); }
template <int CTRL> __device__ __forceinline__ float dpp_f(float v) {
    return __builtin_bit_cast(float, __builtin_amdgcn_mov_dpp(__builtin_bit_cast(int, v), CTRL, 0xF, 0xF, true));
}

#define XB_TMO      128
#define XB_XCNT(j)  (256  + 64 * (j))
#define XB_XSUB(j)  (1280 + 64 * (j))
#define XB_XGEN(j)  (2304 + 64 * (j))
#define XB_TOP      3328
#define XB_TOPGEN   3392
#define XCD_BAR_WORDS 3456
#define XB_SPIN_CAP (1u << 20)
__device__ __forceinline__ unsigned xb_ld(unsigned* p)              { return __hip_atomic_load(p, __ATOMIC_RELAXED, __HIP_MEMORY_SCOPE_AGENT); }
__device__ __forceinline__ unsigned xb_add(unsigned* p, unsigned v) { return __hip_atomic_fetch_add(p, v, __ATOMIC_RELAXED, __HIP_MEMORY_SCOPE_AGENT); }
__device__ __forceinline__ unsigned xb_xcc_id() { return (unsigned)__builtin_amdgcn_s_getreg((3 << 11) | 20) & 0xFu; }
#define XB_SPIN(cond, bar) do { unsigned _sp = 0; while (cond) { __builtin_amdgcn_s_sleep(1); \
    if ((++_sp & 255u) == 0u) { if (xb_ld(&(bar)[XB_TMO])) break; if (_sp > XB_SPIN_CAP) { atomicAdd(&(bar)[XB_TMO], 1u); break; } } } } while (0)
struct XcdBarrier { unsigned* bar; unsigned x; volatile LAS unsigned* st; unsigned G; };
__device__ __forceinline__ XcdBarrier xcd_barrier_post(unsigned* bar, volatile LAS unsigned* st, unsigned G) {
    XcdBarrier b; b.bar = bar; b.x = xb_xcc_id(); b.st = st; b.G = G;
    if (threadIdx.x == 0) (void)xb_add(&bar[XB_XCNT(b.x)], 1u);
    return b;
}
__device__ __forceinline__ void xcd_barrier_complete(unsigned* bar, unsigned x, unsigned& nloc, unsigned& nx, const unsigned G) {
    unsigned sum, cnt, mine, sp = 0u;
    for (;;) {
        sum = 0u; cnt = 0u; mine = 0u;
#pragma unroll
        for (unsigned j = 0; j < 16; ++j) { const unsigned c = xb_ld(&bar[XB_XCNT(j)]); sum += c; cnt += (c > 0u) ? 1u : 0u; mine = (j == x) ? c : mine; }
        if (sum == G) break;
        __builtin_amdgcn_s_sleep(1);
        if ((++sp & 255u) == 0u) { if (xb_ld(&bar[XB_TMO])) break; if (sp > XB_SPIN_CAP) { atomicAdd(&bar[XB_TMO], 1u); break; } }
    }
    nloc = mine > 0u ? mine : 1u; nx = cnt > 0u ? cnt : 1u;
}
__device__ __forceinline__ void xcd_barrier(const XcdBarrier& b) {
    asm volatile("s_waitcnt vmcnt(0)" ::: "memory");
    __syncthreads();
    if (threadIdx.x == 0) {
        unsigned* bar = b.bar;
        __builtin_amdgcn_s_waitcnt(0);
        unsigned nloc = b.st[0], nx = b.st[1];
        if (nloc == 0u) { xcd_barrier_complete(bar, b.x, nloc, nx, b.G); b.st[0] = nloc; b.st[1] = nx; }
        const unsigned old = xb_add(&bar[XB_XSUB(b.x)], 1u);
        const unsigned gen = old / nloc;
        if (old + 1u == (gen + 1u) * nloc) {
            __builtin_amdgcn_fence(__ATOMIC_RELEASE, "agent");
            asm volatile("s_waitcnt vmcnt(0)" ::: "memory");
            const unsigned og = xb_add(&bar[XB_TOP], 1u);
            const unsigned tg = og / nx;
            if (og + 1u == (tg + 1u) * nx) xb_add(&bar[XB_TOPGEN], 1u);
            else XB_SPIN(xb_ld(&bar[XB_TOPGEN]) == tg, bar);
            __builtin_amdgcn_fence(__ATOMIC_ACQUIRE, "agent");
            xb_add(&bar[XB_XGEN(b.x)], 1u);
            asm volatile("s_waitcnt vmcnt(0)" ::: "memory");
        } else {
            XB_SPIN(xb_ld(&bar[XB_XGEN(b.x)]) == gen, bar);
            __builtin_amdgcn_fence(__ATOMIC_ACQUIRE, "agent");
            asm volatile("s_waitcnt vmcnt(0)" ::: "memory");
        }
    }
    __syncthreads();
}

__device__ __forceinline__ void group_barrier(unsigned* ctr, unsigned& gen, unsigned nmemb) {
    asm volatile("s_waitcnt vmcnt(0)" ::: "memory");
    __syncthreads();
    ++gen;
    if (threadIdx.x == 0) {
        __builtin_amdgcn_fence(__ATOMIC_RELEASE, "agent");
        asm volatile("s_waitcnt vmcnt(0)" ::: "memory");
        (void)xb_add(ctr, 1u);
        const unsigned target = gen * nmemb; unsigned sp = 0;
        while (xb_ld(ctr) < target) { __builtin_amdgcn_s_sleep(1); if (++sp > (1u << 22)) break; }
        __builtin_amdgcn_fence(__ATOMIC_ACQUIRE, "agent");
        asm volatile("s_waitcnt vmcnt(0)" ::: "memory");
    }
    __syncthreads();
}

namespace pg8 {
constexpr int BM = 256, BK = 64, HALF = 128, HTB = HALF * BK * 2, NXCD = 8, WGM = 8;
__device__ __forceinline__ int lds_byte(int r, int c) { const int st = (r >> 4) * 2 + (c >> 5), rr = r & 15, cc = c & 31, ob = rr * 64 + cc * 2; return st * 1024 + (ob ^ (((ob >> 9) & 1) << 5)); }
__device__ __forceinline__ void stage_rc(int b, int& R, int& C) { const int st = b / 1024, sb = b % 1024, swz = sb ^ (((sb >> 9) & 1) << 5); R = (st >> 1) * 16 + swz / 64; C = (st & 1) * 32 + (swz % 64) / 2; }
__device__ __forceinline__ int perm32(int rho) { const int n = rho >> 4, i = rho & 15; return 8 * (i >> 2) + 4 * n + (i & 3); }

struct Unit { const char* pa; const char* pb; char* po; float* sp; int rp, RS, CS; int pm, pn; };

__device__ __forceinline__ void tile_map(int wgid, int nM, int nN, int& pm, int& pn) {
    const int nwg = nM * nN;
    { const int q = nwg / NXCD, r = nwg % NXCD, xcd = wgid % NXCD, off = wgid / NXCD; wgid = (xcd < r ? xcd * (q + 1) : r * (q + 1) + (xcd - r) * q) + off; }
    const int nig = WGM * nN, gid = wgid / nig, fm = gid * WGM, gsz = (nM - fm) < WGM ? (nM - fm) : WGM;
    pm = fm + ((wgid % nig) % gsz); pn = (wgid % nig) / gsz;
}

template <class Epi, class Sched>
__device__ __forceinline__ void gemm_phase(LAS unsigned char* lds, const int K, const Sched& S, const Epi& E) {
    const int tid = threadIdx.x, wid = __builtin_amdgcn_readfirstlane(tid >> 6), lane = tid & 63, wr = wid >> 2, wc = wid & 3, fr = lane & 15, fq = lane >> 4;
    const int nt = K / BK;
    unsigned voffA[2], voffB[2];
#pragma unroll
    for (int i = 0; i < 2; ++i) { int R, C; stage_rc(tid * 16 + i * 8192, R, C); const int Rb = Epi::PERM ? ((R & ~31) + perm32(R & 31)) : R;
        voffA[i] = (unsigned)(R * K + C) * 2u; voffB[i] = (unsigned)(Rb * K + C) * 2u; }
    const size_t kstep = (size_t)(BK * 2);
    const size_t hstep = (size_t)HALF * K * 2;
    const unsigned ldsw = (unsigned)wid * 1024u;
    const int aoff = lds_byte(wr * 64 + fr, fq * 8), boff = lds_byte(wc * 32 + fr, fq * 8);
#define PG8_SA(b, h) (((b) * 2 + (h)) * HTB)
#define PG8_SB(b, h) ((4 + (b) * 2 + (h)) * HTB)
#define PG8_STAGE(bufoff, gbase, voff) do { _Pragma("unroll") for (int _i = 0; _i < 2; ++_i) \
        __builtin_amdgcn_global_load_lds((const unsigned*)((const char*)(gbase) + (voff)[_i]), (LAS unsigned*)(lds + (bufoff) + ldsw + _i * 8192), 16, 0, 0); } while (0)
#define PG8_LDA(dst, b, h) do { _Pragma("unroll") for (int m = 0; m < 4; ++m) _Pragma("unroll") for (int k = 0; k < 2; ++k) dst[m][k] = *(const LAS bf16x8*)(lds + PG8_SA(b, h) + aoff + m * 2048 + k * 1024); } while (0)
#define PG8_LDB(dst, b, h) do { _Pragma("unroll") for (int n = 0; n < 2; ++n) _Pragma("unroll") for (int k = 0; k < 2; ++k) dst[n][k] = *(const LAS bf16x8*)(lds + PG8_SB(b, h) + boff + n * 2048 + k * 1024); } while (0)
#define PG8_MMA(ai, bj, At, Bt) do { __builtin_amdgcn_s_setprio(1); _Pragma("unroll") for (int m = 0; m < 4; ++m) _Pragma("unroll") for (int n = 0; n < 2; ++n) _Pragma("unroll") for (int k = 0; k < 2; ++k) \
        acc[ai][bj][m][n] = __builtin_amdgcn_mfma_f32_16x16x32_bf16(Bt[n][k], At[m][k], acc[ai][bj][m][n], 0, 0, 0); __builtin_amdgcn_s_setprio(0); } while (0)
#define PG8_WAIT_V(n) asm volatile("s_waitcnt vmcnt(" #n ")" ::: "memory")
#define PG8_WAIT_L(n) asm volatile("s_waitcnt lgkmcnt(" #n ")" ::: "memory")
#define PG8_BAR __builtin_amdgcn_s_barrier()
#define PG8_SCHED __builtin_amdgcn_sched_barrier(0)
    Unit cur, nxt; int ui = 0;
    if (!S.next(0, cur)) return;
    f32x4 acc[2][2][4][2];
#pragma unroll
    for (int a = 0; a < 2; ++a)
#pragma unroll
        for (int b = 0; b < 2; ++b)
#pragma unroll
            for (int m = 0; m < 4; ++m)
#pragma unroll
                for (int n = 0; n < 2; ++n) acc[a][b][m][n] = (f32x4){0.f, 0.f, 0.f, 0.f};
    bf16x8 At[4][2], B0[2][2], B1[2][2];
    const char* cA = cur.pa; const char* cB = cur.pb;
    PG8_STAGE(PG8_SB(0, 0), cB, voffB); PG8_STAGE(PG8_SA(0, 0), cA, voffA); PG8_STAGE(PG8_SB(0, 1), cB + hstep, voffB); PG8_STAGE(PG8_SA(0, 1), cA + hstep, voffA);
    if (wr == 1) PG8_BAR;
    PG8_WAIT_V(4); PG8_BAR;
    PG8_STAGE(PG8_SB(1, 0), cB + kstep, voffB); PG8_STAGE(PG8_SA(1, 0), cA + kstep, voffA); PG8_STAGE(PG8_SB(1, 1), cB + hstep + kstep, voffB);
    PG8_WAIT_V(6); PG8_BAR;
    for (;;) {
        const bool has_next = S.next(ui + 1, nxt);
        const char* nA = has_next ? nxt.pa : cA; const char* nB = has_next ? nxt.pb : cB;
        for (int t = 0; t < nt; t += 2) {
            const bool last = (t == nt - 2);
            const char* a1 = cA + (size_t)(t + 1) * kstep;
            const char* a2 = last ? nA : cA + (size_t)(t + 2) * kstep; const char* b2 = last ? nB : cB + (size_t)(t + 2) * kstep;
            const char* a3 = a2 + kstep; const char* b3 = b2 + kstep;
            PG8_LDB(B0, 0, 0); PG8_SCHED; PG8_LDA(At, 0, 0); PG8_STAGE(PG8_SA(1, 1), a1 + hstep, voffA);
            PG8_WAIT_L(8); PG8_BAR; PG8_WAIT_L(0); PG8_MMA(0, 0, At, B0); PG8_BAR; PG8_SCHED;
            PG8_LDB(B1, 0, 1); PG8_STAGE(PG8_SB(0, 0), b2, voffB);
            PG8_BAR; PG8_WAIT_L(0); PG8_MMA(0, 1, At, B1); PG8_BAR;
            PG8_LDA(At, 0, 1); PG8_STAGE(PG8_SA(0, 0), a2, voffA);
            PG8_BAR; PG8_WAIT_L(0); PG8_MMA(1, 0, At, B0); PG8_BAR; PG8_SCHED;
            PG8_STAGE(PG8_SB(0, 1), b2 + hstep, voffB);
            PG8_WAIT_V(6); PG8_BAR; PG8_MMA(1, 1, At, B1); PG8_BAR;
            PG8_LDB(B0, 1, 0); PG8_SCHED; PG8_LDA(At, 1, 0); PG8_STAGE(PG8_SA(0, 1), a2 + hstep, voffA);
            PG8_WAIT_L(8); PG8_BAR; PG8_WAIT_L(0); PG8_MMA(0, 0, At, B0); PG8_BAR; PG8_SCHED;
            PG8_LDB(B1, 1, 1); PG8_STAGE(PG8_SB(1, 0), b3, voffB);
            PG8_BAR; PG8_WAIT_L(0); PG8_MMA(0, 1, At, B1); PG8_BAR;
            PG8_LDA(At, 1, 1); PG8_STAGE(PG8_SA(1, 0), a3, voffA);
            PG8_BAR; PG8_WAIT_L(0); PG8_MMA(1, 0, At, B0); PG8_BAR; PG8_SCHED;
            PG8_STAGE(PG8_SB(1, 1), b3 + hstep, voffB);
            PG8_WAIT_V(6); PG8_BAR; PG8_MMA(1, 1, At, B1); PG8_BAR;
        }
        if constexpr (!Epi::AFTER_DRAIN) E(acc, cur, wr, wc, fr, fq);
        if (!has_next) break;
#pragma unroll
        for (int a = 0; a < 2; ++a)
#pragma unroll
            for (int b = 0; b < 2; ++b)
#pragma unroll
                for (int m = 0; m < 4; ++m)
#pragma unroll
                    for (int n = 0; n < 2; ++n) acc[a][b][m][n] = (f32x4){0.f, 0.f, 0.f, 0.f};
        cur = nxt; cA = nA; cB = nB; ++ui;
    }
    PG8_WAIT_V(0);
    if (wr == 0) PG8_BAR;
    PG8_BAR;
    if constexpr (Epi::AFTER_DRAIN) E.fused(acc, cur, wr, wc, fr, fq, lds, wid, lane);
#undef PG8_SA
#undef PG8_SB
#undef PG8_STAGE
#undef PG8_LDA
#undef PG8_LDB
#undef PG8_MMA
#undef PG8_WAIT_V
#undef PG8_WAIT_L
#undef PG8_BAR
#undef PG8_SCHED
}

struct EpiTileBf16 {
    static constexpr bool PERM = true, AFTER_DRAIN = false;
    __device__ __forceinline__ void operator()(const f32x4 (&acc)[2][2][4][2], const Unit& u, int wr, int wc, int fr, int fq) const {
        bf16_t* base = (bf16_t*)u.po + (size_t)wr * u.RS + (size_t)fr * u.rp + (size_t)(wc >> 1) * u.CS + (wc & 1) * 32 + 8 * fq;
#pragma unroll
        for (int ai = 0; ai < 2; ++ai)
#pragma unroll
            for (int m = 0; m < 4; ++m) { bf16_t* rowp = base + (size_t)(2 * ai) * u.RS + (size_t)(m * 16) * u.rp;
#pragma unroll
                for (int bj = 0; bj < 2; ++bj) { const f32x4 v0 = acc[ai][bj][m][0], v1 = acc[ai][bj][m][1];
                    u32x4 w; w.x = cvt_pk_bf16(v0[0], v0[1]); w.y = cvt_pk_bf16(v0[2], v0[3]); w.z = cvt_pk_bf16(v1[0], v1[1]); w.w = cvt_pk_bf16(v1[2], v1[3]);
                    *(u32x4*)(rowp + (size_t)(2 * bj) * u.CS) = w; } }
        if (u.sp) {
#pragma unroll
            for (int ai = 0; ai < 2; ++ai)
#pragma unroll
                for (int m = 0; m < 4; ++m) { float s = 0.f;
#pragma unroll
                    for (int bj = 0; bj < 2; ++bj)
#pragma unroll
                        for (int n = 0; n < 2; ++n) { const f32x4 v = acc[ai][bj][m][n]; s += (v[0] - v[1]) + (v[2] - v[3]); }
                    s += __shfl_xor(s, 16); s += __shfl_xor(s, 32);
                    if (fq == 0) u.sp[(size_t)(ai * HALF + wr * 64 + m * 16 + fr) * 32 + wc] = s; }
        }
    }
};
struct EpiResid {
    static constexpr bool PERM = false, AFTER_DRAIN = false;
    const float* base; float* out; const float* gate; float* ssq;
    __device__ __forceinline__ void operator()(const f32x4 (&acc)[2][2][4][2], const Unit& u, int wr, int wc, int fr, int fq) const {
        const int row0 = u.pm * BM + wr * 64 + fr, col0 = u.pn * BM + wc * 32 + 4 * fq, b = u.pm >> 3;
        f32x4 gv[2][2];
#pragma unroll
        for (int bj = 0; bj < 2; ++bj)
#pragma unroll
            for (int n = 0; n < 2; ++n) gv[bj][n] = *(const f32x4*)(gate + (size_t)b * NMOD + col0 + bj * HALF + n * 16);
#pragma unroll
        for (int ai = 0; ai < 2; ++ai)
#pragma unroll
            for (int m = 0; m < 4; ++m) { const int row = row0 + ai * HALF + m * 16; const size_t off = (size_t)row * DM + col0; float s = 0.f;
#pragma unroll
                for (int bj = 0; bj < 2; ++bj)
#pragma unroll
                    for (int n = 0; n < 2; ++n) { const f32x4 xv = *(const f32x4*)(base + off + bj * HALF + n * 16); const f32x4 o = xv + gv[bj][n] * acc[ai][bj][m][n];
                        *(f32x4*)(out + off + bj * HALF + n * 16) = o; s += (o[0] * o[0] + o[1] * o[1]) + (o[2] * o[2] + o[3] * o[3]); }
                s += __shfl_xor(s, 16); s += __shfl_xor(s, 32);
                if (fq == 0) ssq[(size_t)row * 16 + u.pn * 4 + wc] = s; }
    }
};
struct EpiUp {
    static constexpr bool PERM = true, AFTER_DRAIN = false;
    bf16_t* A; bf16_t* side; const float* cw; const float* cb;
    __device__ __forceinline__ void operator()(f32x4 (&acc)[2][2][4][2], const Unit& u, int wr, int wc, int fr, int fq) const {
        const int J0 = u.pn * 128 + wc * 32 + fq * 8;
        if (fr < 2 || fr >= 14) {
            const int slot = fr < 2 ? fr : fr - 12;
#pragma unroll
            for (int ai = 0; ai < 2; ++ai) { const int chunk = u.pm * 4 + ai * 2 + wr;
#pragma unroll
                for (int bj = 0; bj < 2; ++bj) { const f32x4 a0 = fr < 2 ? acc[ai][bj][0][0] : acc[ai][bj][3][0], a1 = fr < 2 ? acc[ai][bj][0][1] : acc[ai][bj][3][1];
                    u32x4 w; w.x = cvt_pk_bf16(a0[0], a0[1]); w.y = cvt_pk_bf16(a0[2], a0[3]); w.z = cvt_pk_bf16(a1[0], a1[1]); w.w = cvt_pk_bf16(a1[2], a1[3]);
                    *(u32x4*)(side + (size_t)(chunk * 4 + slot) * (2 * DFF) + bj * DFF + J0) = w; } }
        }
        const bool f0 = (fr == 0), f15 = (fr == 15);
#pragma unroll
        for (int bj = 0; bj < 2; ++bj)
#pragma unroll
            for (int n = 0; n < 2; ++n) {
                const int col = bj * DFF + J0 + n * 4;
                const f32x4 k0 = *(const f32x4*)(cw + col), k1 = *(const f32x4*)(cw + 2 * DFF + col), k2 = *(const f32x4*)(cw + 4 * DFF + col), kb = *(const f32x4*)(cb + col);
#pragma unroll
                for (int ai = 0; ai < 2; ++ai) {
                    const f32x4 c0 = acc[ai][bj][0][n], c1 = acc[ai][bj][1][n], c2 = acc[ai][bj][2][n], c3 = acc[ai][bj][3][n];
                    f32x4 o0, o1, o2, o3;
#pragma unroll
                    for (int j = 0; j < 4; ++j) {
                        const float r0 = dpp_f<0x121>(c0[j]), r1 = dpp_f<0x121>(c1[j]), r2 = dpp_f<0x121>(c2[j]), r3 = dpp_f<0x121>(c3[j]);
                        const float l0 = dpp_f<0x12F>(c0[j]), l1 = dpp_f<0x12F>(c1[j]), l2 = dpp_f<0x12F>(c2[j]), l3 = dpp_f<0x12F>(c3[j]);
                        o0[j] = k0[j] * r0 + k1[j] * c0[j] + k2[j] * (f15 ? l1 : l0) + kb[j];
                        o1[j] = k0[j] * (f0 ? r0 : r1) + k1[j] * c1[j] + k2[j] * (f15 ? l2 : l1) + kb[j];
                        o2[j] = k0[j] * (f0 ? r1 : r2) + k1[j] * c2[j] + k2[j] * (f15 ? l3 : l2) + kb[j];
                        o3[j] = k0[j] * (f0 ? r2 : r3) + k1[j] * c3[j] + k2[j] * l3 + kb[j];
                    }
                    asm volatile("" : "+v"(o0), "+v"(o1), "+v"(o2), "+v"(o3));
                    acc[ai][bj][0][n] = o0; acc[ai][bj][1][n] = o1; acc[ai][bj][2][n] = o2; acc[ai][bj][3][n] = o3;
                }
            }
#pragma unroll
        for (int ai = 0; ai < 2; ++ai) { const int chunk = u.pm * 4 + ai * 2 + wr;
#pragma unroll
            for (int m = 0; m < 4; ++m) {
                const f32x4 g0 = acc[ai][0][m][0], g1 = acc[ai][0][m][1], v0 = acc[ai][1][m][0], v1 = acc[ai][1][m][1];
                u32x4 w; w.x = cvt_pk_bf16(silu_f(g0[0]) * v0[0], silu_f(g0[1]) * v0[1]); w.y = cvt_pk_bf16(silu_f(g0[2]) * v0[2], silu_f(g0[3]) * v0[3]);
                w.z = cvt_pk_bf16(silu_f(g1[0]) * v1[0], silu_f(g1[1]) * v1[1]); w.w = cvt_pk_bf16(silu_f(g1[2]) * v1[2], silu_f(g1[3]) * v1[3]);
                const bool valid = !((m == 0 && f0) || (m == 3 && f15));
                if (valid) *(u32x4*)(A + (size_t)(chunk * 64 + m * 16 + fr) * DFF + J0) = w;
            } }
    }
};
struct PanelSsq {
    float* xbuf; unsigned* cnt;
    __device__ __forceinline__ void run(const f32x4 (&v)[2][2][4][2], const Unit& u, int wr, int wc, int fr, int fq, LAS unsigned char* lds, int wid, int lane) const {
        LAS float* P = (LAS float*)lds; LAS float* S = (LAS float*)(lds + 4096);
#pragma unroll
        for (int ai = 0; ai < 2; ++ai)
#pragma unroll
            for (int m = 0; m < 4; ++m) { float s = 0.f;
#pragma unroll
                for (int bj = 0; bj < 2; ++bj)
#pragma unroll
                    for (int n = 0; n < 2; ++n) { const f32x4 x = v[ai][bj][m][n]; s += (x[0] * x[0] + x[1] * x[1]) + (x[2] * x[2] + x[3] * x[3]); }
                s += __shfl_xor(s, 16); s += __shfl_xor(s, 32);
                if (fq == 0) P[(ai * HALF + wr * 64 + m * 16 + fr) * 4 + wc] = s; }
        asm volatile("s_waitcnt lgkmcnt(0)" ::: "memory"); __builtin_amdgcn_s_barrier(); asm volatile("" ::: "memory");
        const int row = wid * 32 + (lane & 31);
        if (lane < 32) { const f32x4 a = *(const LAS f32x4*)(P + row * 4);
            __hip_atomic_store(xbuf + ((size_t)(u.pm * BM + row) * 4 + u.pn), (a[0] + a[1]) + (a[2] + a[3]), __ATOMIC_RELAXED, __HIP_MEMORY_SCOPE_AGENT); }
        asm volatile("s_waitcnt vmcnt(0)" ::: "memory");
        if (lane == 0) __hip_atomic_fetch_add(cnt + 64 * u.pm, 1u, __ATOMIC_RELAXED, __HIP_MEMORY_SCOPE_AGENT);
        if (wid == 0) { unsigned sp = 0;
            while ((unsigned)__builtin_amdgcn_readfirstlane(__hip_atomic_load(cnt + 64 * u.pm, __ATOMIC_RELAXED, __HIP_MEMORY_SCOPE_AGENT)) < 32u) { __builtin_amdgcn_s_sleep(2); if (++sp > (1u << 22)) break; }
            __builtin_amdgcn_fence(__ATOMIC_ACQUIRE, "agent"); }
        asm volatile("s_waitcnt vmcnt(0) lgkmcnt(0)" ::: "memory"); __builtin_amdgcn_s_barrier(); asm volatile("" ::: "memory");
        if (lane < 32) { const float* slot = xbuf + (size_t)(u.pm * BM + row) * 4; float t = 0.f;
#pragma unroll
            for (int k = 0; k < 4; ++k) t += __hip_atomic_load(slot + k, __ATOMIC_RELAXED, __HIP_MEMORY_SCOPE_AGENT);
            S[row] = 1.0f / sqrtf(t * (1.0f / DM) + EPS); }
        asm volatile("s_waitcnt lgkmcnt(0)" ::: "memory"); __builtin_amdgcn_s_barrier(); asm volatile("" ::: "memory");
    }
};
struct EpiResidNormMod {
    static constexpr bool PERM = false, AFTER_DRAIN = true;
    const float* base; bf16_t* x1b; const float* mod; int gate_off, sh_off, sc_off; const float* g; bf16_t* hn; PanelSsq st;
    __device__ __forceinline__ void fused(f32x4 (&acc)[2][2][4][2], const Unit& u, int wr, int wc, int fr, int fq, LAS unsigned char* lds, int wid, int lane) const {
        const int row0 = u.pm * BM + wr * 64 + fr, col0 = u.pn * BM + wc * 32 + 4 * fq, b = u.pm >> 3;
        const float* modb = mod + (size_t)b * NMOD + col0;
        { f32x4 gv[2][2];
#pragma unroll
          for (int bj = 0; bj < 2; ++bj)
#pragma unroll
            for (int n = 0; n < 2; ++n) gv[bj][n] = *(const f32x4*)(modb + gate_off + bj * HALF + n * 16);
#pragma unroll
          for (int ai = 0; ai < 2; ++ai)
#pragma unroll
            for (int m = 0; m < 4; ++m) { const size_t off = (size_t)(row0 + ai * HALF + m * 16) * DM + col0;
#pragma unroll
                for (int bj = 0; bj < 2; ++bj)
#pragma unroll
                    for (int n = 0; n < 2; ++n) { const f32x4 xv = *(const f32x4*)(base + off + bj * HALF + n * 16); const f32x4 o = xv + gv[bj][n] * acc[ai][bj][m][n];
                        u32x2 w; w.x = cvt_pk_bf16(o[0], o[1]); w.y = cvt_pk_bf16(o[2], o[3]); *(u32x2*)(x1b + off + bj * HALF + n * 16) = w; acc[ai][bj][m][n] = o; }
                asm volatile("" ::: "memory"); } }
        st.run(acc, u, wr, wc, fr, fq, lds, wid, lane);
        const LAS float* S = (const LAS float*)(lds + 4096);
#pragma unroll
        for (int bj = 0; bj < 2; ++bj)
#pragma unroll
            for (int n = 0; n < 2; ++n) { const int co = bj * HALF + n * 16;
                const f32x4 gg = *(const f32x4*)(g + col0 + co), sh = *(const f32x4*)(modb + sh_off + co), sc = *(const f32x4*)(modb + sc_off + co);
                const f32x4 mul = gg * (1.0f + sc);
#pragma unroll
                for (int ai = 0; ai < 2; ++ai)
#pragma unroll
                    for (int m = 0; m < 4; ++m) { const int r = ai * HALF + wr * 64 + m * 16 + fr; const float rstd = S[r];
                        const f32x4 h = (acc[ai][bj][m][n] * rstd) * mul + sh;
                        u32x2 w; w.x = cvt_pk_bf16(h[0], h[1]); w.y = cvt_pk_bf16(h[2], h[3]);
                        *(u32x2*)(hn + (size_t)(u.pm * BM + r) * DM + col0 + co) = w; } }
    }
};
struct EpiResidNormOut {
    static constexpr bool PERM = false, AFTER_DRAIN = true;
    const bf16_t* x1b; float* out; const float* mod; int gate_off; const float* g; PanelSsq st;
    __device__ __forceinline__ void fused(f32x4 (&acc)[2][2][4][2], const Unit& u, int wr, int wc, int fr, int fq, LAS unsigned char* lds, int wid, int lane) const {
        const int row0 = u.pm * BM + wr * 64 + fr, col0 = u.pn * BM + wc * 32 + 4 * fq, b = u.pm >> 3;
        const float* modb = mod + (size_t)b * NMOD + col0;
        { f32x4 gv[2][2];
#pragma unroll
          for (int bj = 0; bj < 2; ++bj)
#pragma unroll
            for (int n = 0; n < 2; ++n) gv[bj][n] = *(const f32x4*)(modb + gate_off + bj * HALF + n * 16);
#pragma unroll
          for (int ai = 0; ai < 2; ++ai)
#pragma unroll
            for (int m = 0; m < 4; ++m) { const size_t off = (size_t)(row0 + ai * HALF + m * 16) * DM + col0;
#pragma unroll
                for (int bj = 0; bj < 2; ++bj)
#pragma unroll
                    for (int n = 0; n < 2; ++n) { const u32x2 xw = *(const u32x2*)(x1b + off + bj * HALF + n * 16); const f32x4 xv = (f32x4){bf_lo(xw.x), bf_hi(xw.x), bf_lo(xw.y), bf_hi(xw.y)};
                        acc[ai][bj][m][n] = xv + gv[bj][n] * acc[ai][bj][m][n]; }
                asm volatile("" : "+v"(acc[ai][0][m][0]), "+v"(acc[ai][0][m][1]), "+v"(acc[ai][1][m][0]), "+v"(acc[ai][1][m][1]));
                asm volatile("" ::: "memory"); } }
        st.run(acc, u, wr, wc, fr, fq, lds, wid, lane);
        const LAS float* S = (const LAS float*)(lds + 4096);
        f32x4 gg[2][2];
#pragma unroll
        for (int bj = 0; bj < 2; ++bj)
#pragma unroll
            for (int n = 0; n < 2; ++n) gg[bj][n] = *(const f32x4*)(g + col0 + bj * HALF + n * 16);
#pragma unroll
        for (int ai = 0; ai < 2; ++ai)
#pragma unroll
            for (int m = 0; m < 4; ++m) { const int r = ai * HALF + wr * 64 + m * 16 + fr; const float rstd = S[r]; float* rowp = out + (size_t)(u.pm * BM + r) * DM + col0;
#pragma unroll
                for (int bj = 0; bj < 2; ++bj)
#pragma unroll
                    for (int n = 0; n < 2; ++n) *(f32x4*)(rowp + bj * HALF + n * 16) = (acc[ai][bj][m][n] * rstd) * gg[bj][n];
                asm volatile("" ::: "memory"); }
    }
};
}

struct SchedP2 {
    const char *H, *HE, *HO, *WQK, *WA; char *QK, *VT, *VTA; float* SP; int G, c;
    __device__ __forceinline__ bool next(int i, pg8::Unit& u) const {
        const int L = i * G + c; if (L >= 512) return false;
        constexpr size_t tstep = (size_t)256 * DM * 2;
        u.sp = nullptr;
        if (L < 256) { int pm, pn; pg8::tile_map(L, 64, 4, pm, pn); u.pm = pm; u.pn = pn; u.pa = H + pm * tstep; u.pb = WQK + pn * tstep;
            const int b = pm >> 3, s0 = (pm & 7) * 256, head0 = (pn & 1) * 4;
            u.po = QK + (size_t)(pn >> 1) * (16u << 20) + ((size_t)((b * 8 + head0) * SEQ + s0) * 64) * 2; u.rp = 64; u.RS = 64 * 64; u.CS = SEQ * 64; }
        else if (L < 384) { int pm, pn; pg8::tile_map(L - 256, 2, 64, pm, pn); u.pm = 4 + pm; u.pn = pn; u.pa = WA + (size_t)(4 + pm) * tstep; u.pb = H + pn * tstep;
            const int b = pn >> 3;
            u.po = VTA + ((size_t)((b * 8 + 4 * pm) * 32 + 4 * (pn & 7)) * 4096) * 2; u.rp = 64; u.RS = 32 * 4096; u.CS = 4096; }
        else { const int which = (L - 384) >> 6; int pm, pn; pg8::tile_map((L - 384) & 63, 2, 32, pm, pn); u.pm = which * 2 + pm; u.pn = pn;
            u.pa = WA + (size_t)(which * 2 + pm) * tstep; u.pb = (which ? HO : HE) + pn * tstep;
            const int b = pn >> 2, st = pn & 3;
            u.po = VT + (size_t)which * (8u << 20) + ((size_t)(b * 512 + pm * 256) * 1024 + st * 256) * 2; u.rp = 1024; u.RS = 64 * 1024; u.CS = 64;
            if (!which) u.sp = SP + ((size_t)(b * 512 + pm * 256) * 32 + st * 4); }
        return true;
    }
};
struct SchedFourier {
    const char *CS, *VT; char* PQ; int G, c;
    __device__ __forceinline__ bool next(int i, pg8::Unit& u) const {
        const int L = i * G + c; if (L >= 128) return false;
        int pm, pn; pg8::tile_map(L, 8, 16, pm, pn); u.pm = pm; u.pn = pn;
        constexpr size_t tstep = (size_t)256 * 1024 * 2;
        u.pa = CS + pm * tstep; u.pb = VT + (size_t)(pm >> 2) * (8u << 20) + pn * tstep; u.po = PQ + ((size_t)pm * 256 * 4096 + pn * 256) * 2; u.rp = 4096; u.RS = 64 * 4096; u.CS = 64; u.sp = nullptr;
        return true;
    }
};
struct SchedPlain {
    const char *A, *B; int nM, nN, K, G, c;
    __device__ __forceinline__ bool next(int i, pg8::Unit& u) const {
        const int L = i * G + c; if (L >= nM * nN) return false;
        int pm, pn; pg8::tile_map(L, nM, nN, pm, pn); u.pm = pm; u.pn = pn;
        const size_t tstep = (size_t)256 * K * 2;
        u.pa = A + pm * tstep; u.pb = B + pn * tstep; u.po = nullptr; u.sp = nullptr; u.rp = 0; u.RS = 0; u.CS = 0;
        return true;
    }
};

__device__ __forceinline__ void p0_mod_item(const Params& p, LAS unsigned char* lds, int item) {
    LAS float* cs = (LAS float*)lds;
    LAS float* red = (LAS float*)(lds + 32768);
    const int tid = threadIdx.x;
    for (int u = tid; u < NBATCH * DM; u += NTHREADS) { const float v = p.c[u]; cs[u] = v / (1.0f + __expf(-v)); }
    __syncthreads();
    const int j0 = item * 64, l16 = tid & 15, rs = tid >> 4;
    f32x4 acc[8];
#pragma unroll
    for (int b = 0; b < 8; ++b) acc[b] = (f32x4){0.f, 0.f, 0.f, 0.f};
#pragma unroll 32
    for (int pass = 0; pass < 32; ++pass) { const int i = pass * 32 + rs; const f32x4 w = *(const f32x4*)(p.w_ada + (size_t)i * NMOD + j0 + 4 * l16);
#pragma unroll
        for (int b = 0; b < 8; ++b) acc[b] += cs[b * DM + i] * w; }
#pragma unroll
    for (int b = 0; b < 8; ++b) *(LAS f32x4*)(red + (rs * 8 + b) * 64 + 4 * l16) = acc[b];
    __syncthreads();
    { const int b = tid >> 6, col = tid & 63; float s = p.b_ada[j0 + col];
#pragma unroll 8
      for (int r = 0; r < 32; ++r) s += red[(r * 8 + b) * 64 + col];
      ((float*)(p.ws + WS_MOD))[(size_t)b * NMOD + j0 + col] = s; }
    asm volatile("s_waitcnt vmcnt(0)" ::: "memory");
    __syncthreads();
    if (tid == 0) {
        __builtin_amdgcn_fence(__ATOMIC_RELEASE, "agent");
        asm volatile("s_waitcnt vmcnt(0)" ::: "memory");
        __hip_atomic_fetch_add((unsigned*)(p.ws + WS_BAR) + 3712, 1u, __ATOMIC_RELAXED, __HIP_MEMORY_SCOPE_AGENT);
    }
}
typedef float f32x16 __attribute__((ext_vector_type(16)));
__device__ __forceinline__ void p0_fold_item(const Params& p, LAS unsigned char* lds, int item) {
    LAS float* Wf = (LAS float*)lds;
    LAS float* Gm = (LAS float*)(lds + 65536);
    LAS float* wt = (LAS float*)(lds + 131072);
    const int tid = threadIdx.x, lane = tid & 63, w = tid >> 6, which = item >> 6, g = (item >> 4) & 3, ib = (item & 15) * 64;
    for (int u = tid; u < 4096; u += NTHREADS) *(LAS f32x4*)(Wf + 4 * u) = *(const f32x4*)(p.w_four + (size_t)g * 16384 + 4 * u);
    __syncthreads();
    {
        const int mt = w >> 1, nt0 = (w & 1) * 2, li = lane & 31, lk = lane >> 5, c = mt * 32 + li;
        f32x16 acc0, acc1;
#pragma unroll
        for (int r = 0; r < 16; ++r) { acc0[r] = 0.f; acc1[r] = 0.f; }
#pragma unroll 4
        for (int ks = 0; ks < 64; ++ks) { const int e = 2 * ks + lk; const float ang = (float)((c * e) & 127) * (1.0f / 128.0f);
            const float a = (which ? __builtin_amdgcn_sinf(ang) : __builtin_amdgcn_cosf(ang)) * 0.08838834764831845f;
            const float b0 = Wf[e * 128 + nt0 * 32 + li], b1 = Wf[e * 128 + nt0 * 32 + 32 + li];
            acc0 = __builtin_amdgcn_mfma_f32_32x32x2f32(a, b0, acc0, 0, 0, 0); acc1 = __builtin_amdgcn_mfma_f32_32x32x2f32(a, b1, acc1, 0, 0, 0); }
#pragma unroll
        for (int r = 0; r < 16; ++r) { const int row = mt * 32 + (r & 3) + 8 * (r >> 2) + 4 * lk; Gm[row * 128 + nt0 * 32 + li] = acc0[r]; Gm[row * 128 + nt0 * 32 + 32 + li] = acc1[r]; }
    }
    for (int sub = 0; sub < 2; ++sub) { const int i0 = ib + sub * 32;
    for (int u = tid; u < 4096; u += NTHREADS) { const int il = u >> 7, c = u & 127; wt[il * 129 + c] = p.w_in[(size_t)(i0 + il) * 2048 + g * 128 + c]; }
    __syncthreads();
    {
        const int li = lane & 15, lk = lane >> 4;
        f32x4 acc0 = (f32x4){0.f, 0.f, 0.f, 0.f}, acc1 = (f32x4){0.f, 0.f, 0.f, 0.f};
#pragma unroll 4
        for (int ks = 0; ks < 32; ++ks) { const int c = 4 * ks + lk; const float a = Gm[c * 128 + 16 * w + li], b0 = wt[li * 129 + c], b1 = wt[(16 + li) * 129 + c];
            acc0 = __builtin_amdgcn_mfma_f32_16x16x4f32(a, b0, acc0, 0, 0, 0); acc1 = __builtin_amdgcn_mfma_f32_16x16x4f32(a, b1, acc1, 0, 0, 0); }
        bf16_t* WA = (bf16_t*)(p.ws + WS_WA);
#pragma unroll
        for (int r = 0; r < 4; ++r) { const int d = 16 * w + lk * 4 + r; bf16_t* rowp = WA + (size_t)(which * 512 + g * 128 + d) * DM + i0;
            rowp[li] = (bf16_t)(cvt_pk_bf16(acc0[r], 0.f) & 0xffffu); rowp[16 + li] = (bf16_t)(cvt_pk_bf16(acc1[r], 0.f) & 0xffffu); }
    }
    __syncthreads();
    }
}
__device__ __forceinline__ void p0_transpose_item(const float* W, int ldw, int ncol0, int K, bf16_t* WT, int orow, const float* gk, LAS float* scr, int kb, int lane) {
    const int k0 = 64 * kb;
#pragma unroll 8
    for (int i = 0; i < 32; ++i) { const int kk = 2 * i + (lane >> 5); float v = W[(size_t)(k0 + kk) * ldw + ncol0 + (lane & 31)]; if (gk) v *= gk[k0 + kk]; scr[kk * 33 + (lane & 31)] = v; }
    asm volatile("s_waitcnt lgkmcnt(0)" ::: "memory");
    const int c = lane & 7;
#pragma unroll
    for (int j = 0; j < 4; ++j) { const int n = (lane >> 3) + 8 * j; const LAS float* s = scr + (8 * c) * 33 + n;
        u32x4 o; o.x = cvt_pk_bf16(s[0 * 33], s[1 * 33]); o.y = cvt_pk_bf16(s[2 * 33], s[3 * 33]); o.z = cvt_pk_bf16(s[4 * 33], s[5 * 33]); o.w = cvt_pk_bf16(s[6 * 33], s[7 * 33]);
        *(u32x4*)(WT + (size_t)(orow + n) * K + k0 + 8 * c) = o; }
    asm volatile("s_waitcnt lgkmcnt(0)" ::: "memory");
}
__device__ __forceinline__ void p0_prologue(const Params& p, LAS unsigned char* lds) {
    const int tid = threadIdx.x, lane = tid & 63, wave = tid >> 6, G = gridDim.x;
    if (G == 256) {
        if (blockIdx.x < 128) p0_fold_item(p, lds, blockIdx.x); else if (blockIdx.x < 224) p0_mod_item(p, lds, blockIdx.x - 128);
    } else { for (int it = blockIdx.x; it < 96; it += G) p0_mod_item(p, lds, it);
        for (int it = blockIdx.x; it < 128; it += G) p0_fold_item(p, lds, it); }
    LAS float* scr = (LAS float*)(lds + wave * 16384);
    const int gw = blockIdx.x * NWAVES + wave, NGW = G * NWAVES;
    constexpr int I_QK = 16 * 32, I_V = 16 * 16;
    for (int it = gw; it < I_QK + I_V; it += NGW) {
        int r = it;
        if (r < I_QK) { const int kb = r >> 5, nb = r & 31; p0_transpose_item(p.w_in, 2048, 512 + nb * 32, DM, (bf16_t*)(p.ws + WS_WQK), nb * 32, nullptr, scr, kb, lane); continue; } r -= I_QK;
        { const int kb = r >> 4, nb = r & 15; p0_transpose_item(p.w_in, 2048, 1536 + nb * 32, DM, (bf16_t*)(p.ws + WS_WA), 1024 + nb * 32, nullptr, scr, kb, lane); }
    }
}
__device__ __forceinline__ void late_work(const Params& p, LAS unsigned char* lds, int hidx, int nh, int what) {
    const int tid = threadIdx.x, lane = tid & 63, wave = tid >> 6;
    LAS float* scr = (LAS float*)(lds + wave * 16384);
    const int gw = hidx * NWAVES + wave, NGW = nh * NWAVES;
    constexpr int I_O = 16 * 32, I_UP = 16 * 176, I_DN = 44 * 32;
    const int it_lo = (what & 1) ? 0 : I_O + I_UP, it_hi = (what & 2) ? I_O + I_UP + I_DN : ((what & 1) ? I_O + I_UP : it_lo);
    for (int it = it_lo + gw; it < it_hi; it += NGW) {
        int r = it;
        if (r < I_O) { const int kb = r >> 5, nb = r & 31; p0_transpose_item(p.w_out, DM, nb * 32, DM, (bf16_t*)(p.ws + WS_WOUT), nb * 32, kb < 8 ? p.g_four_out : p.g_na_out - 512, scr, kb, lane); continue; } r -= I_O;
        if (r < I_UP) { const int kb = r / 176, nb = r % 176; const int n0 = nb * 32; const int isv = n0 >= DFF, j = isv ? n0 - DFF : n0;
            p0_transpose_item(p.w_up, 2 * DFF, n0, DM, (bf16_t*)(p.ws + WS_WUP), (j >> 7) * 256 + isv * 128 + (j & 127), nullptr, scr, kb, lane); continue; } r -= I_UP;
        { const int kb = r >> 5, nb = r & 31; p0_transpose_item(p.w_down, DM, nb * 32, DFF, (bf16_t*)(p.ws + WS_WDN), nb * 32, nullptr, scr, kb, lane); }
    }
    bf16_t* CS = (bf16_t*)(p.ws + WS_CS);
    if (what & 4) for (int u = hidx * NTHREADS + tid; u < 2048 * 128; u += nh * NTHREADS) { const int kp = u >> 7, s0 = (u & 127) * 8, k = kp & 1023; float v[8];
#pragma unroll
        for (int j = 0; j < 8; ++j) { const float ang = (float)((k * (s0 + j)) & 2047) * (1.0f / 2048.0f); v[j] = (kp >= 1024 ? __builtin_amdgcn_sinf(ang) : __builtin_amdgcn_cosf(ang)) * 0.022097086912079608f; }
        u32x4 o; o.x = cvt_pk_bf16(v[0], v[1]); o.y = cvt_pk_bf16(v[2], v[3]); o.z = cvt_pk_bf16(v[4], v[5]); o.w = cvt_pk_bf16(v[6], v[7]);
        *(u32x4*)(CS + (size_t)kp * 1024 + s0) = o; }
}

__device__ __forceinline__ void pass_norm_mod(const float* src, const float* ssq, const float* g, const float* mod, int sh_off, int sc_off, bf16_t* dst) {
    constexpr int RW = 4;
    const int lane = threadIdx.x & 63, gw = blockIdx.x * NWAVES + (threadIdx.x >> 6), NGW = gridDim.x * NWAVES;
    if (!ssq && NGW == 2048) {
        const int rowb = gw * 8, b = rowb >> 11;
        f32x4 mul[4], sh[4];
#pragma unroll
        for (int j = 0; j < 4; ++j) { const f32x4 gg = ((const f32x4*)g)[lane + 64 * j], sc = ((const f32x4*)(mod + (size_t)b * NMOD + sc_off))[lane + 64 * j];
            mul[j] = gg * (1.0f + sc); sh[j] = ((const f32x4*)(mod + (size_t)b * NMOD + sh_off))[lane + 64 * j]; }
#pragma unroll
        for (int half = 0; half < 2; ++half) {
            f32x4 v[RW][4];
#pragma unroll
            for (int q = 0; q < RW; ++q) { const f32x4* xr = (const f32x4*)(src + (size_t)(rowb + half * RW + q) * DM) + lane;
#pragma unroll
                for (int j = 0; j < 4; ++j) v[q][j] = xr[64 * j]; }
#pragma unroll
            for (int q = 0; q < RW; ++q) { float t = 0.f;
#pragma unroll
                for (int j = 0; j < 4; ++j) t += (v[q][j][0] * v[q][j][0] + v[q][j][1] * v[q][j][1]) + (v[q][j][2] * v[q][j][2] + v[q][j][3] * v[q][j][3]);
                t = wave_sum(t); const float rstd = 1.0f / sqrtf(t * (1.0f / DM) + EPS);
                u32x2* o8 = (u32x2*)(dst + (size_t)(rowb + half * RW + q) * DM) + lane;
#pragma unroll
                for (int j = 0; j < 4; ++j) { const f32x4 h = (v[q][j] * rstd) * mul[j] + sh[j]; u32x2 w; w.x = cvt_pk_bf16(h[0], h[1]); w.y = cvt_pk_bf16(h[2], h[3]); o8[64 * j] = w; } }
        }
        return;
    }
    for (int row0 = gw; row0 < NTOK; row0 += RW * NGW) {
        f32x4 v[RW][4]; float s[RW];
#pragma unroll
        for (int q = 0; q < RW; ++q) { const int row = min(row0 + q * NGW, NTOK - 1); const f32x4* xr = (const f32x4*)(src + (size_t)row * DM) + lane;
#pragma unroll
            for (int j = 0; j < 4; ++j) v[q][j] = xr[64 * j]; }
#pragma unroll
        for (int q = 0; q < RW; ++q) { const int row = min(row0 + q * NGW, NTOK - 1); float t = 0.f;
#pragma unroll
            for (int j = 0; j < 4; ++j) t += (v[q][j][0] * v[q][j][0] + v[q][j][1] * v[q][j][1]) + (v[q][j][2] * v[q][j][2] + v[q][j][3] * v[q][j][3]);
            if (ssq) { t = ssq[(size_t)row * 16 + (lane & 15)]; t += __shfl_xor(t, 1); t += __shfl_xor(t, 2); t += __shfl_xor(t, 4); t += __shfl_xor(t, 8); }
            else t = wave_sum(t);
            s[q] = 1.0f / sqrtf(t * (1.0f / DM) + EPS); }
#pragma unroll
        for (int q = 0; q < RW; ++q) { const int row = row0 + q * NGW; if (row < NTOK) { const int b = row >> 11;
            const f32x4* g4 = (const f32x4*)g + lane; const f32x4* sh4 = (const f32x4*)(mod + (size_t)b * NMOD + sh_off) + lane; const f32x4* sc4 = (const f32x4*)(mod + (size_t)b * NMOD + sc_off) + lane;
            u32x2* o8 = (u32x2*)(dst + (size_t)row * DM) + lane;
#pragma unroll
            for (int j = 0; j < 4; ++j) { const f32x4 gg = g4[64 * j], sh = sh4[64 * j], sc = sc4[64 * j]; const f32x4 h = (v[q][j] * s[q] * gg) * (1.0f + sc) + sh;
                u32x2 w; w.x = cvt_pk_bf16(h[0], h[1]); w.y = cvt_pk_bf16(h[2], h[3]); o8[64 * j] = w; } } }
    }
}
__device__ __forceinline__ void pass_h_fold(const float* src, const float* g, const float* mod, bf16_t* H, bf16_t* HE, bf16_t* HO) {
    const int vb = (gridDim.x & 7) ? (int)blockIdx.x : (int)((blockIdx.x & 7) * (gridDim.x >> 3) + (blockIdx.x >> 3));
    const int lane = threadIdx.x & 63, gw = vb * NWAVES + (threadIdx.x >> 6), NGW = gridDim.x * NWAVES;
    for (int ch = gw; ch < 2048; ch += NGW) {
        const int b = ch >> 8, sb = (ch & 255) * 4;
        f32x4 mul[4], sh[4];
#pragma unroll
        for (int j = 0; j < 4; ++j) { const f32x4 gg = ((const f32x4*)g)[lane + 64 * j], sc = ((const f32x4*)(mod + (size_t)b * NMOD + DM))[lane + 64 * j];
            mul[j] = gg * (1.0f + sc); sh[j] = ((const f32x4*)(mod + (size_t)b * NMOD))[lane + 64 * j]; }
#pragma unroll
        for (int half = 0; half < 2; ++half) {
            f32x4 v[2][2][4];
#pragma unroll
            for (int q = 0; q < 2; ++q) { const int s = sb + half * 2 + q, pr = (s == 0) ? SEQ / 2 : SEQ - s;
                const f32x4* x0 = (const f32x4*)(src + (size_t)(b * SEQ + s) * DM) + lane; const f32x4* x1 = (const f32x4*)(src + (size_t)(b * SEQ + pr) * DM) + lane;
#pragma unroll
                for (int j = 0; j < 4; ++j) { v[q][0][j] = x0[64 * j]; v[q][1][j] = x1[64 * j]; } }
#pragma unroll
            for (int q = 0; q < 2; ++q) { const int s = sb + half * 2 + q, pr = (s == 0) ? SEQ / 2 : SEQ - s;
                float t0 = 0.f, t1 = 0.f;
#pragma unroll
                for (int j = 0; j < 4; ++j) { const f32x4 a = v[q][0][j], c = v[q][1][j]; t0 += (a[0] * a[0] + a[1] * a[1]) + (a[2] * a[2] + a[3] * a[3]); t1 += (c[0] * c[0] + c[1] * c[1]) + (c[2] * c[2] + c[3] * c[3]); }
                t0 = wave_sum(t0); t1 = wave_sum(t1);
                const float r0 = 1.0f / sqrtf(t0 * (1.0f / DM) + EPS), r1 = 1.0f / sqrtf(t1 * (1.0f / DM) + EPS);
                u32x2* o0 = (u32x2*)(H + (size_t)(b * SEQ + s) * DM) + lane; u32x2* o1 = (u32x2*)(H + (size_t)(b * SEQ + pr) * DM) + lane;
                u32x2* oe = (u32x2*)(HE + (size_t)(b * 1024 + s) * DM) + lane; u32x2* oo = (u32x2*)(HO + (size_t)(b * 1024 + s) * DM) + lane;
#pragma unroll
                for (int j = 0; j < 4; ++j) { const f32x4 h0 = (v[q][0][j] * r0) * mul[j] + sh[j], h1 = (v[q][1][j] * r1) * mul[j] + sh[j];
                    u32x2 w; w.x = cvt_pk_bf16(h0[0], h0[1]); w.y = cvt_pk_bf16(h0[2], h0[3]); o0[64 * j] = w;
                    w.x = cvt_pk_bf16(h1[0], h1[1]); w.y = cvt_pk_bf16(h1[2], h1[3]); o1[64 * j] = w;
                    const f32x4 e = (s == 0) ? h0 : h0 + h1, o = (s == 0) ? (f32x4){0.f, 0.f, 0.f, 0.f} : h0 - h1;
                    w.x = cvt_pk_bf16(e[0], e[1]); w.y = cvt_pk_bf16(e[2], e[3]); oe[64 * j] = w;
                    w.x = cvt_pk_bf16(o[0], o[1]); w.y = cvt_pk_bf16(o[2], o[3]); oo[64 * j] = w; } }
        }
    }
}
__device__ __forceinline__ void pass_xmid(const bf16_t* H, const bf16_t* WA, float* X) {
    const int lane = threadIdx.x & 63, gw = blockIdx.x * NWAVES + (threadIdx.x >> 6), NGW = gridDim.x * NWAVES;
    for (int t = gw; t < NBATCH * 512; t += NGW) { const int b = t >> 9, c = t & 511;
        const u32x4* hp = (const u32x4*)(H + (size_t)(b * SEQ + SEQ / 2) * DM) + lane * 2; const u32x4* wp = (const u32x4*)(WA + (size_t)c * DM) + lane * 2;
        float s = 0.f;
#pragma unroll
        for (int q = 0; q < 2; ++q) { const u32x4 hv = hp[q], wv = wp[q];
#pragma unroll
            for (int j = 0; j < 4; ++j) s += bf_lo(hv[j]) * bf_lo(wv[j]) + bf_hi(hv[j]) * bf_hi(wv[j]); }
        s = wave_sum(s);
        if (lane == 0) X[t] = s; }
}
__device__ __forceinline__ void pass_final(float* xo, const float* ssq, const float* g) {
    const int lane = threadIdx.x & 63, gw = blockIdx.x * NWAVES + (threadIdx.x >> 6), NGW = gridDim.x * NWAVES;
    for (int row = gw; row < NTOK; row += NGW) {
        f32x4* xr = (f32x4*)(xo + (size_t)row * DM) + lane;
        float s = ssq[(size_t)row * 16 + (lane & 15)]; s += __shfl_xor(s, 1); s += __shfl_xor(s, 2); s += __shfl_xor(s, 4); s += __shfl_xor(s, 8);
        const float rstd = 1.0f / sqrtf(s * (1.0f / DM) + EPS);
        const f32x4* g4 = (const f32x4*)g + lane;
#pragma unroll
        for (int j = 0; j < 4; ++j) { const f32x4 v = xr[64 * j]; xr[64 * j] = v * rstd * g4[64 * j]; }
    }
}
__device__ __forceinline__ void combine_row(int row, const float (&y)[8], const float* SSQNA, bf16_t* YCAT, int lane) {
    float s = 0.f;
#pragma unroll
    for (int j = 0; j < 8; ++j) s += y[j] * y[j];
    s = wave_sum(s);
    const float rstd = 1.0f / sqrtf(s * (1.0f / 512.0f) + EPS);
    u32x4 o; o.x = cvt_pk_bf16(y[0] * rstd, y[1] * rstd); o.y = cvt_pk_bf16(y[2] * rstd, y[3] * rstd); o.z = cvt_pk_bf16(y[4] * rstd, y[5] * rstd); o.w = cvt_pk_bf16(y[6] * rstd, y[7] * rstd);
    *(u32x4*)(YCAT + (size_t)row * DM + lane * 8) = o;
    float t = SSQNA[(size_t)row * 8 + (lane & 7)]; t += __shfl_xor(t, 1); t += __shfl_xor(t, 2); t += __shfl_xor(t, 4);
    const float rn = 1.0f / sqrtf(t * (1.0f / 512.0f) + EPS);
    u32x4* ap = (u32x4*)(YCAT + (size_t)row * DM + 512 + lane * 8); const u32x4 aw = *ap; u32x4 ow;
#pragma unroll
    for (int j = 0; j < 4; ++j) ow[j] = cvt_pk_bf16(bf_lo(aw[j]) * rn, bf_hi(aw[j]) * rn);
    *ap = ow;
}
__device__ __forceinline__ void pass_combine(const bf16_t* PQ, const float* SP, const float* XM, const float* SSQNA, bf16_t* YCAT) {
    const int vb = (gridDim.x & 7) ? (int)blockIdx.x : (int)((blockIdx.x & 7) * (gridDim.x >> 3) + (blockIdx.x >> 3));
    const int lane = threadIdx.x & 63, gw = vb * NWAVES + (threadIdx.x >> 6), NGW = gridDim.x * NWAVES;
    for (int pi0 = gw; pi0 < NBATCH * 1024; pi0 += NGW) {
        const int pi = (NGW == 2048) ? gw * 4 + (pi0 - gw) / NGW : pi0;
        const int b = pi >> 10, kk = pi & 1023;
        const u32x4 pw = *(const u32x4*)(PQ + (size_t)kk * 4096 + b * 512 + lane * 8), qw = *(const u32x4*)(PQ + (size_t)(1024 + kk) * 4096 + b * 512 + lane * 8);
        float y1[8], y2[8];
        const f32x4 xa = *(const f32x4*)(XM + b * 512 + lane * 8), xb = *(const f32x4*)(XM + b * 512 + lane * 8 + 4); const float xs = (kk & 1) ? -0.022097086912079608f : 0.022097086912079608f;
        const float xm[8] = {xa[0] * xs, xa[1] * xs, xa[2] * xs, xa[3] * xs, xb[0] * xs, xb[1] * xs, xb[2] * xs, xb[3] * xs};
#pragma unroll
        for (int j = 0; j < 4; ++j) { const float pl = bf_lo(pw[j]) + xm[2 * j], ph = bf_hi(pw[j]) + xm[2 * j + 1], ql = bf_lo(qw[j]), qh = bf_hi(qw[j]); y1[2 * j] = pl - ql; y1[2 * j + 1] = ph - qh; y2[2 * j] = pl + ql; y2[2 * j + 1] = ph + qh; }
        if (kk == 0) {
#pragma unroll
            for (int j = 0; j < 8; ++j) { const f32x4* sp = (const f32x4*)(SP + (size_t)(b * 512 + lane * 8 + j) * 32); f32x4 a = sp[0];
#pragma unroll
                for (int i = 1; i < 4; ++i) a += sp[i];
                y2[j] = ((a[0] + a[1]) + (a[2] + a[3])) * 0.022097086912079608f + xm[j]; }
        }
        combine_row(b * SEQ + kk, y1, SSQNA, YCAT, lane);
        combine_row(b * SEQ + (kk == 0 ? 1024 : SEQ - kk), y2, SSQNA, YCAT, lane);
    }
}
__device__ __forceinline__ void pass_fixup(const bf16_t* side, const float* cw, const float* cb, bf16_t* A, int ri0, int nri, int widx, int nw) {
    const int total = nri * (DFF / 4);
    for (int u = widx * NTHREADS + threadIdx.x; u < total; u += nw * NTHREADS) {
        const int ri = ri0 + u / (DFF / 4), J = (u % (DFF / 4)) * 4, chunk = ri >> 1, bot = ri & 1;
        const bf16_t* sc = side + (size_t)chunk * 4 * (2 * DFF);
        const bf16_t *pp, *pc, *pn; bool hp = true, hn = true; int tok;
        if (!bot) { hp = (chunk & 31) != 0; pp = sc - (2 * DFF); pc = sc; pn = sc + (2 * DFF); tok = chunk * 64; }
        else { hn = (chunk & 31) != 31; pp = sc + 2 * (2 * DFF); pc = sc + 3 * (2 * DFF); pn = sc + 4 * (2 * DFF); tok = chunk * 64 + 63; }
        float up[2][4];
#pragma unroll
        for (int bj = 0; bj < 2; ++bj) {
            const int col = bj * DFF + J;
            u32x2 wp = (u32x2){0u, 0u}, wn = (u32x2){0u, 0u}; if (hp) wp = *(const u32x2*)(pp + col); if (hn) wn = *(const u32x2*)(pn + col); const u32x2 wc2 = *(const u32x2*)(pc + col);
            const f32x4 k0 = *(const f32x4*)(cw + col), k1 = *(const f32x4*)(cw + 2 * DFF + col), k2 = *(const f32x4*)(cw + 4 * DFF + col), kb = *(const f32x4*)(cb + col);
            const float pv[4] = {bf_lo(wp.x), bf_hi(wp.x), bf_lo(wp.y), bf_hi(wp.y)}, cv[4] = {bf_lo(wc2.x), bf_hi(wc2.x), bf_lo(wc2.y), bf_hi(wc2.y)}, nv[4] = {bf_lo(wn.x), bf_hi(wn.x), bf_lo(wn.y), bf_hi(wn.y)};
#pragma unroll
            for (int j = 0; j < 4; ++j) up[bj][j] = k0[j] * pv[j] + k1[j] * cv[j] + k2[j] * nv[j] + kb[j];
        }
        u32x2 w; w.x = cvt_pk_bf16(silu_f(up[0][0]) * up[1][0], silu_f(up[0][1]) * up[1][1]); w.y = cvt_pk_bf16(silu_f(up[0][2]) * up[1][2], silu_f(up[0][3]) * up[1][3]);
        *(u32x2*)(A + (size_t)tok * DFF + J) = w;
    }
}

__device__ __forceinline__ void attn_phase(const Params& p, LAS unsigned char* lds) {
    const int tid = threadIdx.x, lane = tid & 63, w = __builtin_amdgcn_readfirstlane(tid >> 6), fr = lane & 15, fq = lane >> 4;
    LAS unsigned char* Ks = lds;
    LAS unsigned char* Vs = lds + 73728;
    LAS float* rp = (LAS float*)(lds + 147456);
    volatile LAS unsigned* slot = (volatile LAS unsigned*)(lds + 147456 + 2048);
    const bf16_t* QH = (const bf16_t*)(p.ws + WS_QK); const bf16_t* KH = (const bf16_t*)(p.ws + WS_QK + (16u << 20)); const bf16_t* VTA = (const bf16_t*)(p.ws + WS_VTA);
    bf16_t* YCAT = (bf16_t*)(p.ws + WS_YCAT); float* SSQNA = (float*)(p.ws + WS_SSQ1 + 512 * 1024);
    const float sc2 = 0.125f * 1.4426950408889634f;
    unsigned* ctr = (unsigned*)(p.ws + WS_BAR) + 3584;
    const int ri = w >> 2, qb = w & 3, q0 = qb * 16, kc0 = min(max(q0 - 8, 0), 32);
    const int kperm = 8 * (fr >> 2) + (fr & 3);
    for (;;) {
        __syncthreads();
        if (tid == 0) slot[0] = __hip_atomic_fetch_add(ctr, 1u, __ATOMIC_RELAXED, __HIP_MEMORY_SCOPE_AGENT);
        __syncthreads();
        const int item = (int)slot[0];
        if (item >= 1024) break;
        const int b = item >> 7, h = (item >> 4) & 7, r0 = (item & 15) * 2, R0 = min(max(r0 - 4, 0), 24);
        const int r = r0 + ri, rs = min(max(r - 4, 0), 24), j0 = rs - R0;
        const int tq = b * SEQ + r * 64 + q0 + fr;
        const bf16_t* qp = QH + ((size_t)(b * 8 + h) * SEQ + r * 64 + q0 + fr) * 64 + fq * 8;
        const bf16x8 qf0 = *(const bf16x8*)qp, qf1 = *(const bf16x8*)(qp + 32);
        for (int u = tid; u < 465; u += NTHREADS) rp[u] = p.rpb[h * 465 + u] * 1.4426950408889634f;
        { const int t = tid >> 3, c = tid & 7; const unsigned dstk = (unsigned)(t * 128 + ((c ^ (((t >> 1) & 1) | (((t >> 3) & 3) << 1))) << 4)), dstv = (unsigned)(t * 128 + ((c ^ ((t >> 1) & 7)) << 4));
          u32x4 kv[9], vv[9];
#pragma unroll
          for (int j = 0; j < 9; ++j) { const int srow = min(R0 + j, 31);
              kv[j] = *(const u32x4*)(KH + ((size_t)(b * 8 + h) * SEQ + srow * 64 + t) * 64 + c * 8);
              vv[j] = *(const u32x4*)(VTA + ((size_t)((b * 8 + h) * 32 + srow) * 64 + t) * 64 + c * 8); }
#pragma unroll
          for (int j = 0; j < 9; ++j) { *(LAS u32x4*)(Ks + j * 8192 + dstk) = kv[j]; *(LAS u32x4*)(Vs + j * 8192 + dstv) = vv[j]; } }
        __syncthreads();
        f32x4 s[8][2];
#pragma unroll
        for (int i = 0; i < 8; ++i)
#pragma unroll
            for (int t = 0; t < 2; ++t) { const int tok = kc0 + kperm + 4 * t; const LAS unsigned char* kr = Ks + (j0 + i) * 8192 + tok * 128;
                const int fk = ((tok >> 1) & 1) | (((tok >> 3) & 3) << 1);
                const bf16x8 k0 = *(const LAS bf16x8*)(kr + ((fq ^ fk) << 4)), k1 = *(const LAS bf16x8*)(kr + (((4 + fq) ^ fk) << 4));
                f32x4 a = (f32x4){0.f, 0.f, 0.f, 0.f};
                a = __builtin_amdgcn_mfma_f32_16x16x32_bf16(k0, qf0, a, 0, 0, 0); a = __builtin_amdgcn_mfma_f32_16x16x32_bf16(k1, qf1, a, 0, 0, 0); s[i][t] = a; }
        const int qc = q0 + fr, cs0 = min(max(qc - 8, 0), 48);
        float madd[2][4]; int dco[2][4];
#pragma unroll
        for (int t = 0; t < 2; ++t)
#pragma unroll
            for (int j = 0; j < 4; ++j) { const int kc = kc0 + 8 * fq + 4 * t + j; madd[t][j] = ((kc >= cs0) && (kc < cs0 + 16)) ? 0.f : -1e30f; dco[t][j] = min(max(kc - qc, -15), 15); }
        float mx = -1e30f;
#pragma unroll
        for (int i = 0; i < 8; ++i) { const int dr = rs + i - r; const LAS float* rrow = rp + (dr + 7) * 31 + 15;
#pragma unroll
            for (int t = 0; t < 2; ++t)
#pragma unroll
                for (int j = 0; j < 4; ++j) { const float v = (s[i][t][j] * sc2 + rrow[dco[t][j]]) + madd[t][j]; s[i][t][j] = v; mx = fmaxf(mx, v); } }
        mx = fmaxf(mx, __shfl_xor(mx, 16)); mx = fmaxf(mx, __shfl_xor(mx, 32));
        float sum = 0.f;
#pragma unroll
        for (int i = 0; i < 8; ++i)
#pragma unroll
            for (int t = 0; t < 2; ++t)
#pragma unroll
                for (int j = 0; j < 4; ++j) { const float e = __builtin_amdgcn_exp2f(s[i][t][j] - mx); s[i][t][j] = e; sum += e; }
        sum += __shfl_xor(sum, 16); sum += __shfl_xor(sum, 32);
        const float inv = 1.0f / sum;
        f32x4 o[4];
#pragma unroll
        for (int nb = 0; nb < 4; ++nb) o[nb] = (f32x4){0.f, 0.f, 0.f, 0.f};
        const int vc = (kc0 >> 3) + fq;
#pragma unroll
        for (int i = 0; i < 8; ++i) {
            u32x4 pw; pw.x = cvt_pk_bf16(s[i][0][0], s[i][0][1]); pw.y = cvt_pk_bf16(s[i][0][2], s[i][0][3]); pw.z = cvt_pk_bf16(s[i][1][0], s[i][1][1]); pw.w = cvt_pk_bf16(s[i][1][2], s[i][1][3]);
            const bf16x8 pf = __builtin_bit_cast(bf16x8, pw);
#pragma unroll
            for (int nb = 0; nb < 4; ++nb) { const int d = nb * 16 + fr; const bf16x8 va = *(const LAS bf16x8*)(Vs + (j0 + i) * 8192 + d * 128 + ((vc ^ ((d >> 1) & 7)) << 4));
                o[nb] = __builtin_amdgcn_mfma_f32_16x16x32_bf16(va, pf, o[nb], 0, 0, 0); } }
        float q2 = 0.f;
#pragma unroll
        for (int nb = 0; nb < 4; ++nb) { o[nb] = o[nb] * inv; q2 += (o[nb][0] * o[nb][0] + o[nb][1] * o[nb][1]) + (o[nb][2] * o[nb][2] + o[nb][3] * o[nb][3]); }
        q2 += __shfl_xor(q2, 16); q2 += __shfl_xor(q2, 32);
        if (fq == 0) SSQNA[(size_t)tq * 8 + h] = q2;
        bf16_t* op = YCAT + (size_t)tq * DM + 512 + h * 64 + 4 * fq;
#pragma unroll
        for (int nb = 0; nb < 4; ++nb) { u32x2 wv; wv.x = cvt_pk_bf16(o[nb][0], o[nb][1]); wv.y = cvt_pk_bf16(o[nb][2], o[nb][3]); *(u32x2*)(op + nb * 16) = wv; }
    }
    __syncthreads();
}

constexpr int N_PHASES = 11;
__global__ void __launch_bounds__(NTHREADS, 2) fwd_megakernel(Params p) {
    extern __shared__ __attribute__((aligned(16))) unsigned char lds_raw[];
    LAS unsigned char* lds = (LAS unsigned char*)lds_raw;
    volatile LAS unsigned* bst = (volatile LAS unsigned*)(lds + LDS_BYTES - 16);
    const int lo = p.ph_lo, hi = p.ph_hi, G = gridDim.x, cid = blockIdx.x;
    if (threadIdx.x < 4) bst[threadIdx.x] = 0u;
    __syncthreads();
    XcdBarrier bar; bar.bar = (unsigned*)(p.ws + WS_BAR); bar.x = 0; bar.st = bst; bar.G = gridDim.x;
    if (!MK_PER_PHASE) bar = xcd_barrier_post((unsigned*)(p.ws + WS_BAR), bst, gridDim.x);
    XcdBarrier gbar; gbar.bar = (unsigned*)(p.ws + WS_BAR + 65536 + 16384 * (blockIdx.x & 7)); gbar.x = 0; gbar.st = bst + 2; gbar.G = gridDim.x >> 3;
    if (!MK_PER_PHASE && gridDim.x == 256) gbar = xcd_barrier_post(gbar.bar, bst + 2, gridDim.x >> 3);
    if (lo < 0) cg::this_grid().sync();
#define IN(k) (lo <= (k) && (k) < hi)
#define REP(k) for (int rep_ = 0; rep_ < 1 + ((REPEAT_MASK >> (k)) & 1); ++rep_)
#define SEAM(k) do { if (IN(k) && IN((k) + 1)) xcd_barrier(bar); } while (0)
    unsigned char* ws = p.ws;
    const float* mod = (const float*)(ws + WS_MOD);

    if (IN(0)) REP(0) p0_prologue(p, lds);
    if (IN(0) && IN(1)) {
        if (threadIdx.x < 64) { unsigned sp = 0; unsigned* mc = (unsigned*)(ws + WS_BAR) + 3712;
            while ((unsigned)__builtin_amdgcn_readfirstlane(__hip_atomic_load(mc, __ATOMIC_RELAXED, __HIP_MEMORY_SCOPE_AGENT)) < 96u) { __builtin_amdgcn_s_sleep(2); if (++sp > (1u << 22)) break; }
            __builtin_amdgcn_fence(__ATOMIC_ACQUIRE, "agent");
            asm volatile("s_waitcnt vmcnt(0)" ::: "memory"); }
        __syncthreads();
    }
    if (IN(1)) REP(1) pass_h_fold(p.x, p.g_mix, mod, (bf16_t*)(ws + WS_H), (bf16_t*)(ws + WS_HE), (bf16_t*)(ws + WS_HO));
    SEAM(1);
    if (IN(2)) { SchedP2 S{(const char*)(ws + WS_H), (const char*)(ws + WS_HE), (const char*)(ws + WS_HO), (const char*)(ws + WS_WQK), (const char*)(ws + WS_WA), (char*)(ws + WS_QK), (char*)(ws + WS_VT), (char*)(ws + WS_VTA), (float*)(ws + WS_SSQ2 + 512 * 1024), G, cid};
        pg8::EpiTileBf16 E; pg8::gemm_phase(lds, DM, S, E);
        late_work(p, lds, cid, G, 4); }
    SEAM(2);
    if (IN(3)) { pass_xmid((const bf16_t*)(ws + WS_H), (const bf16_t*)(ws + WS_WA), (float*)(ws + WS_SSQ2 + 256 * 1024));
        SchedFourier S{(const char*)(ws + WS_CS), (const char*)(ws + WS_VT), (char*)(ws + WS_PQ), G, cid};
        pg8::EpiTileBf16 E; pg8::gemm_phase(lds, 1024, S, E);
        if (G == 256) { if (cid >= 128) late_work(p, lds, cid - 128, 128, 3); } else late_work(p, lds, cid, G, 3);
        attn_phase(p, lds); }
    SEAM(3);
    if (IN(4)) REP(4) pass_combine((const bf16_t*)(ws + WS_PQ), (const float*)(ws + WS_SSQ2 + 512 * 1024), (const float*)(ws + WS_SSQ2 + 256 * 1024), (const float*)(ws + WS_SSQ1 + 512 * 1024), (bf16_t*)(ws + WS_YCAT));
    const bool fuse = (G == 256);
#define GSEAM(k, k2) do { if (IN(k) && IN(k2)) { if (fuse) xcd_barrier(gbar); else xcd_barrier(bar); } } while (0)
    GSEAM(4, 5);
    if (IN(5)) { SchedPlain S{(const char*)(ws + WS_YCAT), (const char*)(ws + WS_WOUT), 64, 4, DM, G, cid};
        if (fuse) { pg8::EpiResidNormMod E{p.x, (bf16_t*)(ws + WS_HE), mod, 2 * DM, 3 * DM, 4 * DM, p.g_ffn, (bf16_t*)(ws + WS_H), pg8::PanelSsq{(float*)(ws + WS_SSQ1), (unsigned*)(ws + WS_BAR + 16384)}}; pg8::gemm_phase(lds, DM, S, E); }
        else { pg8::EpiResid E{p.x, p.out, mod + 2 * DM, (float*)(ws + WS_SSQ1)}; pg8::gemm_phase(lds, DM, S, E); } }
    if (!fuse) SEAM(5);
    if (IN(6) && !fuse) pass_norm_mod(p.out, (const float*)(ws + WS_SSQ1), p.g_ffn, mod, 3 * DM, 4 * DM, (bf16_t*)(ws + WS_H));
    if (fuse) GSEAM(5, 7); else SEAM(6);
    if (IN(7)) REP(7) { SchedPlain S{(const char*)(ws + WS_H), (const char*)(ws + WS_WUP), 64, 22, DM, G, cid};
        pg8::EpiUp E{(bf16_t*)(ws + WS_A), (bf16_t*)(ws + WS_SIDE), p.conv_w, p.conv_b}; pg8::gemm_phase(lds, DM, S, E);
        }
    GSEAM(7, 8);
    if (IN(8)) { if (fuse) pass_fixup((const bf16_t*)(ws + WS_SIDE), p.conv_w, p.conv_b, (bf16_t*)(ws + WS_A), 64 * (cid & 7), 64, cid >> 3, G >> 3);
        else pass_fixup((const bf16_t*)(ws + WS_SIDE), p.conv_w, p.conv_b, (bf16_t*)(ws + WS_A), 0, 512, cid, G); }
    GSEAM(8, 9);
    if (REPEAT_MASK & (1 << 20)) { for (int e_ = 0; e_ < 8; ++e_) xcd_barrier(bar); }
    if (IN(9)) { SchedPlain S{(const char*)(ws + WS_A), (const char*)(ws + WS_WDN), 64, 4, DFF, G, cid};
        if (fuse) { pg8::EpiResidNormOut E{(const bf16_t*)(ws + WS_HE), p.out, mod, 5 * DM, p.g_final, pg8::PanelSsq{(float*)(ws + WS_SSQ2), (unsigned*)(ws + WS_BAR + 32768)}}; pg8::gemm_phase(lds, DFF, S, E); }
        else { pg8::EpiResid E{p.out, p.out, mod + 5 * DM, (float*)(ws + WS_SSQ2)}; pg8::gemm_phase(lds, DFF, S, E); } }
    if (!fuse) SEAM(9);
    if (IN(10) && !fuse) pass_final(p.out, (const float*)(ws + WS_SSQ2), p.g_final);
#undef IN
#undef SEAM
#undef GSEAM
}

extern "C" void kernel_launch(void* const* d_in, const int* in_sizes, int n_in, void* d_out, int out_size, void* d_ws, size_t ws_size, hipStream_t stream) {
    static int grid = 0;
    if (grid == 0) {
        int dev = 0, cus = 0, per_cu = 0;
        if (n_in != 17 || ws_size < WS_END) { fprintf(stderr, "kernel_launch: unexpected inputs (n_in %d, ws %zu)\n", n_in, ws_size); grid = -1; return; }
        hipGetDevice(&dev);
        hipDeviceGetAttribute(&cus, hipDeviceAttributeMultiprocessorCount, dev);
        if (hipFuncSetAttribute((const void*)fwd_megakernel, hipFuncAttributeMaxDynamicSharedMemorySize, LDS_BYTES) != hipSuccess) { fprintf(stderr, "kernel_launch: hipFuncSetAttribute failed\n"); grid = -1; return; }
        hipOccupancyMaxActiveBlocksPerMultiprocessor(&per_cu, (const void*)fwd_megakernel, NTHREADS, LDS_BYTES);
        if (per_cu < 1) { fprintf(stderr, "kernel_launch: occupancy query says %d blocks per CU\n", per_cu); per_cu = 1; }
        (void)hipGetLastError();
        grid = cus;
    }
    if (grid < 0) return;
    Params p{};
    const float** f = (const float**)&p;
    for (int i = 0; i < 17; ++i) f[i] = (const float*)d_in[i];
    p.out = (float*)d_out; p.ws = (unsigned char*)d_ws;
    hipMemsetAsync((char*)d_ws + WS_BAR, 0, 196608, stream);
#if MK_PER_PHASE
    for (int ph = 0; ph < N_PHASES; ++ph) { p.ph_lo = ph; p.ph_hi = ph + 1; hipLaunchKernelGGL(fwd_megakernel, dim3(grid), dim3(NTHREADS), LDS_BYTES, stream, p); }
#else
    p.ph_lo = 0; p.ph_hi = N_PHASES;
    void* args[] = {&p};
    hipError_t e = hipLaunchCooperativeKernel((const void*)fwd_megakernel, dim3(grid), dim3(NTHREADS), args, LDS_BYTES, stream);
    if (e != hipSuccess) fprintf(stderr, "cooperative launch failed: %s (grid %d)\n", hipGetErrorString(e), grid);
#endif
}
```

```cpp
#include <hip/hip_runtime.h>
#include <hip/hip_cooperative_groups.h>
#include <cstdio>
namespace cg = cooperative_groups;

#ifndef REPEAT_MASK
#define REPEAT_MASK 0
#endif
#ifndef MK_PER_PHASE
#define MK_PER_PHASE 0
#endif

#define LAS __attribute__((address_space(3)))
typedef unsigned short bf16_t;
typedef short bf16x8 __attribute__((ext_vector_type(8)));
typedef float f32x4 __attribute__((ext_vector_type(4)));
typedef float f32x2 __attribute__((ext_vector_type(2)));
typedef unsigned u32x4 __attribute__((ext_vector_type(4)));
typedef unsigned u32x2 __attribute__((ext_vector_type(2)));

constexpr int DM = 1024, NBATCH = 8, SEQ = 2048, NTOK = NBATCH * SEQ, DFF = 2816, NMOD = 6 * DM;
constexpr float EPS = 1e-6f;
constexpr int NTHREADS = 512, NWAVES = 8;
constexpr int LDS_STAGE = 131072, LDS_EXTRA = 20480, LDS_BYTES = LDS_STAGE + LDS_EXTRA;

constexpr size_t MiB = 1u << 20;
constexpr size_t WS_MOD = 0;
constexpr size_t WS_BAR = 512 * 1024;
constexpr size_t WS_SSQ1 = 1 * MiB;
constexpr size_t WS_SSQ2 = 2 * MiB;
constexpr size_t WS_WQK = 3 * MiB;
constexpr size_t WS_WA = 5 * MiB;
constexpr size_t WS_WOUT = 8 * MiB;
constexpr size_t WS_WUP = 10 * MiB;
constexpr size_t WS_WDN = 21 * MiB;
constexpr size_t WS_CS = 27 * MiB;
constexpr size_t WS_H = 47 * MiB;
constexpr size_t WS_VT = 79 * MiB;
constexpr size_t WS_QK = 95 * MiB;
constexpr size_t WS_VTA = 127 * MiB;
constexpr size_t WS_PQ = 31 * MiB;
constexpr size_t WS_YCAT = 178 * MiB;
constexpr size_t WS_A = 79 * MiB;
constexpr size_t WS_SIDE = 167 * MiB;
constexpr size_t WS_HE = 143 * MiB;
constexpr size_t WS_HO = 159 * MiB;
constexpr size_t WS_X1B = 210 * MiB;
constexpr size_t WS_END = 242 * MiB;

struct Params {
    const float *x, *c, *w_ada, *b_ada, *g_mix, *w_in, *w_four, *rpb, *g_four_out, *g_na_out, *w_out, *g_ffn, *w_up, *conv_w, *conv_b, *w_down, *g_final;
    float* out; unsigned char* ws;
    int ph_lo, ph_hi;
};

__device__ __forceinline__ unsigned cvt_pk_bf16(float lo, float hi) { unsigned r; asm volatile("v_cvt_pk_bf16_f32 %0, %1, %2" : "=v"(r) : "v"(lo), "v"(hi)); return r; }
__device__ __forceinline__ float bf_lo(unsigned w) { return __uint_as_float(w << 16); }
__device__ __forceinline__ float bf_hi(unsigned w) { return __uint_as_float(w & 0xffff0000u); }
__device__ __forceinline__ float wave_sum(float v) {
#pragma unroll
    for (int o = 1; o < 64; o <<= 1) v += __shfl_xor(v, o);
    return v;
}
__device__ __forceinline__ float silu_f(float v) { return v * __builtin_amdgcn_rcpf(1.0f + __expf(-v)); }
template <int CTRL> __device__ __forceinline__ float dpp_f(float v) {
    return __builtin_bit_cast(float, __builtin_amdgcn_mov_dpp(__builtin_bit_cast(int, v), CTRL, 0xF, 0xF, true));
}

#define XB_TMO      128
#define XB_XCNT(j)  (256  + 64 * (j))
#define XB_XSUB(j)  (1280 + 64 * (j))
#define XB_XGEN(j)  (2304 + 64 * (j))
#define XB_TOP      3328
#define XB_TOPGEN   3392
#define XCD_BAR_WORDS 3456
#define XB_SPIN_CAP (1u << 20)
__device__ __forceinline__ unsigned xb_ld(unsigned* p)              { return __hip_atomic_load(p, __ATOMIC_RELAXED, __HIP_MEMORY_SCOPE_AGENT); }
__device__ __forceinline__ unsigned xb_add(unsigned* p, unsigned v) { return __hip_atomic_fetch_add(p, v, __ATOMIC_RELAXED, __HIP_MEMORY_SCOPE_AGENT); }
__device__ __forceinline__ unsigned xb_xcc_id() { return (unsigned)__builtin_amdgcn_s_getreg((3 << 11) | 20) & 0xFu; }
#define XB_SPIN(cond, bar) do { unsigned _sp = 0; while (cond) { __builtin_amdgcn_s_sleep(1); \
    if ((++_sp & 255u) == 0u) { if (xb_ld(&(bar)[XB_TMO])) break; if (_sp > XB_SPIN_CAP) { atomicAdd(&(bar)[XB_TMO], 1u); break; } } } } while (0)
struct XcdBarrier { unsigned* bar; unsigned x; volatile LAS unsigned* st; unsigned G; };
__device__ __forceinline__ XcdBarrier xcd_barrier_post(unsigned* bar, volatile LAS unsigned* st, unsigned G) {
    XcdBarrier b; b.bar = bar; b.x = xb_xcc_id(); b.st = st; b.G = G;
    if (threadIdx.x == 0) (void)xb_add(&bar[XB_XCNT(b.x)], 1u);
    return b;
}
__device__ __forceinline__ void xcd_barrier_complete(unsigned* bar, unsigned x, unsigned& nloc, unsigned& nx, const unsigned G) {
    unsigned sum, cnt, mine, sp = 0u;
    for (;;) {
        sum = 0u; cnt = 0u; mine = 0u;
#pragma unroll
        for (unsigned j = 0; j < 16; ++j) { const unsigned c = xb_ld(&bar[XB_XCNT(j)]); sum += c; cnt += (c > 0u) ? 1u : 0u; mine = (j == x) ? c : mine; }
        if (sum == G) break;
        __builtin_amdgcn_s_sleep(1);
        if ((++sp & 255u) == 0u) { if (xb_ld(&bar[XB_TMO])) break; if (sp > XB_SPIN_CAP) { atomicAdd(&bar[XB_TMO], 1u); break; } }
    }
    nloc = mine > 0u ? mine : 1u; nx = cnt > 0u ? cnt : 1u;
}
__device__ __forceinline__ void xcd_barrier(const XcdBarrier& b) {
    asm volatile("s_waitcnt vmcnt(0)" ::: "memory");
    __syncthreads();
    if (threadIdx.x == 0) {
        unsigned* bar = b.bar;
        __builtin_amdgcn_s_waitcnt(0);
        unsigned nloc = b.st[0], nx = b.st[1];
        if (nloc == 0u) { xcd_barrier_complete(bar, b.x, nloc, nx, b.G); b.st[0] = nloc; b.st[1] = nx; }
        const unsigned old = xb_add(&bar[XB_XSUB(b.x)], 1u);
        const unsigned gen = old / nloc;
        if (old + 1u == (gen + 1u) * nloc) {
            __builtin_amdgcn_fence(__ATOMIC_RELEASE, "agent");
            asm volatile("s_waitcnt vmcnt(0)" ::: "memory");
            const unsigned og = xb_add(&bar[XB_TOP], 1u);
            const unsigned tg = og / nx;
            if (og + 1u == (tg + 1u) * nx) xb_add(&bar[XB_TOPGEN], 1u);
            else XB_SPIN(xb_ld(&bar[XB_TOPGEN]) == tg, bar);
            __builtin_amdgcn_fence(__ATOMIC_ACQUIRE, "agent");
            xb_add(&bar[XB_XGEN(b.x)], 1u);
            asm volatile("s_waitcnt vmcnt(0)" ::: "memory");
        } else {
            XB_SPIN(xb_ld(&bar[XB_XGEN(b.x)]) == gen, bar);
            __builtin_amdgcn_fence(__ATOMIC_ACQUIRE, "agent");
            asm volatile("s_waitcnt vmcnt(0)" ::: "memory");
        }
    }
    __syncthreads();
}

__device__ __forceinline__ void group_barrier(unsigned* ctr, unsigned& gen, unsigned nmemb) {
    asm volatile("s_waitcnt vmcnt(0)" ::: "memory");
    __syncthreads();
    ++gen;
    if (threadIdx.x == 0) {
        __builtin_amdgcn_fence(__ATOMIC_RELEASE, "agent");
        asm volatile("s_waitcnt vmcnt(0)" ::: "memory");
        (void)xb_add(ctr, 1u);
        const unsigned target = gen * nmemb; unsigned sp = 0;
        while (xb_ld(ctr) < target) { __builtin_amdgcn_s_sleep(1); if (++sp > (1u << 22)) break; }
        __builtin_amdgcn_fence(__ATOMIC_ACQUIRE, "agent");
        asm volatile("s_waitcnt vmcnt(0)" ::: "memory");
    }
    __syncthreads();
}

namespace pg8 {
constexpr int BM = 256, BK = 64, HALF = 128, HTB = HALF * BK * 2, NXCD = 8, WGM = 8;
__device__ __forceinline__ int lds_byte(int r, int c) { const int st = (r >> 4) * 2 + (c >> 5), rr = r & 15, cc = c & 31, ob = rr * 64 + cc * 2; return st * 1024 + (ob ^ (((ob >> 9) & 1) << 5)); }
__device__ __forceinline__ void stage_rc(int b, int& R, int& C) { const int st = b / 1024, sb = b % 1024, swz = sb ^ (((sb >> 9) & 1) << 5); R = (st >> 1) * 16 + swz / 64; C = (st & 1) * 32 + (swz % 64) / 2; }
__device__ __forceinline__ int perm32(int rho) { const int n = rho >> 4, i = rho & 15; return 8 * (i >> 2) + 4 * n + (i & 3); }

struct Unit { const char* pa; const char* pb; char* po; float* sp; int rp, RS, CS; int pm, pn; };

__device__ __forceinline__ void tile_map(int wgid, int nM, int nN, int& pm, int& pn) {
    const int nwg = nM * nN;
    { const int q = nwg / NXCD, r = nwg % NXCD, xcd = wgid % NXCD, off = wgid / NXCD; wgid = (xcd < r ? xcd * (q + 1) : r * (q + 1) + (xcd - r) * q) + off; }
    const int nig = WGM * nN, gid = wgid / nig, fm = gid * WGM, gsz = (nM - fm) < WGM ? (nM - fm) : WGM;
    pm = fm + ((wgid % nig) % gsz); pn = (wgid % nig) / gsz;
}

template <class Epi, class Sched>
__device__ __forceinline__ void gemm_phase(LAS unsigned char* lds, const int K, const Sched& S, const Epi& E) {
    const int tid = threadIdx.x, wid = __builtin_amdgcn_readfirstlane(tid >> 6), lane = tid & 63, wr = wid >> 2, wc = wid & 3, fr = lane & 15, fq = lane >> 4;
    const int nt = K / BK;
    unsigned voffA[2], voffB[2];
#pragma unroll
    for (int i = 0; i < 2; ++i) { int R, C; stage_rc(tid * 16 + i * 8192, R, C); const int Rb = Epi::PERM ? ((R & ~31) + perm32(R & 31)) : R;
        voffA[i] = (unsigned)(R * K + C) * 2u; voffB[i] = (unsigned)(Rb * K + C) * 2u; }
    const size_t kstep = (size_t)(BK * 2);
    const size_t hstep = (size_t)HALF * K * 2;
    const unsigned ldsw = (unsigned)wid * 1024u;
    const int aoff = lds_byte(wr * 64 + fr, fq * 8), boff = lds_byte(wc * 32 + fr, fq * 8);
#define PG8_SA(b, h) (((b) * 2 + (h)) * HTB)
#define PG8_SB(b, h) ((4 + (b) * 2 + (h)) * HTB)
#define PG8_STAGE(bufoff, gbase, voff) do { _Pragma("unroll") for (int _i = 0; _i < 2; ++_i) \
        __builtin_amdgcn_global_load_lds((const unsigned*)((const char*)(gbase) + (voff)[_i]), (LAS unsigned*)(lds + (bufoff) + ldsw + _i * 8192), 16, 0, 0); } while (0)
#define PG8_LDA(dst, b, h) do { _Pragma("unroll") for (int m = 0; m < 4; ++m) _Pragma("unroll") for (int k = 0; k < 2; ++k) dst[m][k] = *(const LAS bf16x8*)(lds + PG8_SA(b, h) + aoff + m * 2048 + k * 1024); } while (0)
#define PG8_LDB(dst, b, h) do { _Pragma("unroll") for (int n = 0; n < 2; ++n) _Pragma("unroll") for (int k = 0; k < 2; ++k) dst[n][k] = *(const LAS bf16x8*)(lds + PG8_SB(b, h) + boff + n * 2048 + k * 1024); } while (0)
#define PG8_MMA(ai, bj, At, Bt) do { __builtin_amdgcn_s_setprio(1); _Pragma("unroll") for (int m = 0; m < 4; ++m) _Pragma("unroll") for (int n = 0; n < 2; ++n) _Pragma("unroll") for (int k = 0; k < 2; ++k) \
        acc[ai][bj][m][n] = __builtin_amdgcn_mfma_f32_16x16x32_bf16(Bt[n][k], At[m][k], acc[ai][bj][m][n], 0, 0, 0); __builtin_amdgcn_s_setprio(0); } while (0)
#define PG8_WAIT_V(n) asm volatile("s_waitcnt vmcnt(" #n ")" ::: "memory")
#define PG8_WAIT_L(n) asm volatile("s_waitcnt lgkmcnt(" #n ")" ::: "memory")
#define PG8_BAR __builtin_amdgcn_s_barrier()
#define PG8_SCHED __builtin_amdgcn_sched_barrier(0)
    Unit cur, nxt; int ui = 0;
    if (!S.next(0, cur)) return;
    f32x4 acc[2][2][4][2];
#pragma unroll
    for (int a = 0; a < 2; ++a)
#pragma unroll
        for (int b = 0; b < 2; ++b)
#pragma unroll
            for (int m = 0; m < 4; ++m)
#pragma unroll
                for (int n = 0; n < 2; ++n) acc[a][b][m][n] = (f32x4){0.f, 0.f, 0.f, 0.f};
    bf16x8 At[4][2], B0[2][2], B1[2][2];
    const char* cA = cur.pa; const char* cB = cur.pb;
    PG8_STAGE(PG8_SB(0, 0), cB, voffB); PG8_STAGE(PG8_SA(0, 0), cA, voffA); PG8_STAGE(PG8_SB(0, 1), cB + hstep, voffB); PG8_STAGE(PG8_SA(0, 1), cA + hstep, voffA);
    if (wr == 1) PG8_BAR;
    PG8_WAIT_V(4); PG8_BAR;
    PG8_STAGE(PG8_SB(1, 0), cB + kstep, voffB); PG8_STAGE(PG8_SA(1, 0), cA + kstep, voffA); PG8_STAGE(PG8_SB(1, 1), cB + hstep + kstep, voffB);
    PG8_WAIT_V(6); PG8_BAR;
    for (;;) {
        const bool has_next = S.next(ui + 1, nxt);
        const char* nA = has_next ? nxt.pa : cA; const char* nB = has_next ? nxt.pb : cB;
        for (int t = 0; t < nt; t += 2) {
            const bool last = (t == nt - 2);
            const char* a1 = cA + (size_t)(t + 1) * kstep;
            const char* a2 = last ? nA : cA + (size_t)(t + 2) * kstep; const char* b2 = last ? nB : cB + (size_t)(t + 2) * kstep;
            const char* a3 = a2 + kstep; const char* b3 = b2 + kstep;
            PG8_LDB(B0, 0, 0); PG8_SCHED; PG8_LDA(At, 0, 0); PG8_STAGE(PG8_SA(1, 1), a1 + hstep, voffA);
            PG8_WAIT_L(8); PG8_BAR; PG8_WAIT_L(0); PG8_MMA(0, 0, At, B0); PG8_BAR; PG8_SCHED;
            PG8_LDB(B1, 0, 1); PG8_STAGE(PG8_SB(0, 0), b2, voffB);
            PG8_BAR; PG8_WAIT_L(0); PG8_MMA(0, 1, At, B1); PG8_BAR;
            PG8_LDA(At, 0, 1); PG8_STAGE(PG8_SA(0, 0), a2, voffA);
            PG8_BAR; PG8_WAIT_L(0); PG8_MMA(1, 0, At, B0); PG8_BAR; PG8_SCHED;
            PG8_STAGE(PG8_SB(0, 1), b2 + hstep, voffB);
            PG8_WAIT_V(6); PG8_BAR; PG8_MMA(1, 1, At, B1); PG8_BAR;
            PG8_LDB(B0, 1, 0); PG8_SCHED; PG8_LDA(At, 1, 0); PG8_STAGE(PG8_SA(0, 1), a2 + hstep, voffA);
            PG8_WAIT_L(8); PG8_BAR; PG8_WAIT_L(0); PG8_MMA(0, 0, At, B0); PG8_BAR; PG8_SCHED;
            PG8_LDB(B1, 1, 1); PG8_STAGE(PG8_SB(1, 0), b3, voffB);
            PG8_BAR; PG8_WAIT_L(0); PG8_MMA(0, 1, At, B1); PG8_BAR;
            PG8_LDA(At, 1, 1); PG8_STAGE(PG8_SA(1, 0), a3, voffA);
            PG8_BAR; PG8_WAIT_L(0); PG8_MMA(1, 0, At, B0); PG8_BAR; PG8_SCHED;
            PG8_STAGE(PG8_SB(1, 1), b3 + hstep, voffB);
            PG8_WAIT_V(6); PG8_BAR; PG8_MMA(1, 1, At, B1); PG8_BAR;
        }
        if constexpr (!Epi::AFTER_DRAIN) E(acc, cur, wr, wc, fr, fq);
        if (!has_next) break;
#pragma unroll
        for (int a = 0; a < 2; ++a)
#pragma unroll
            for (int b = 0; b < 2; ++b)
#pragma unroll
                for (int m = 0; m < 4; ++m)
#pragma unroll
                    for (int n = 0; n < 2; ++n) acc[a][b][m][n] = (f32x4){0.f, 0.f, 0.f, 0.f};
        cur = nxt; cA = nA; cB = nB; ++ui;
    }
    PG8_WAIT_V(0);
    if (wr == 0) PG8_BAR;
    PG8_BAR;
    if constexpr (Epi::AFTER_DRAIN) E.fused(acc, cur, wr, wc, fr, fq, lds, wid, lane);
#undef PG8_SA
#undef PG8_SB
#undef PG8_STAGE
#undef PG8_LDA
#undef PG8_LDB
#undef PG8_MMA
#undef PG8_WAIT_V
#undef PG8_WAIT_L
#undef PG8_BAR
#undef PG8_SCHED
}

struct EpiTileBf16 {
    static constexpr bool PERM = true, AFTER_DRAIN = false;
    __device__ __forceinline__ void operator()(const f32x4 (&acc)[2][2][4][2], const Unit& u, int wr, int wc, int fr, int fq) const {
        bf16_t* base = (bf16_t*)u.po + (size_t)wr * u.RS + (size_t)fr * u.rp + (size_t)(wc >> 1) * u.CS + (wc & 1) * 32 + 8 * fq;
#pragma unroll
        for (int ai = 0; ai < 2; ++ai)
#pragma unroll
            for (int m = 0; m < 4; ++m) { bf16_t* rowp = base + (size_t)(2 * ai) * u.RS + (size_t)(m * 16) * u.rp;
#pragma unroll
                for (int bj = 0; bj < 2; ++bj) { const f32x4 v0 = acc[ai][bj][m][0], v1 = acc[ai][bj][m][1];
                    u32x4 w; w.x = cvt_pk_bf16(v0[0], v0[1]); w.y = cvt_pk_bf16(v0[2], v0[3]); w.z = cvt_pk_bf16(v1[0], v1[1]); w.w = cvt_pk_bf16(v1[2], v1[3]);
                    *(u32x4*)(rowp + (size_t)(2 * bj) * u.CS) = w; } }
        if (u.sp) {
#pragma unroll
            for (int ai = 0; ai < 2; ++ai)
#pragma unroll
                for (int m = 0; m < 4; ++m) { float s = 0.f;
#pragma unroll
                    for (int bj = 0; bj < 2; ++bj)
#pragma unroll
                        for (int n = 0; n < 2; ++n) { const f32x4 v = acc[ai][bj][m][n]; s += (v[0] - v[1]) + (v[2] - v[3]); }
                    s += __shfl_xor(s, 16); s += __shfl_xor(s, 32);
                    if (fq == 0) u.sp[(size_t)(ai * HALF + wr * 64 + m * 16 + fr) * 32 + wc] = s; }
        }
    }
};
struct EpiResid {
    static constexpr bool PERM = false, AFTER_DRAIN = false;
    const float* base; float* out; const float* gate; float* ssq;
    __device__ __forceinline__ void operator()(const f32x4 (&acc)[2][2][4][2], const Unit& u, int wr, int wc, int fr, int fq) const {
        const int row0 = u.pm * BM + wr * 64 + fr, col0 = u.pn * BM + wc * 32 + 4 * fq, b = u.pm >> 3;
        f32x4 gv[2][2];
#pragma unroll
        for (int bj = 0; bj < 2; ++bj)
#pragma unroll
            for (int n = 0; n < 2; ++n) gv[bj][n] = *(const f32x4*)(gate + (size_t)b * NMOD + col0 + bj * HALF + n * 16);
#pragma unroll
        for (int ai = 0; ai < 2; ++ai)
#pragma unroll
            for (int m = 0; m < 4; ++m) { const int row = row0 + ai * HALF + m * 16; const size_t off = (size_t)row * DM + col0; float s = 0.f;
#pragma unroll
                for (int bj = 0; bj < 2; ++bj)
#pragma unroll
                    for (int n = 0; n < 2; ++n) { const f32x4 xv = *(const f32x4*)(base + off + bj * HALF + n * 16); const f32x4 o = xv + gv[bj][n] * acc[ai][bj][m][n];
                        *(f32x4*)(out + off + bj * HALF + n * 16) = o; s += (o[0] * o[0] + o[1] * o[1]) + (o[2] * o[2] + o[3] * o[3]); }
                s += __shfl_xor(s, 16); s += __shfl_xor(s, 32);
                if (fq == 0) ssq[(size_t)row * 16 + u.pn * 4 + wc] = s; }
    }
};
struct EpiUp {
    static constexpr bool PERM = true, AFTER_DRAIN = false;
    bf16_t* A; bf16_t* side; const float* cw; const float* cb;
    __device__ __forceinline__ void operator()(f32x4 (&acc)[2][2][4][2], const Unit& u, int wr, int wc, int fr, int fq) const {
        const int J0 = u.pn * 128 + wc * 32 + fq * 8;
        if (fr < 2 || fr >= 14) {
            const int slot = fr < 2 ? fr : fr - 12;
#pragma unroll
            for (int ai = 0; ai < 2; ++ai) { const int chunk = u.pm * 4 + ai * 2 + wr;
#pragma unroll
                for (int bj = 0; bj < 2; ++bj) { const f32x4 a0 = fr < 2 ? acc[ai][bj][0][0] : acc[ai][bj][3][0], a1 = fr < 2 ? acc[ai][bj][0][1] : acc[ai][bj][3][1];
                    u32x4 w; w.x = cvt_pk_bf16(a0[0], a0[1]); w.y = cvt_pk_bf16(a0[2], a0[3]); w.z = cvt_pk_bf16(a1[0], a1[1]); w.w = cvt_pk_bf16(a1[2], a1[3]);
                    *(u32x4*)(side + (size_t)(chunk * 4 + slot) * (2 * DFF) + bj * DFF + J0) = w; } }
        }
        const bool f0 = (fr == 0), f15 = (fr == 15);
#pragma unroll
        for (int bj = 0; bj < 2; ++bj)
#pragma unroll
            for (int n = 0; n < 2; ++n) {
                const int col = bj * DFF + J0 + n * 4;
                const f32x4 k0 = *(const f32x4*)(cw + col), k1 = *(const f32x4*)(cw + 2 * DFF + col), k2 = *(const f32x4*)(cw + 4 * DFF + col), kb = *(const f32x4*)(cb + col);
#pragma unroll
                for (int ai = 0; ai < 2; ++ai) {
                    const f32x4 c0 = acc[ai][bj][0][n], c1 = acc[ai][bj][1][n], c2 = acc[ai][bj][2][n], c3 = acc[ai][bj][3][n];
                    f32x4 o0, o1, o2, o3;
#pragma unroll
                    for (int j = 0; j < 4; ++j) {
                        const float r0 = dpp_f<0x121>(c0[j]), r1 = dpp_f<0x121>(c1[j]), r2 = dpp_f<0x121>(c2[j]), r3 = dpp_f<0x121>(c3[j]);
                        const float l0 = dpp_f<0x12F>(c0[j]), l1 = dpp_f<0x12F>(c1[j]), l2 = dpp_f<0x12F>(c2[j]), l3 = dpp_f<0x12F>(c3[j]);
                        o0[j] = k0[j] * r0 + k1[j] * c0[j] + k2[j] * (f15 ? l1 : l0) + kb[j];
                        o1[j] = k0[j] * (f0 ? r0 : r1) + k1[j] * c1[j] + k2[j] * (f15 ? l2 : l1) + kb[j];
                        o2[j] = k0[j] * (f0 ? r1 : r2) + k1[j] * c2[j] + k2[j] * (f15 ? l3 : l2) + kb[j];
                        o3[j] = k0[j] * (f0 ? r2 : r3) + k1[j] * c3[j] + k2[j] * l3 + kb[j];
                    }
                    asm volatile("" : "+v"(o0), "+v"(o1), "+v"(o2), "+v"(o3));
                    acc[ai][bj][0][n] = o0; acc[ai][bj][1][n] = o1; acc[ai][bj][2][n] = o2; acc[ai][bj][3][n] = o3;
                }
            }
#pragma unroll
        for (int ai = 0; ai < 2; ++ai) { const int chunk = u.pm * 4 + ai * 2 + wr;
#pragma unroll
            for (int m = 0; m < 4; ++m) {
                const f32x4 g0 = acc[ai][0][m][0], g1 = acc[ai][0][m][1], v0 = acc[ai][1][m][0], v1 = acc[ai][1][m][1];
                u32x4 w; w.x = cvt_pk_bf16(silu_f(g0[0]) * v0[0], silu_f(g0[1]) * v0[1]); w.y = cvt_pk_bf16(silu_f(g0[2]) * v0[2], silu_f(g0[3]) * v0[3]);
                w.z = cvt_pk_bf16(silu_f(g1[0]) * v1[0], silu_f(g1[1]) * v1[1]); w.w = cvt_pk_bf16(silu_f(g1[2]) * v1[2], silu_f(g1[3]) * v1[3]);
                const bool valid = !((m == 0 && f0) || (m == 3 && f15));
                if (valid) *(u32x4*)(A + (size_t)(chunk * 64 + m * 16 + fr) * DFF + J0) = w;
            } }
    }
};
struct PanelSsq {
    float* xbuf; unsigned* cnt;
    __device__ __forceinline__ void run(const f32x4 (&v)[2][2][4][2], const Unit& u, int wr, int wc, int fr, int fq, LAS unsigned char* lds, int wid, int lane) const {
        LAS float* P = (LAS float*)lds; LAS float* S = (LAS float*)(lds + 4096);
#pragma unroll
        for (int ai = 0; ai < 2; ++ai)
#pragma unroll
            for (int m = 0; m < 4; ++m) { float s = 0.f;
#pragma unroll
                for (int bj = 0; bj < 2; ++bj)
#pragma unroll
                    for (int n = 0; n < 2; ++n) { const f32x4 x = v[ai][bj][m][n]; s += (x[0] * x[0] + x[1] * x[1]) + (x[2] * x[2] + x[3] * x[3]); }
                s += __shfl_xor(s, 16); s += __shfl_xor(s, 32);
                if (fq == 0) P[(ai * HALF + wr * 64 + m * 16 + fr) * 4 + wc] = s; }
        asm volatile("s_waitcnt lgkmcnt(0)" ::: "memory"); __builtin_amdgcn_s_barrier(); asm volatile("" ::: "memory");
        const int row = wid * 32 + (lane & 31);
        if (lane < 32) { const f32x4 a = *(const LAS f32x4*)(P + row * 4);
            __hip_atomic_store(xbuf + ((size_t)(u.pm * BM + row) * 4 + u.pn), (a[0] + a[1]) + (a[2] + a[3]), __ATOMIC_RELAXED, __HIP_MEMORY_SCOPE_AGENT); }
        asm volatile("s_waitcnt vmcnt(0)" ::: "memory");
        if (lane == 0) __hip_atomic_fetch_add(cnt + 64 * u.pm, 1u, __ATOMIC_RELAXED, __HIP_MEMORY_SCOPE_AGENT);
        if (wid == 0) { unsigned sp = 0;
            while ((unsigned)__builtin_amdgcn_readfirstlane(__hip_atomic_load(cnt + 64 * u.pm, __ATOMIC_RELAXED, __HIP_MEMORY_SCOPE_AGENT)) < 32u) { __builtin_amdgcn_s_sleep(2); if (++sp > (1u << 22)) break; }
            __builtin_amdgcn_fence(__ATOMIC_ACQUIRE, "agent"); }
        asm volatile("s_waitcnt vmcnt(0) lgkmcnt(0)" ::: "memory"); __builtin_amdgcn_s_barrier(); asm volatile("" ::: "memory");
        if (lane < 32) { const float* slot = xbuf + (size_t)(u.pm * BM + row) * 4; float t = 0.f;
#pragma unroll
            for (int k = 0; k < 4; ++k) t += __hip_atomic_load(slot + k, __ATOMIC_RELAXED, __HIP_MEMORY_SCOPE_AGENT);
            S[row] = 1.0f / sqrtf(t * (1.0f / DM) + EPS); }
        asm volatile("s_waitcnt lgkmcnt(0)" ::: "memory"); __builtin_amdgcn_s_barrier(); asm volatile("" ::: "memory");
    }
};
struct EpiResidNormMod {
    static constexpr bool PERM = false, AFTER_DRAIN = true;
    const float* base; bf16_t* x1b; const float* mod; int gate_off, sh_off, sc_off; const float* g; bf16_t* hn; PanelSsq st;
    __device__ __forceinline__ void fused(f32x4 (&acc)[2][2][4][2], const Unit& u, int wr, int wc, int fr, int fq, LAS unsigned char* lds, int wid, int lane) const {
        const int row0 = u.pm * BM + wr * 64 + fr, col0 = u.pn * BM + wc * 32 + 4 * fq, b = u.pm >> 3;
        const float* modb = mod + (size_t)b * NMOD + col0;
        { f32x4 gv[2][2];
#pragma unroll
          for (int bj = 0; bj < 2; ++bj)
#pragma unroll
            for (int n = 0; n < 2; ++n) gv[bj][n] = *(const f32x4*)(modb + gate_off + bj * HALF + n * 16);
#pragma unroll
          for (int ai = 0; ai < 2; ++ai)
#pragma unroll
            for (int m = 0; m < 4; ++m) { const size_t off = (size_t)(row0 + ai * HALF + m * 16) * DM + col0;
#pragma unroll
                for (int bj = 0; bj < 2; ++bj)
#pragma unroll
                    for (int n = 0; n < 2; ++n) { const f32x4 xv = *(const f32x4*)(base + off + bj * HALF + n * 16); const f32x4 o = xv + gv[bj][n] * acc[ai][bj][m][n];
                        u32x2 w; w.x = cvt_pk_bf16(o[0], o[1]); w.y = cvt_pk_bf16(o[2], o[3]); *(u32x2*)(x1b + off + bj * HALF + n * 16) = w; acc[ai][bj][m][n] = o; }
                asm volatile("" ::: "memory"); } }
        st.run(acc, u, wr, wc, fr, fq, lds, wid, lane);
        const LAS float* S = (const LAS float*)(lds + 4096);
#pragma unroll
        for (int bj = 0; bj < 2; ++bj)
#pragma unroll
            for (int n = 0; n < 2; ++n) { const int co = bj * HALF + n * 16;
                const f32x4 gg = *(const f32x4*)(g + col0 + co), sh = *(const f32x4*)(modb + sh_off + co), sc = *(const f32x4*)(modb + sc_off + co);
                const f32x4 mul = gg * (1.0f + sc);
#pragma unroll
                for (int ai = 0; ai < 2; ++ai)
#pragma unroll
                    for (int m = 0; m < 4; ++m) { const int r = ai * HALF + wr * 64 + m * 16 + fr; const float rstd = S[r];
                        const f32x4 h = (acc[ai][bj][m][n] * rstd) * mul + sh;
                        u32x2 w; w.x = cvt_pk_bf16(h[0], h[1]); w.y = cvt_pk_bf16(h[2], h[3]);
                        *(u32x2*)(hn + (size_t)(u.pm * BM + r) * DM + col0 + co) = w; } }
    }
};
struct EpiResidNormOut {
    static constexpr bool PERM = false, AFTER_DRAIN = true;
    const bf16_t* x1b; float* out; const float* mod; int gate_off; const float* g; PanelSsq st;
    __device__ __forceinline__ void fused(f32x4 (&acc)[2][2][4][2], const Unit& u, int wr, int wc, int fr, int fq, LAS unsigned char* lds, int wid, int lane) const {
        const int row0 = u.pm * BM + wr * 64 + fr, col0 = u.pn * BM + wc * 32 + 4 * fq, b = u.pm >> 3;
        const float* modb = mod + (size_t)b * NMOD + col0;
        { f32x4 gv[2][2];
#pragma unroll
          for (int bj = 0; bj < 2; ++bj)
#pragma unroll
            for (int n = 0; n < 2; ++n) gv[bj][n] = *(const f32x4*)(modb + gate_off + bj * HALF + n * 16);
#pragma unroll
          for (int ai = 0; ai < 2; ++ai)
#pragma unroll
            for (int m = 0; m < 4; ++m) { const size_t off = (size_t)(row0 + ai * HALF + m * 16) * DM + col0;
#pragma unroll
                for (int bj = 0; bj < 2; ++bj)
#pragma unroll
                    for (int n = 0; n < 2; ++n) { const u32x2 xw = *(const u32x2*)(x1b + off + bj * HALF + n * 16); const f32x4 xv = (f32x4){bf_lo(xw.x), bf_hi(xw.x), bf_lo(xw.y), bf_hi(xw.y)};
                        acc[ai][bj][m][n] = xv + gv[bj][n] * acc[ai][bj][m][n]; }
                asm volatile("" : "+v"(acc[ai][0][m][0]), "+v"(acc[ai][0][m][1]), "+v"(acc[ai][1][m][0]), "+v"(acc[ai][1][m][1]));
                asm volatile("" ::: "memory"); } }
        st.run(acc, u, wr, wc, fr, fq, lds, wid, lane);
        const LAS float* S = (const LAS float*)(lds + 4096);
        f32x4 gg[2][2];
#pragma unroll
        for (int bj = 0; bj < 2; ++bj)
#pragma unroll
            for (int n = 0; n < 2; ++n) gg[bj][n] = *(const f32x4*)(g + col0 + bj * HALF + n * 16);
#pragma unroll
        for (int ai = 0; ai < 2; ++ai)
#pragma unroll
            for (int m = 0; m < 4; ++m) { const int r = ai * HALF + wr * 64 + m * 16 + fr; const float rstd = S[r]; float* rowp = out + (size_t)(u.pm * BM + r) * DM + col0;
#pragma unroll
                for (int bj = 0; bj < 2; ++bj)
#pragma unroll
                    for (int n = 0; n < 2; ++n) *(f32x4*)(rowp + bj * HALF + n * 16) = (acc[ai][bj][m][n] * rstd) * gg[bj][n];
                asm volatile("" ::: "memory"); }
    }
};
}

struct SchedP2 {
    const char *H, *HE, *HO, *WQK, *WA; char *QK, *VT, *VTA; float* SP; int G, c;
    __device__ __forceinline__ bool next(int i, pg8::Unit& u) const {
        const int L = i * G + c; if (L >= 512) return false;
        constexpr size_t tstep = (size_t)256 * DM * 2;
        u.sp = nullptr;
        if (L < 256) { int pm, pn; pg8::tile_map(L, 64, 4, pm, pn); u.pm = pm; u.pn = pn; u.pa = H + pm * tstep; u.pb = WQK + pn * tstep;
            const int b = pm >> 3, s0 = (pm & 7) * 256, head0 = (pn & 1) * 4;
            u.po = QK + (size_t)(pn >> 1) * (16u << 20) + ((size_t)((b * 8 + head0) * SEQ + s0) * 64) * 2; u.rp = 64; u.RS = 64 * 64; u.CS = SEQ * 64; }
        else if (L < 384) { int pm, pn; pg8::tile_map(L - 256, 2, 64, pm, pn); u.pm = 4 + pm; u.pn = pn; u.pa = WA + (size_t)(4 + pm) * tstep; u.pb = H + pn * tstep;
            const int b = pn >> 3;
            u.po = VTA + ((size_t)((b * 8 + 4 * pm) * 32 + 4 * (pn & 7)) * 4096) * 2; u.rp = 64; u.RS = 32 * 4096; u.CS = 4096; }
        else { const int which = (L - 384) >> 6; int pm, pn; pg8::tile_map((L - 384) & 63, 2, 32, pm, pn); u.pm = which * 2 + pm; u.pn = pn;
            u.pa = WA + (size_t)(which * 2 + pm) * tstep; u.pb = (which ? HO : HE) + pn * tstep;
            const int b = pn >> 2, st = pn & 3;
            u.po = VT + (size_t)which * (8u << 20) + ((size_t)(b * 512 + pm * 256) * 1024 + st * 256) * 2; u.rp = 1024; u.RS = 64 * 1024; u.CS = 64;
            if (!which) u.sp = SP + ((size_t)(b * 512 + pm * 256) * 32 + st * 4); }
        return true;
    }
};
struct SchedFourier {
    const char *CS, *VT; char* PQ; int G, c;
    __device__ __forceinline__ bool next(int i, pg8::Unit& u) const {
        const int L = i * G + c; if (L >= 128) return false;
        int pm, pn; pg8::tile_map(L, 8, 16, pm, pn); u.pm = pm; u.pn = pn;
        constexpr size_t tstep = (size_t)256 * 1024 * 2;
        u.pa = CS + pm * tstep; u.pb = VT + (size_t)(pm >> 2) * (8u << 20) + pn * tstep; u.po = PQ + ((size_t)pm * 256 * 4096 + pn * 256) * 2; u.rp = 4096; u.RS = 64 * 4096; u.CS = 64; u.sp = nullptr;
        return true;
    }
};
struct SchedPlain {
    const char *A, *B; int nM, nN, K, G, c;
    __device__ __forceinline__ bool next(int i, pg8::Unit& u) const {
        const int L = i * G + c; if (L >= nM * nN) return false;
        int pm, pn; pg8::tile_map(L, nM, nN, pm, pn); u.pm = pm; u.pn = pn;
        const size_t tstep = (size_t)256 * K * 2;
        u.pa = A + pm * tstep; u.pb = B + pn * tstep; u.po = nullptr; u.sp = nullptr; u.rp = 0; u.RS = 0; u.CS = 0;
        return true;
    }
};

__device__ __forceinline__ void p0_mod_item(const Params& p, LAS unsigned char* lds, int item) {
    LAS float* cs = (LAS float*)lds;
    LAS float* red = (LAS float*)(lds + 32768);
    const int tid = threadIdx.x;
    for (int u = tid; u < NBATCH * DM; u += NTHREADS) { const float v = p.c[u]; cs[u] = v / (1.0f + __expf(-v)); }
    __syncthreads();
    const int j0 = item * 64, l16 = tid & 15, rs = tid >> 4;
    f32x4 acc[8];
#pragma unroll
    for (int b = 0; b < 8; ++b) acc[b] = (f32x4){0.f, 0.f, 0.f, 0.f};
#pragma unroll 32
    for (int pass = 0; pass < 32; ++pass) { const int i = pass * 32 + rs; const f32x4 w = *(const f32x4*)(p.w_ada + (size_t)i * NMOD + j0 + 4 * l16);
#pragma unroll
        for (int b = 0; b < 8; ++b) acc[b] += cs[b * DM + i] * w; }
#pragma unroll
    for (int b = 0; b < 8; ++b) *(LAS f32x4*)(red + (rs * 8 + b) * 64 + 4 * l16) = acc[b];
    __syncthreads();
    { const int b = tid >> 6, col = tid & 63; float s = p.b_ada[j0 + col];
#pragma unroll 8
      for (int r = 0; r < 32; ++r) s += red[(r * 8 + b) * 64 + col];
      ((float*)(p.ws + WS_MOD))[(size_t)b * NMOD + j0 + col] = s; }
    asm volatile("s_waitcnt vmcnt(0)" ::: "memory");
    __syncthreads();
    if (tid == 0) {
        __builtin_amdgcn_fence(__ATOMIC_RELEASE, "agent");
        asm volatile("s_waitcnt vmcnt(0)" ::: "memory");
        __hip_atomic_fetch_add((unsigned*)(p.ws + WS_BAR) + 3712, 1u, __ATOMIC_RELAXED, __HIP_MEMORY_SCOPE_AGENT);
    }
}
typedef float f32x16 __attribute__((ext_vector_type(16)));
__device__ __forceinline__ void p0_fold_item(const Params& p, LAS unsigned char* lds, int item) {
    LAS float* Wf = (LAS float*)lds;
    LAS float* Gm = (LAS float*)(lds + 65536);
    LAS float* wt = (LAS float*)(lds + 131072);
    const int tid = threadIdx.x, lane = tid & 63, w = tid >> 6, which = item >> 6, g = (item >> 4) & 3, ib = (item & 15) * 64;
    for (int u = tid; u < 4096; u += NTHREADS) *(LAS f32x4*)(Wf + 4 * u) = *(const f32x4*)(p.w_four + (size_t)g * 16384 + 4 * u);
    __syncthreads();
    {
        const int mt = w >> 1, nt0 = (w & 1) * 2, li = lane & 31, lk = lane >> 5, c = mt * 32 + li;
        f32x16 acc0, acc1;
#pragma unroll
        for (int r = 0; r < 16; ++r) { acc0[r] = 0.f; acc1[r] = 0.f; }
#pragma unroll 4
        for (int ks = 0; ks < 64; ++ks) { const int e = 2 * ks + lk; const float ang = (float)((c * e) & 127) * (1.0f / 128.0f);
            const float a = (which ? __builtin_amdgcn_sinf(ang) : __builtin_amdgcn_cosf(ang)) * 0.08838834764831845f;
            const float b0 = Wf[e * 128 + nt0 * 32 + li], b1 = Wf[e * 128 + nt0 * 32 + 32 + li];
            acc0 = __builtin_amdgcn_mfma_f32_32x32x2f32(a, b0, acc0, 0, 0, 0); acc1 = __builtin_amdgcn_mfma_f32_32x32x2f32(a, b1, acc1, 0, 0, 0); }
#pragma unroll
        for (int r = 0; r < 16; ++r) { const int row = mt * 32 + (r & 3) + 8 * (r >> 2) + 4 * lk; Gm[row * 128 + nt0 * 32 + li] = acc0[r]; Gm[row * 128 + nt0 * 32 + 32 + li] = acc1[r]; }
    }
    for (int sub = 0; sub < 2; ++sub) { const int i0 = ib + sub * 32;
    for (int u = tid; u < 4096; u += NTHREADS) { const int il = u >> 7, c = u & 127; wt[il * 129 + c] = p.w_in[(size_t)(i0 + il) * 2048 + g * 128 + c]; }
    __syncthreads();
    {
        const int li = lane & 15, lk = lane >> 4;
        f32x4 acc0 = (f32x4){0.f, 0.f, 0.f, 0.f}, acc1 = (f32x4){0.f, 0.f, 0.f, 0.f};
#pragma unroll 4
        for (int ks = 0; ks < 32; ++ks) { const int c = 4 * ks + lk; const float a = Gm[c * 128 + 16 * w + li], b0 = wt[li * 129 + c], b1 = wt[(16 + li) * 129 + c];
            acc0 = __builtin_amdgcn_mfma_f32_16x16x4f32(a, b0, acc0, 0, 0, 0); acc1 = __builtin_amdgcn_mfma_f32_16x16x4f32(a, b1, acc1, 0, 0, 0); }
        bf16_t* WA = (bf16_t*)(p.ws + WS_WA);
#pragma unroll
        for (int r = 0; r < 4; ++r) { const int d = 16 * w + lk * 4 + r; bf16_t* rowp = WA + (size_t)(which * 512 + g * 128 + d) * DM + i0;
            rowp[li] = (bf16_t)(cvt_pk_bf16(acc0[r], 0.f) & 0xffffu); rowp[16 + li] = (bf16_t)(cvt_pk_bf16(acc1[r], 0.f) & 0xffffu); }
    }
    __syncthreads();
    }
}
__device__ __forceinline__ void p0_transpose_item(const float* W, int ldw, int ncol0, int K, bf16_t* WT, int orow, const float* gk, LAS float* scr, int kb, int lane) {
    const int k0 = 64 * kb;
    float v[32];
#pragma unroll
    for (int i = 0; i < 32; ++i) v[i] = W[(size_t)(k0 + 2 * i + (lane >> 5)) * ldw + ncol0 + (lane & 31)];
    if (gk) {
#pragma unroll
        for (int i = 0; i < 32; ++i) v[i] *= gk[k0 + 2 * i + (lane >> 5)]; }
#pragma unroll
    for (int i = 0; i < 32; ++i) scr[(2 * i + (lane >> 5)) * 33 + (lane & 31)] = v[i];
    asm volatile("s_waitcnt lgkmcnt(0)" ::: "memory");
    const int c = lane & 7;
#pragma unroll
    for (int j = 0; j < 4; ++j) { const int n = (lane >> 3) + 8 * j; const LAS float* s = scr + (8 * c) * 33 + n;
        u32x4 o; o.x = cvt_pk_bf16(s[0 * 33], s[1 * 33]); o.y = cvt_pk_bf16(s[2 * 33], s[3 * 33]); o.z = cvt_pk_bf16(s[4 * 33], s[5 * 33]); o.w = cvt_pk_bf16(s[6 * 33], s[7 * 33]);
        *(u32x4*)(WT + (size_t)(orow + n) * K + k0 + 8 * c) = o; }
    asm volatile("s_waitcnt lgkmcnt(0)" ::: "memory");
}
__device__ __forceinline__ void p0_prologue(const Params& p, LAS unsigned char* lds) {
    const int tid = threadIdx.x, lane = tid & 63, wave = tid >> 6, G = gridDim.x;
    if (G == 256) {
        if (blockIdx.x < 128) p0_fold_item(p, lds, blockIdx.x); else if (blockIdx.x < 224) p0_mod_item(p, lds, blockIdx.x - 128);
    } else { for (int it = blockIdx.x; it < 96; it += G) p0_mod_item(p, lds, it);
        for (int it = blockIdx.x; it < 128; it += G) p0_fold_item(p, lds, it); }
    LAS float* scr = (LAS float*)(lds + wave * 16384);
    const int gw = blockIdx.x * NWAVES + wave, NGW = G * NWAVES;
    constexpr int I_QK = 16 * 32, I_V = 16 * 16;
    for (int it = gw; it < I_QK + I_V; it += NGW) {
        int r = it;
        if (r < I_QK) { const int kb = r >> 5, nb = r & 31; p0_transpose_item(p.w_in, 2048, 512 + nb * 32, DM, (bf16_t*)(p.ws + WS_WQK), nb * 32, nullptr, scr, kb, lane); continue; } r -= I_QK;
        { const int kb = r >> 4, nb = r & 15; p0_transpose_item(p.w_in, 2048, 1536 + nb * 32, DM, (bf16_t*)(p.ws + WS_WA), 1024 + nb * 32, nullptr, scr, kb, lane); }
    }
}
__device__ __forceinline__ void late_work(const Params& p, LAS unsigned char* lds, int hidx, int nh, int what) {
    const int tid = threadIdx.x, lane = tid & 63, wave = tid >> 6;
    LAS float* scr = (LAS float*)(lds + wave * 16384);
    const int gw = hidx * NWAVES + wave, NGW = nh * NWAVES;
    constexpr int I_O = 16 * 32, I_UP = 16 * 176, I_DN = 44 * 32;
    const int it_lo = (what & 1) ? 0 : I_O + I_UP, it_hi = (what & 2) ? I_O + I_UP + I_DN : ((what & 1) ? I_O + I_UP : it_lo);
    for (int it = it_lo + gw; it < it_hi; it += NGW) {
        int r = it;
        if (r < I_O) { const int kb = r >> 5, nb = r & 31; p0_transpose_item(p.w_out, DM, nb * 32, DM, (bf16_t*)(p.ws + WS_WOUT), nb * 32, kb < 8 ? p.g_four_out : p.g_na_out - 512, scr, kb, lane); continue; } r -= I_O;
        if (r < I_UP) { const int kb = r / 176, nb = r % 176; const int n0 = nb * 32; const int isv = n0 >= DFF, j = isv ? n0 - DFF : n0;
            p0_transpose_item(p.w_up, 2 * DFF, n0, DM, (bf16_t*)(p.ws + WS_WUP), (j >> 7) * 256 + isv * 128 + (j & 127), nullptr, scr, kb, lane); continue; } r -= I_UP;
        { const int kb = r >> 5, nb = r & 31; p0_transpose_item(p.w_down, DM, nb * 32, DFF, (bf16_t*)(p.ws + WS_WDN), nb * 32, nullptr, scr, kb, lane); }
    }
    bf16_t* CS = (bf16_t*)(p.ws + WS_CS);
    if (what & 4) for (int u = hidx * NTHREADS + tid; u < 2048 * 128; u += nh * NTHREADS) { const int kp = u >> 7, s0 = (u & 127) * 8, k = kp & 1023; float v[8];
#pragma unroll
        for (int j = 0; j < 8; ++j) { const float ang = (float)((k * (s0 + j)) & 2047) * (1.0f / 2048.0f); v[j] = (kp >= 1024 ? __builtin_amdgcn_sinf(ang) : __builtin_amdgcn_cosf(ang)) * 0.022097086912079608f; }
        u32x4 o; o.x = cvt_pk_bf16(v[0], v[1]); o.y = cvt_pk_bf16(v[2], v[3]); o.z = cvt_pk_bf16(v[4], v[5]); o.w = cvt_pk_bf16(v[6], v[7]);
        *(u32x4*)(CS + (size_t)kp * 1024 + s0) = o; }
}

__device__ __forceinline__ void pass_norm_mod(const float* src, const float* ssq, const float* g, const float* mod, int sh_off, int sc_off, bf16_t* dst) {
    constexpr int RW = 4;
    const int lane = threadIdx.x & 63, gw = blockIdx.x * NWAVES + (threadIdx.x >> 6), NGW = gridDim.x * NWAVES;
    if (!ssq && NGW == 2048) {
        const int rowb = gw * 8, b = rowb >> 11;
        f32x4 mul[4], sh[4];
#pragma unroll
        for (int j = 0; j < 4; ++j) { const f32x4 gg = ((const f32x4*)g)[lane + 64 * j], sc = ((const f32x4*)(mod + (size_t)b * NMOD + sc_off))[lane + 64 * j];
            mul[j] = gg * (1.0f + sc); sh[j] = ((const f32x4*)(mod + (size_t)b * NMOD + sh_off))[lane + 64 * j]; }
#pragma unroll
        for (int half = 0; half < 2; ++half) {
            f32x4 v[RW][4];
#pragma unroll
            for (int q = 0; q < RW; ++q) { const f32x4* xr = (const f32x4*)(src + (size_t)(rowb + half * RW + q) * DM) + lane;
#pragma unroll
                for (int j = 0; j < 4; ++j) v[q][j] = xr[64 * j]; }
#pragma unroll
            for (int q = 0; q < RW; ++q) { float t = 0.f;
#pragma unroll
                for (int j = 0; j < 4; ++j) t += (v[q][j][0] * v[q][j][0] + v[q][j][1] * v[q][j][1]) + (v[q][j][2] * v[q][j][2] + v[q][j][3] * v[q][j][3]);
                t = wave_sum(t); const float rstd = 1.0f / sqrtf(t * (1.0f / DM) + EPS);
                u32x2* o8 = (u32x2*)(dst + (size_t)(rowb + half * RW + q) * DM) + lane;
#pragma unroll
                for (int j = 0; j < 4; ++j) { const f32x4 h = (v[q][j] * rstd) * mul[j] + sh[j]; u32x2 w; w.x = cvt_pk_bf16(h[0], h[1]); w.y = cvt_pk_bf16(h[2], h[3]); o8[64 * j] = w; } }
        }
        return;
    }
    for (int row0 = gw; row0 < NTOK; row0 += RW * NGW) {
        f32x4 v[RW][4]; float s[RW];
#pragma unroll
        for (int q = 0; q < RW; ++q) { const int row = min(row0 + q * NGW, NTOK - 1); const f32x4* xr = (const f32x4*)(src + (size_t)row * DM) + lane;
#pragma unroll
            for (int j = 0; j < 4; ++j) v[q][j] = xr[64 * j]; }
#pragma unroll
        for (int q = 0; q < RW; ++q) { const int row = min(row0 + q * NGW, NTOK - 1); float t = 0.f;
#pragma unroll
            for (int j = 0; j < 4; ++j) t += (v[q][j][0] * v[q][j][0] + v[q][j][1] * v[q][j][1]) + (v[q][j][2] * v[q][j][2] + v[q][j][3] * v[q][j][3]);
            if (ssq) { t = ssq[(size_t)row * 16 + (lane & 15)]; t += __shfl_xor(t, 1); t += __shfl_xor(t, 2); t += __shfl_xor(t, 4); t += __shfl_xor(t, 8); }
            else t = wave_sum(t);
            s[q] = 1.0f / sqrtf(t * (1.0f / DM) + EPS); }
#pragma unroll
        for (int q = 0; q < RW; ++q) { const int row = row0 + q * NGW; if (row < NTOK) { const int b = row >> 11;
            const f32x4* g4 = (const f32x4*)g + lane; const f32x4* sh4 = (const f32x4*)(mod + (size_t)b * NMOD + sh_off) + lane; const f32x4* sc4 = (const f32x4*)(mod + (size_t)b * NMOD + sc_off) + lane;
            u32x2* o8 = (u32x2*)(dst + (size_t)row * DM) + lane;
#pragma unroll
            for (int j = 0; j < 4; ++j) { const f32x4 gg = g4[64 * j], sh = sh4[64 * j], sc = sc4[64 * j]; const f32x4 h = (v[q][j] * s[q] * gg) * (1.0f + sc) + sh;
                u32x2 w; w.x = cvt_pk_bf16(h[0], h[1]); w.y = cvt_pk_bf16(h[2], h[3]); o8[64 * j] = w; } } }
    }
}
__device__ __forceinline__ void pass_h_fold(const float* src, const float* g, const float* mod, bf16_t* H, bf16_t* HE, bf16_t* HO) {
    const int vb = (gridDim.x & 7) ? (int)blockIdx.x : (int)((blockIdx.x & 7) * (gridDim.x >> 3) + (blockIdx.x >> 3));
    const int lane = threadIdx.x & 63, gw = vb * NWAVES + (threadIdx.x >> 6), NGW = gridDim.x * NWAVES;
    for (int ch = gw; ch < 2048; ch += NGW) {
        const int b = ch >> 8, sb = (ch & 255) * 4;
        f32x4 mul[4], sh[4];
#pragma unroll
        for (int j = 0; j < 4; ++j) { const f32x4 gg = ((const f32x4*)g)[lane + 64 * j], sc = ((const f32x4*)(mod + (size_t)b * NMOD + DM))[lane + 64 * j];
            mul[j] = gg * (1.0f + sc); sh[j] = ((const f32x4*)(mod + (size_t)b * NMOD))[lane + 64 * j]; }
#pragma unroll
        for (int half = 0; half < 2; ++half) {
            f32x4 v[2][2][4];
#pragma unroll
            for (int q = 0; q < 2; ++q) { const int s = sb + half * 2 + q, pr = (s == 0) ? SEQ / 2 : SEQ - s;
                const f32x4* x0 = (const f32x4*)(src + (size_t)(b * SEQ + s) * DM) + lane; const f32x4* x1 = (const f32x4*)(src + (size_t)(b * SEQ + pr) * DM) + lane;
#pragma unroll
                for (int j = 0; j < 4; ++j) { v[q][0][j] = x0[64 * j]; v[q][1][j] = x1[64 * j]; } }
#pragma unroll
            for (int q = 0; q < 2; ++q) { const int s = sb + half * 2 + q, pr = (s == 0) ? SEQ / 2 : SEQ - s;
                float t0 = 0.f, t1 = 0.f;
#pragma unroll
                for (int j = 0; j < 4; ++j) { const f32x4 a = v[q][0][j], c = v[q][1][j]; t0 += (a[0] * a[0] + a[1] * a[1]) + (a[2] * a[2] + a[3] * a[3]); t1 += (c[0] * c[0] + c[1] * c[1]) + (c[2] * c[2] + c[3] * c[3]); }
                t0 = wave_sum(t0); t1 = wave_sum(t1);
                const float r0 = 1.0f / sqrtf(t0 * (1.0f / DM) + EPS), r1 = 1.0f / sqrtf(t1 * (1.0f / DM) + EPS);
                u32x2* o0 = (u32x2*)(H + (size_t)(b * SEQ + s) * DM) + lane; u32x2* o1 = (u32x2*)(H + (size_t)(b * SEQ + pr) * DM) + lane;
                u32x2* oe = (u32x2*)(HE + (size_t)(b * 1024 + s) * DM) + lane; u32x2* oo = (u32x2*)(HO + (size_t)(b * 1024 + s) * DM) + lane;
#pragma unroll
                for (int j = 0; j < 4; ++j) { const f32x4 h0 = (v[q][0][j] * r0) * mul[j] + sh[j], h1 = (v[q][1][j] * r1) * mul[j] + sh[j];
                    u32x2 w; w.x = cvt_pk_bf16(h0[0], h0[1]); w.y = cvt_pk_bf16(h0[2], h0[3]); o0[64 * j] = w;
                    w.x = cvt_pk_bf16(h1[0], h1[1]); w.y = cvt_pk_bf16(h1[2], h1[3]); o1[64 * j] = w;
                    const f32x4 e = (s == 0) ? h0 : h0 + h1, o = (s == 0) ? (f32x4){0.f, 0.f, 0.f, 0.f} : h0 - h1;
                    w.x = cvt_pk_bf16(e[0], e[1]); w.y = cvt_pk_bf16(e[2], e[3]); oe[64 * j] = w;
                    w.x = cvt_pk_bf16(o[0], o[1]); w.y = cvt_pk_bf16(o[2], o[3]); oo[64 * j] = w; } }
        }
    }
}
__device__ __forceinline__ void pass_xmid(const bf16_t* H, const bf16_t* WA, float* X) {
    const int lane = threadIdx.x & 63, gw = blockIdx.x * NWAVES + (threadIdx.x >> 6), NGW = gridDim.x * NWAVES;
    for (int t = gw; t < NBATCH * 512; t += NGW) { const int b = t >> 9, c = t & 511;
        const u32x4* hp = (const u32x4*)(H + (size_t)(b * SEQ + SEQ / 2) * DM) + lane * 2; const u32x4* wp = (const u32x4*)(WA + (size_t)c * DM) + lane * 2;
        float s = 0.f;
#pragma unroll
        for (int q = 0; q < 2; ++q) { const u32x4 hv = hp[q], wv = wp[q];
#pragma unroll
            for (int j = 0; j < 4; ++j) s += bf_lo(hv[j]) * bf_lo(wv[j]) + bf_hi(hv[j]) * bf_hi(wv[j]); }
        s = wave_sum(s);
        if (lane == 0) X[t] = s; }
}
__device__ __forceinline__ void pass_final(float* xo, const float* ssq, const float* g) {
    const int lane = threadIdx.x & 63, gw = blockIdx.x * NWAVES + (threadIdx.x >> 6), NGW = gridDim.x * NWAVES;
    for (int row = gw; row < NTOK; row += NGW) {
        f32x4* xr = (f32x4*)(xo + (size_t)row * DM) + lane;
        float s = ssq[(size_t)row * 16 + (lane & 15)]; s += __shfl_xor(s, 1); s += __shfl_xor(s, 2); s += __shfl_xor(s, 4); s += __shfl_xor(s, 8);
        const float rstd = 1.0f / sqrtf(s * (1.0f / DM) + EPS);
        const f32x4* g4 = (const f32x4*)g + lane;
#pragma unroll
        for (int j = 0; j < 4; ++j) { const f32x4 v = xr[64 * j]; xr[64 * j] = v * rstd * g4[64 * j]; }
    }
}
__device__ __forceinline__ void combine_row(int row, const float (&y)[8], const float* SSQNA, bf16_t* YCAT, int lane) {
    float s = 0.f;
#pragma unroll
    for (int j = 0; j < 8; ++j) s += y[j] * y[j];
    s = wave_sum(s);
    const float rstd = 1.0f / sqrtf(s * (1.0f / 512.0f) + EPS);
    u32x4 o; o.x = cvt_pk_bf16(y[0] * rstd, y[1] * rstd); o.y = cvt_pk_bf16(y[2] * rstd, y[3] * rstd); o.z = cvt_pk_bf16(y[4] * rstd, y[5] * rstd); o.w = cvt_pk_bf16(y[6] * rstd, y[7] * rstd);
    *(u32x4*)(YCAT + (size_t)row * DM + lane * 8) = o;
    float t = SSQNA[(size_t)row * 8 + (lane & 7)]; t += __shfl_xor(t, 1); t += __shfl_xor(t, 2); t += __shfl_xor(t, 4);
    const float rn = 1.0f / sqrtf(t * (1.0f / 512.0f) + EPS);
    u32x4* ap = (u32x4*)(YCAT + (size_t)row * DM + 512 + lane * 8); const u32x4 aw = *ap; u32x4 ow;
#pragma unroll
    for (int j = 0; j < 4; ++j) ow[j] = cvt_pk_bf16(bf_lo(aw[j]) * rn, bf_hi(aw[j]) * rn);
    *ap = ow;
}
__device__ __forceinline__ void pass_combine(const bf16_t* PQ, const float* SP, const float* XM, const float* SSQNA, bf16_t* YCAT) {
    const int vb = (gridDim.x & 7) ? (int)blockIdx.x : (int)((blockIdx.x & 7) * (gridDim.x >> 3) + (blockIdx.x >> 3));
    const int lane = threadIdx.x & 63, gw = vb * NWAVES + (threadIdx.x >> 6), NGW = gridDim.x * NWAVES;
    for (int pi0 = gw; pi0 < NBATCH * 1024; pi0 += NGW) {
        const int pi = (NGW == 2048) ? gw * 4 + (pi0 - gw) / NGW : pi0;
        const int b = pi >> 10, kk = pi & 1023;
        const u32x4 pw = *(const u32x4*)(PQ + (size_t)kk * 4096 + b * 512 + lane * 8), qw = *(const u32x4*)(PQ + (size_t)(1024 + kk) * 4096 + b * 512 + lane * 8);
        float y1[8], y2[8];
        const f32x4 xa = *(const f32x4*)(XM + b * 512 + lane * 8), xb = *(const f32x4*)(XM + b * 512 + lane * 8 + 4); const float xs = (kk & 1) ? -0.022097086912079608f : 0.022097086912079608f;
        const float xm[8] = {xa[0] * xs, xa[1] * xs, xa[2] * xs, xa[3] * xs, xb[0] * xs, xb[1] * xs, xb[2] * xs, xb[3] * xs};
#pragma unroll
        for (int j = 0; j < 4; ++j) { const float pl = bf_lo(pw[j]) + xm[2 * j], ph = bf_hi(pw[j]) + xm[2 * j + 1], ql = bf_lo(qw[j]), qh = bf_hi(qw[j]); y1[2 * j] = pl - ql; y1[2 * j + 1] = ph - qh; y2[2 * j] = pl + ql; y2[2 * j + 1] = ph + qh; }
        if (kk == 0) {
#pragma unroll
            for (int j = 0; j < 8; ++j) { const f32x4* sp = (const f32x4*)(SP + (size_t)(b * 512 + lane * 8 + j) * 32); f32x4 a = sp[0];
#pragma unroll
                for (int i = 1; i < 4; ++i) a += sp[i];
                y2[j] = ((a[0] + a[1]) + (a[2] + a[3])) * 0.022097086912079608f + xm[j]; }
        }
        combine_row(b * SEQ + kk, y1, SSQNA, YCAT, lane);
        combine_row(b * SEQ + (kk == 0 ? 1024 : SEQ - kk), y2, SSQNA, YCAT, lane);
    }
}
__device__ __forceinline__ void pass_fixup(const bf16_t* side, const float* cw, const float* cb, bf16_t* A, int ri0, int nri, int widx, int nw) {
    const int total = nri * (DFF / 4);
    for (int u = widx * NTHREADS + threadIdx.x; u < total; u += nw * NTHREADS) {
        const int ri = ri0 + u / (DFF / 4), J = (u % (DFF / 4)) * 4, chunk = ri >> 1, bot = ri & 1;
        const bf16_t* sc = side + (size_t)chunk * 4 * (2 * DFF);
        const bf16_t *pp, *pc, *pn; bool hp = true, hn = true; int tok;
        if (!bot) { hp = (chunk & 31) != 0; pp = sc - (2 * DFF); pc = sc; pn = sc + (2 * DFF); tok = chunk * 64; }
        else { hn = (chunk & 31) != 31; pp = sc + 2 * (2 * DFF); pc = sc + 3 * (2 * DFF); pn = sc + 4 * (2 * DFF); tok = chunk * 64 + 63; }
        float up[2][4];
#pragma unroll
        for (int bj = 0; bj < 2; ++bj) {
            const int col = bj * DFF + J;
            u32x2 wp = (u32x2){0u, 0u}, wn = (u32x2){0u, 0u}; if (hp) wp = *(const u32x2*)(pp + col); if (hn) wn = *(const u32x2*)(pn + col); const u32x2 wc2 = *(const u32x2*)(pc + col);
            const f32x4 k0 = *(const f32x4*)(cw + col), k1 = *(const f32x4*)(cw + 2 * DFF + col), k2 = *(const f32x4*)(cw + 4 * DFF + col), kb = *(const f32x4*)(cb + col);
            const float pv[4] = {bf_lo(wp.x), bf_hi(wp.x), bf_lo(wp.y), bf_hi(wp.y)}, cv[4] = {bf_lo(wc2.x), bf_hi(wc2.x), bf_lo(wc2.y), bf_hi(wc2.y)}, nv[4] = {bf_lo(wn.x), bf_hi(wn.x), bf_lo(wn.y), bf_hi(wn.y)};
#pragma unroll
            for (int j = 0; j < 4; ++j) up[bj][j] = k0[j] * pv[j] + k1[j] * cv[j] + k2[j] * nv[j] + kb[j];
        }
        u32x2 w; w.x = cvt_pk_bf16(silu_f(up[0][0]) * up[1][0], silu_f(up[0][1]) * up[1][1]); w.y = cvt_pk_bf16(silu_f(up[0][2]) * up[1][2], silu_f(up[0][3]) * up[1][3]);
        *(u32x2*)(A + (size_t)tok * DFF + J) = w;
    }
}

__device__ __forceinline__ void attn_phase(const Params& p, LAS unsigned char* lds) {
    const int tid = threadIdx.x, lane = tid & 63, w = __builtin_amdgcn_readfirstlane(tid >> 6), fr = lane & 15, fq = lane >> 4;
    LAS unsigned char* Ks = lds;
    LAS unsigned char* Vs = lds + 73728;
    LAS float* rp = (LAS float*)(lds + 147456);
    volatile LAS unsigned* slot = (volatile LAS unsigned*)(lds + 147456 + 2048);
    const bf16_t* QH = (const bf16_t*)(p.ws + WS_QK); const bf16_t* KH = (const bf16_t*)(p.ws + WS_QK + (16u << 20)); const bf16_t* VTA = (const bf16_t*)(p.ws + WS_VTA);
    bf16_t* YCAT = (bf16_t*)(p.ws + WS_YCAT); float* SSQNA = (float*)(p.ws + WS_SSQ1 + 512 * 1024);
    const float sc2 = 0.125f * 1.4426950408889634f;
    unsigned* ctr = (unsigned*)(p.ws + WS_BAR) + 3584;
    const int ri = w >> 2, qb = w & 3, q0 = qb * 16, kc0 = min(max(q0 - 8, 0), 32);
    const int kperm = 8 * (fr >> 2) + (fr & 3);
    for (;;) {
        __syncthreads();
        if (tid == 0) slot[0] = __hip_atomic_fetch_add(ctr, 1u, __ATOMIC_RELAXED, __HIP_MEMORY_SCOPE_AGENT);
        __syncthreads();
        const int item = (int)slot[0];
        if (item >= 1024) break;
        const int b = item >> 7, h = (item >> 4) & 7, r0 = (item & 15) * 2, R0 = min(max(r0 - 4, 0), 24);
        const int r = r0 + ri, rs = min(max(r - 4, 0), 24), j0 = rs - R0;
        const int tq = b * SEQ + r * 64 + q0 + fr;
        const bf16_t* qp = QH + ((size_t)(b * 8 + h) * SEQ + r * 64 + q0 + fr) * 64 + fq * 8;
        const bf16x8 qf0 = *(const bf16x8*)qp, qf1 = *(const bf16x8*)(qp + 32);
        for (int u = tid; u < 465; u += NTHREADS) rp[u] = p.rpb[h * 465 + u] * 1.4426950408889634f;
        { const int t = tid >> 3, c = tid & 7; const unsigned dstk = (unsigned)(t * 128 + ((c ^ (((t >> 1) & 1) | (((t >> 3) & 3) << 1))) << 4)), dstv = (unsigned)(t * 128 + ((c ^ ((t >> 1) & 7)) << 4));
          u32x4 kv[9], vv[9];
#pragma unroll
          for (int j = 0; j < 9; ++j) { const int srow = min(R0 + j, 31);
              kv[j] = *(const u32x4*)(KH + ((size_t)(b * 8 + h) * SEQ + srow * 64 + t) * 64 + c * 8);
              vv[j] = *(const u32x4*)(VTA + ((size_t)((b * 8 + h) * 32 + srow) * 64 + t) * 64 + c * 8); }
#pragma unroll
          for (int j = 0; j < 9; ++j) { *(LAS u32x4*)(Ks + j * 8192 + dstk) = kv[j]; *(LAS u32x4*)(Vs + j * 8192 + dstv) = vv[j]; } }
        __syncthreads();
        f32x4 s[8][2];
#pragma unroll
        for (int i = 0; i < 8; ++i)
#pragma unroll
            for (int t = 0; t < 2; ++t) { const int tok = kc0 + kperm + 4 * t; const LAS unsigned char* kr = Ks + (j0 + i) * 8192 + tok * 128;
                const int fk = ((tok >> 1) & 1) | (((tok >> 3) & 3) << 1);
                const bf16x8 k0 = *(const LAS bf16x8*)(kr + ((fq ^ fk) << 4)), k1 = *(const LAS bf16x8*)(kr + (((4 + fq) ^ fk) << 4));
                f32x4 a = (f32x4){0.f, 0.f, 0.f, 0.f};
                a = __builtin_amdgcn_mfma_f32_16x16x32_bf16(k0, qf0, a, 0, 0, 0); a = __builtin_amdgcn_mfma_f32_16x16x32_bf16(k1, qf1, a, 0, 0, 0); s[i][t] = a; }
        const int qc = q0 + fr, cs0 = min(max(qc - 8, 0), 48);
        float madd[2][4]; int dco[2][4];
#pragma unroll
        for (int t = 0; t < 2; ++t)
#pragma unroll
            for (int j = 0; j < 4; ++j) { const int kc = kc0 + 8 * fq + 4 * t + j; madd[t][j] = ((kc >= cs0) && (kc < cs0 + 16)) ? 0.f : -1e30f; dco[t][j] = min(max(kc - qc, -15), 15); }
        float mx = -1e30f;
#pragma unroll
        for (int i = 0; i < 8; ++i) { const int dr = rs + i - r; const LAS float* rrow = rp + (dr + 7) * 31 + 15;
#pragma unroll
            for (int t = 0; t < 2; ++t)
#pragma unroll
                for (int j = 0; j < 4; ++j) { const float v = (s[i][t][j] * sc2 + rrow[dco[t][j]]) + madd[t][j]; s[i][t][j] = v; mx = fmaxf(mx, v); } }
        mx = fmaxf(mx, __shfl_xor(mx, 16)); mx = fmaxf(mx, __shfl_xor(mx, 32));
        float sum = 0.f;
#pragma unroll
        for (int i = 0; i < 8; ++i)
#pragma unroll
            for (int t = 0; t < 2; ++t)
#pragma unroll
                for (int j = 0; j < 4; ++j) { const float e = __builtin_amdgcn_exp2f(s[i][t][j] - mx); s[i][t][j] = e; sum += e; }
        sum += __shfl_xor(sum, 16); sum += __shfl_xor(sum, 32);
        const float inv = 1.0f / sum;
        f32x4 o[4];
#pragma unroll
        for (int nb = 0; nb < 4; ++nb) o[nb] = (f32x4){0.f, 0.f, 0.f, 0.f};
        const int vc = (kc0 >> 3) + fq;
#pragma unroll
        for (int i = 0; i < 8; ++i) {
            u32x4 pw; pw.x = cvt_pk_bf16(s[i][0][0], s[i][0][1]); pw.y = cvt_pk_bf16(s[i][0][2], s[i][0][3]); pw.z = cvt_pk_bf16(s[i][1][0], s[i][1][1]); pw.w = cvt_pk_bf16(s[i][1][2], s[i][1][3]);
            const bf16x8 pf = __builtin_bit_cast(bf16x8, pw);
#pragma unroll
            for (int nb = 0; nb < 4; ++nb) { const int d = nb * 16 + fr; const bf16x8 va = *(const LAS bf16x8*)(Vs + (j0 + i) * 8192 + d * 128 + ((vc ^ ((d >> 1) & 7)) << 4));
                o[nb] = __builtin_amdgcn_mfma_f32_16x16x32_bf16(va, pf, o[nb], 0, 0, 0); } }
        float q2 = 0.f;
#pragma unroll
        for (int nb = 0; nb < 4; ++nb) { o[nb] = o[nb] * inv; q2 += (o[nb][0] * o[nb][0] + o[nb][1] * o[nb][1]) + (o[nb][2] * o[nb][2] + o[nb][3] * o[nb][3]); }
        q2 += __shfl_xor(q2, 16); q2 += __shfl_xor(q2, 32);
        if (fq == 0) SSQNA[(size_t)tq * 8 + h] = q2;
        bf16_t* op = YCAT + (size_t)tq * DM + 512 + h * 64 + 4 * fq;
#pragma unroll
        for (int nb = 0; nb < 4; ++nb) { u32x2 wv; wv.x = cvt_pk_bf16(o[nb][0], o[nb][1]); wv.y = cvt_pk_bf16(o[nb][2], o[nb][3]); *(u32x2*)(op + nb * 16) = wv; }
    }
    __syncthreads();
}

constexpr int N_PHASES = 11;
__global__ void __launch_bounds__(NTHREADS, 2) fwd_megakernel(Params p) {
    extern __shared__ __attribute__((aligned(16))) unsigned char lds_raw[];
    LAS unsigned char* lds = (LAS unsigned char*)lds_raw;
    volatile LAS unsigned* bst = (volatile LAS unsigned*)(lds + LDS_BYTES - 16);
    const int lo = p.ph_lo, hi = p.ph_hi, G = gridDim.x, cid = blockIdx.x;
    if (threadIdx.x < 4) bst[threadIdx.x] = 0u;
    __syncthreads();
    XcdBarrier bar; bar.bar = (unsigned*)(p.ws + WS_BAR); bar.x = 0; bar.st = bst; bar.G = gridDim.x;
    if (!MK_PER_PHASE) bar = xcd_barrier_post((unsigned*)(p.ws + WS_BAR), bst, gridDim.x);
    XcdBarrier gbar; gbar.bar = (unsigned*)(p.ws + WS_BAR + 65536 + 16384 * (blockIdx.x & 7)); gbar.x = 0; gbar.st = bst + 2; gbar.G = gridDim.x >> 3;
    if (!MK_PER_PHASE && gridDim.x == 256) gbar = xcd_barrier_post(gbar.bar, bst + 2, gridDim.x >> 3);
    if (lo < 0) cg::this_grid().sync();
#define IN(k) (lo <= (k) && (k) < hi)
#define REP(k) for (int rep_ = 0; rep_ < 1 + ((REPEAT_MASK >> (k)) & 1); ++rep_)
#define SEAM(k) do { if (IN(k) && IN((k) + 1)) xcd_barrier(bar); } while (0)
    unsigned char* ws = p.ws;
    const float* mod = (const float*)(ws + WS_MOD);

    if (IN(0)) REP(0) p0_prologue(p, lds);
    if (IN(0) && IN(1)) {
        if (threadIdx.x < 64) { unsigned sp = 0; unsigned* mc = (unsigned*)(ws + WS_BAR) + 3712;
            while ((unsigned)__builtin_amdgcn_readfirstlane(__hip_atomic_load(mc, __ATOMIC_RELAXED, __HIP_MEMORY_SCOPE_AGENT)) < 96u) { __builtin_amdgcn_s_sleep(2); if (++sp > (1u << 22)) break; }
            __builtin_amdgcn_fence(__ATOMIC_ACQUIRE, "agent");
            asm volatile("s_waitcnt vmcnt(0)" ::: "memory"); }
        __syncthreads();
    }
    if (IN(1)) REP(1) pass_h_fold(p.x, p.g_mix, mod, (bf16_t*)(ws + WS_H), (bf16_t*)(ws + WS_HE), (bf16_t*)(ws + WS_HO));
    SEAM(1);
    if (IN(2)) { SchedP2 S{(const char*)(ws + WS_H), (const char*)(ws + WS_HE), (const char*)(ws + WS_HO), (const char*)(ws + WS_WQK), (const char*)(ws + WS_WA), (char*)(ws + WS_QK), (char*)(ws + WS_VT), (char*)(ws + WS_VTA), (float*)(ws + WS_SSQ2 + 512 * 1024), G, cid};
        pg8::EpiTileBf16 E; pg8::gemm_phase(lds, DM, S, E);
        late_work(p, lds, cid, G, 4); }
    SEAM(2);
    if (IN(3)) { pass_xmid((const bf16_t*)(ws + WS_H), (const bf16_t*)(ws + WS_WA), (float*)(ws + WS_SSQ2 + 256 * 1024));
        SchedFourier S{(const char*)(ws + WS_CS), (const char*)(ws + WS_VT), (char*)(ws + WS_PQ), G, cid};
        pg8::EpiTileBf16 E; pg8::gemm_phase(lds, 1024, S, E);
        if (G == 256) { if (cid >= 128) late_work(p, lds, cid - 128, 128, 3); } else late_work(p, lds, cid, G, 3);
        attn_phase(p, lds); }
    SEAM(3);
    if (IN(4)) REP(4) pass_combine((const bf16_t*)(ws + WS_PQ), (const float*)(ws + WS_SSQ2 + 512 * 1024), (const float*)(ws + WS_SSQ2 + 256 * 1024), (const float*)(ws + WS_SSQ1 + 512 * 1024), (bf16_t*)(ws + WS_YCAT));
    const bool fuse = (G == 256);
#define GSEAM(k, k2) do { if (IN(k) && IN(k2)) { if (fuse) xcd_barrier(gbar); else xcd_barrier(bar); } } while (0)
    GSEAM(4, 5);
    if (IN(5)) { SchedPlain S{(const char*)(ws + WS_YCAT), (const char*)(ws + WS_WOUT), 64, 4, DM, G, cid};
        if (fuse) { pg8::EpiResidNormMod E{p.x, (bf16_t*)(ws + WS_X1B), mod, 2 * DM, 3 * DM, 4 * DM, p.g_ffn, (bf16_t*)(ws + WS_H), pg8::PanelSsq{(float*)(ws + WS_SSQ1), (unsigned*)(ws + WS_BAR + 16384)}}; pg8::gemm_phase(lds, DM, S, E); }
        else { pg8::EpiResid E{p.x, p.out, mod + 2 * DM, (float*)(ws + WS_SSQ1)}; pg8::gemm_phase(lds, DM, S, E); } }
    if (!fuse) SEAM(5);
    if (IN(6) && !fuse) pass_norm_mod(p.out, (const float*)(ws + WS_SSQ1), p.g_ffn, mod, 3 * DM, 4 * DM, (bf16_t*)(ws + WS_H));
    if (fuse) GSEAM(5, 7); else SEAM(6);
    if (IN(7)) REP(7) { SchedPlain S{(const char*)(ws + WS_H), (const char*)(ws + WS_WUP), 64, 22, DM, G, cid};
        pg8::EpiUp E{(bf16_t*)(ws + WS_A), (bf16_t*)(ws + WS_SIDE), p.conv_w, p.conv_b}; pg8::gemm_phase(lds, DM, S, E);
        }
    GSEAM(7, 8);
    if (IN(8)) { if (fuse) pass_fixup((const bf16_t*)(ws + WS_SIDE), p.conv_w, p.conv_b, (bf16_t*)(ws + WS_A), 64 * (cid & 7), 64, cid >> 3, G >> 3);
        else pass_fixup((const bf16_t*)(ws + WS_SIDE), p.conv_w, p.conv_b, (bf16_t*)(ws + WS_A), 0, 512, cid, G); }
    GSEAM(8, 9);
    if (REPEAT_MASK & (1 << 20)) { for (int e_ = 0; e_ < 8; ++e_) xcd_barrier(bar); }
    if (IN(9)) { SchedPlain S{(const char*)(ws + WS_A), (const char*)(ws + WS_WDN), 64, 4, DFF, G, cid};
        if (fuse) { pg8::EpiResidNormOut E{(const bf16_t*)(ws + WS_X1B), p.out, mod, 5 * DM, p.g_final, pg8::PanelSsq{(float*)(ws + WS_SSQ2), (unsigned*)(ws + WS_BAR + 32768)}}; pg8::gemm_phase(lds, DFF, S, E); }
        else { pg8::EpiResid E{p.out, p.out, mod + 5 * DM, (float*)(ws + WS_SSQ2)}; pg8::gemm_phase(lds, DFF, S, E); } }
    if (!fuse) SEAM(9);
    if (IN(10) && !fuse) pass_final(p.out, (const float*)(ws + WS_SSQ2), p.g_final);
#undef IN
#undef SEAM
#undef GSEAM
}

extern "C" void kernel_launch(void* const* d_in, const int* in_sizes, int n_in, void* d_out, int out_size, void* d_ws, size_t ws_size, hipStream_t stream) {
    static int grid = 0;
    if (grid == 0) {
        int dev = 0, cus = 0, per_cu = 0;
        if (n_in != 17 || ws_size < WS_END) { fprintf(stderr, "kernel_launch: unexpected inputs (n_in %d, ws %zu)\n", n_in, ws_size); grid = -1; return; }
        hipGetDevice(&dev);
        hipDeviceGetAttribute(&cus, hipDeviceAttributeMultiprocessorCount, dev);
        if (hipFuncSetAttribute((const void*)fwd_megakernel, hipFuncAttributeMaxDynamicSharedMemorySize, LDS_BYTES) != hipSuccess) { fprintf(stderr, "kernel_launch: hipFuncSetAttribute failed\n"); grid = -1; return; }
        hipOccupancyMaxActiveBlocksPerMultiprocessor(&per_cu, (const void*)fwd_megakernel, NTHREADS, LDS_BYTES);
        if (per_cu < 1) { fprintf(stderr, "kernel_launch: occupancy query says %d blocks per CU\n", per_cu); per_cu = 1; }
        (void)hipGetLastError();
        grid = cus;
    }
    if (grid < 0) return;
    Params p{};
    const float** f = (const float**)&p;
    for (int i = 0; i < 17; ++i) f[i] = (const float*)d_in[i];
    p.out = (float*)d_out; p.ws = (unsigned char*)d_ws;
    hipMemsetAsync((char*)d_ws + WS_BAR, 0, 196608, stream);
#if MK_PER_PHASE
    for (int ph = 0; ph < N_PHASES; ++ph) { p.ph_lo = ph; p.ph_hi = ph + 1; hipLaunchKernelGGL(fwd_megakernel, dim3(grid), dim3(NTHREADS), LDS_BYTES, stream, p); }
#else
    p.ph_lo = 0; p.ph_hi = N_PHASES;
    void* args[] = {&p};
    hipError_t e = hipLaunchCooperativeKernel((const void*)fwd_megakernel, dim3(grid), dim3(NTHREADS), args, LDS_BYTES, stream);
    if (e != hipSuccess) fprintf(stderr, "cooperative launch failed: %s (grid %d)\n", hipGetErrorString(e), grid);
#endif
}
```

```cpp
#include <hip/hip_runtime.h>
#include <hip/hip_cooperative_groups.h>
#include <cstdio>
namespace cg = cooperative_groups;

#ifndef REPEAT_MASK
#define REPEAT_MASK 0
#endif
#ifndef MK_PER_PHASE
#define MK_PER_PHASE 0
#endif

#define LAS __attribute__((address_space(3)))
typedef unsigned short bf16_t;
typedef short bf16x8 __attribute__((ext_vector_type(8)));
typedef float f32x4 __attribute__((ext_vector_type(4)));
typedef float f32x2 __attribute__((ext_vector_type(2)));
typedef unsigned u32x4 __attribute__((ext_vector_type(4)));
typedef unsigned u32x2 __attribute__((ext_vector_type(2)));

constexpr int DM = 1024, NBATCH = 8, SEQ = 2048, NTOK = NBATCH * SEQ, DFF = 2816, NMOD = 6 * DM;
constexpr float EPS = 1e-6f;
constexpr int NTHREADS = 512, NWAVES = 8;
constexpr int LDS_STAGE = 131072, LDS_EXTRA = 20480, LDS_BYTES = LDS_STAGE + LDS_EXTRA;

constexpr size_t MiB = 1u << 20;
constexpr size_t WS_MOD = 0;
constexpr size_t WS_BAR = 512 * 1024;
constexpr size_t WS_SSQ1 = 1 * MiB;
constexpr size_t WS_SSQ2 = 2 * MiB;
constexpr size_t WS_WQK = 3 * MiB;
constexpr size_t WS_WA = 5 * MiB;
constexpr size_t WS_WOUT = 8 * MiB;
constexpr size_t WS_WUP = 10 * MiB;
constexpr size_t WS_WDN = 21 * MiB;
constexpr size_t WS_CS = 27 * MiB;
constexpr size_t WS_H = 47 * MiB;
constexpr size_t WS_VT = 79 * MiB;
constexpr size_t WS_QK = 95 * MiB;
constexpr size_t WS_VTA = 127 * MiB;
constexpr size_t WS_PQ = 31 * MiB;
constexpr size_t WS_YCAT = 178 * MiB;
constexpr size_t WS_A = 79 * MiB;
constexpr size_t WS_SIDE = 167 * MiB;
constexpr size_t WS_HE = 143 * MiB;
constexpr size_t WS_HO = 159 * MiB;
constexpr size_t WS_X1B = 210 * MiB;
constexpr size_t WS_END = 242 * MiB;

struct Params {
    const float *x, *c, *w_ada, *b_ada, *g_mix, *w_in, *w_four, *rpb, *g_four_out, *g_na_out, *w_out, *g_ffn, *w_up, *conv_w, *conv_b, *w_down, *g_final;
    float* out; unsigned char* ws;
    int ph_lo, ph_hi;
};

__device__ __forceinline__ unsigned cvt_pk_bf16(float lo, float hi) { unsigned r; asm volatile("v_cvt_pk_bf16_f32 %0, %1, %2" : "=v"(r) : "v"(lo), "v"(hi)); return r; }
__device__ __forceinline__ float bf_lo(unsigned w) { return __uint_as_float(w << 16); }
__device__ __forceinline__ float bf_hi(unsigned w) { return __uint_as_float(w & 0xffff0000u); }
__device__ __forceinline__ float wave_sum(float v) {
#pragma unroll
    for (int o = 1; o < 64; o <<= 1) v += __shfl_xor(v, o);
    return v;
}
__device__ __forceinline__ float silu_f(float v) { return v * __builtin_amdgcn_rcpf(1.0f + __expf(-v)); }
template <int CTRL> __device__ __forceinline__ float dpp_f(float v) {
    return __builtin_bit_cast(float, __builtin_amdgcn_mov_dpp(__builtin_bit_cast(int, v), CTRL, 0xF, 0xF, true));
}

#define XB_TMO      128
#define XB_XCNT(j)  (256  + 64 * (j))
#define XB_XSUB(j)  (1280 + 64 * (j))
#define XB_XGEN(j)  (2304 + 64 * (j))
#define XB_TOP      3328
#define XB_TOPGEN   3392
#define XCD_BAR_WORDS 3456
#define XB_SPIN_CAP (1u << 20)
__device__ __forceinline__ unsigned xb_ld(unsigned* p)              { return __hip_atomic_load(p, __ATOMIC_RELAXED, __HIP_MEMORY_SCOPE_AGENT); }
__device__ __forceinline__ unsigned xb_add(unsigned* p, unsigned v) { return __hip_atomic_fetch_add(p, v, __ATOMIC_RELAXED, __HIP_MEMORY_SCOPE_AGENT); }
__device__ __forceinline__ unsigned xb_xcc_id() { return (unsigned)__builtin_amdgcn_s_getreg((3 << 11) | 20) & 0xFu; }
#define XB_SPIN(cond, bar) do { unsigned _sp = 0; while (cond) { __builtin_amdgcn_s_sleep(1); \
    if ((++_sp & 255u) == 0u) { if (xb_ld(&(bar)[XB_TMO])) break; if (_sp > XB_SPIN_CAP) { atomicAdd(&(bar)[XB_TMO], 1u); break; } } } } while (0)
struct XcdBarrier { unsigned* bar; unsigned x; volatile LAS unsigned* st; unsigned G; };
__device__ __forceinline__ XcdBarrier xcd_barrier_post(unsigned* bar, volatile LAS unsigned* st, unsigned G) {
    XcdBarrier b; b.bar = bar; b.x = xb_xcc_id(); b.st = st; b.G = G;
    if (threadIdx.x == 0) (void)xb_add(&bar[XB_XCNT(b.x)], 1u);
    return b;
}
__device__ __forceinline__ void xcd_barrier_complete(unsigned* bar, unsigned x, unsigned& nloc, unsigned& nx, const unsigned G) {
    unsigned sum, cnt, mine, sp = 0u;
    for (;;) {
        sum = 0u; cnt = 0u; mine = 0u;
#pragma unroll
        for (unsigned j = 0; j < 16; ++j) { const unsigned c = xb_ld(&bar[XB_XCNT(j)]); sum += c; cnt += (c > 0u) ? 1u : 0u; mine = (j == x) ? c : mine; }
        if (sum == G) break;
        __builtin_amdgcn_s_sleep(1);
        if ((++sp & 255u) == 0u) { if (xb_ld(&bar[XB_TMO])) break; if (sp > XB_SPIN_CAP) { atomicAdd(&bar[XB_TMO], 1u); break; } }
    }
    nloc = mine > 0u ? mine : 1u; nx = cnt > 0u ? cnt : 1u;
}
__device__ __forceinline__ void xcd_barrier(const XcdBarrier& b) {
    asm volatile("s_waitcnt vmcnt(0)" ::: "memory");
    __syncthreads();
    if (threadIdx.x == 0) {
        unsigned* bar = b.bar;
        __builtin_amdgcn_s_waitcnt(0);
        unsigned nloc = b.st[0], nx = b.st[1];
        if (nloc == 0u) { xcd_barrier_complete(bar, b.x, nloc, nx, b.G); b.st[0] = nloc; b.st[1] = nx; }
        const unsigned old = xb_add(&bar[XB_XSUB(b.x)], 1u);
        const unsigned gen = old / nloc;
        if (old + 1u == (gen + 1u) * nloc) {
            __builtin_amdgcn_fence(__ATOMIC_RELEASE, "agent");
            asm volatile("s_waitcnt vmcnt(0)" ::: "memory");
            const unsigned og = xb_add(&bar[XB_TOP], 1u);
            const unsigned tg = og / nx;
            if (og + 1u == (tg + 1u) * nx) xb_add(&bar[XB_TOPGEN], 1u);
            else XB_SPIN(xb_ld(&bar[XB_TOPGEN]) == tg, bar);
            __builtin_amdgcn_fence(__ATOMIC_ACQUIRE, "agent");
            xb_add(&bar[XB_XGEN(b.x)], 1u);
            asm volatile("s_waitcnt vmcnt(0)" ::: "memory");
        } else {
            XB_SPIN(xb_ld(&bar[XB_XGEN(b.x)]) == gen, bar);
            __builtin_amdgcn_fence(__ATOMIC_ACQUIRE, "agent");
            asm volatile("s_waitcnt vmcnt(0)" ::: "memory");
        }
    }
    __syncthreads();
}

__device__ __forceinline__ void group_barrier(unsigned* ctr, unsigned& gen, unsigned nmemb) {
    asm volatile("s_waitcnt vmcnt(0)" ::: "memory");
    __syncthreads();
    ++gen;
    if (threadIdx.x == 0) {
        __builtin_amdgcn_fence(__ATOMIC_RELEASE, "agent");
        asm volatile("s_waitcnt vmcnt(0)" ::: "memory");
        (void)xb_add(ctr, 1u);
        const unsigned target = gen * nmemb; unsigned sp = 0;
        while (xb_ld(ctr) < target) { __builtin_amdgcn_s_sleep(1); if (++sp > (1u << 22)) break; }
        __builtin_amdgcn_fence(__ATOMIC_ACQUIRE, "agent");
        asm volatile("s_waitcnt vmcnt(0)" ::: "memory");
    }
    __syncthreads();
}

namespace pg8 {
constexpr int BM = 256, BK = 64, HALF = 128, HTB = HALF * BK * 2, NXCD = 8, WGM = 8;
__device__ __forceinline__ int lds_byte(int r, int c) { const int st = (r >> 4) * 2 + (c >> 5), rr = r & 15, cc = c & 31, ob = rr * 64 + cc * 2; return st * 1024 + (ob ^ (((ob >> 9) & 1) << 5)); }
__device__ __forceinline__ void stage_rc(int b, int& R, int& C) { const int st = b / 1024, sb = b % 1024, swz = sb ^ (((sb >> 9) & 1) << 5); R = (st >> 1) * 16 + swz / 64; C = (st & 1) * 32 + (swz % 64) / 2; }
__device__ __forceinline__ int perm32(int rho) { const int n = rho >> 4, i = rho & 15; return 8 * (i >> 2) + 4 * n + (i & 3); }

struct Unit { const char* pa; const char* pb; char* po; float* sp; int rp, RS, CS; int pm, pn; };

__device__ __forceinline__ void tile_map(int wgid, int nM, int nN, int& pm, int& pn) {
    const int nwg = nM * nN;
    { const int q = nwg / NXCD, r = nwg % NXCD, xcd = wgid % NXCD, off = wgid / NXCD; wgid = (xcd < r ? xcd * (q + 1) : r * (q + 1) + (xcd - r) * q) + off; }
    const int nig = WGM * nN, gid = wgid / nig, fm = gid * WGM, gsz = (nM - fm) < WGM ? (nM - fm) : WGM;
    pm = fm + ((wgid % nig) % gsz); pn = (wgid % nig) / gsz;
}

template <class Epi, class Sched>
__device__ __forceinline__ void gemm_phase(LAS unsigned char* lds, const int K, const Sched& S, const Epi& E) {
    const int tid = threadIdx.x, wid = __builtin_amdgcn_readfirstlane(tid >> 6), lane = tid & 63, wr = wid >> 2, wc = wid & 3, fr = lane & 15, fq = lane >> 4;
    const int nt = K / BK;
    unsigned voffA[2], voffB[2];
#pragma unroll
    for (int i = 0; i < 2; ++i) { int R, C; stage_rc(tid * 16 + i * 8192, R, C); const int Rb = Epi::PERM ? ((R & ~31) + perm32(R & 31)) : R;
        const int Ra = Epi::APERM ? ((R & 64) + 4 * (R & 15) + ((R >> 4) & 3)) : R;
        voffA[i] = (unsigned)(Ra * K + C) * 2u; voffB[i] = (unsigned)(Rb * K + C) * 2u; }
    const size_t kstep = (size_t)(BK * 2);
    const size_t hstep = (size_t)HALF * K * 2;
    const unsigned ldsw = (unsigned)wid * 1024u;
    const int aoff = lds_byte(wr * 64 + fr, fq * 8), boff = lds_byte(wc * 32 + fr, fq * 8);
#define PG8_SA(b, h) (((b) * 2 + (h)) * HTB)
#define PG8_SB(b, h) ((4 + (b) * 2 + (h)) * HTB)
#define PG8_STAGE(bufoff, gbase, voff) do { _Pragma("unroll") for (int _i = 0; _i < 2; ++_i) \
        __builtin_amdgcn_global_load_lds((const unsigned*)((const char*)(gbase) + (voff)[_i]), (LAS unsigned*)(lds + (bufoff) + ldsw + _i * 8192), 16, 0, 0); } while (0)
#define PG8_LDA(dst, b, h) do { _Pragma("unroll") for (int m = 0; m < 4; ++m) _Pragma("unroll") for (int k = 0; k < 2; ++k) dst[m][k] = *(const LAS bf16x8*)(lds + PG8_SA(b, h) + aoff + m * 2048 + k * 1024); } while (0)
#define PG8_LDB(dst, b, h) do { _Pragma("unroll") for (int n = 0; n < 2; ++n) _Pragma("unroll") for (int k = 0; k < 2; ++k) dst[n][k] = *(const LAS bf16x8*)(lds + PG8_SB(b, h) + boff + n * 2048 + k * 1024); } while (0)
#define PG8_MMA(ai, bj, At, Bt) do { __builtin_amdgcn_s_setprio(1); _Pragma("unroll") for (int m = 0; m < 4; ++m) _Pragma("unroll") for (int n = 0; n < 2; ++n) _Pragma("unroll") for (int k = 0; k < 2; ++k) \
        acc[ai][bj][m][n] = __builtin_amdgcn_mfma_f32_16x16x32_bf16(Bt[n][k], At[m][k], acc[ai][bj][m][n], 0, 0, 0); __builtin_amdgcn_s_setprio(0); } while (0)
#define PG8_WAIT_V(n) asm volatile("s_waitcnt vmcnt(" #n ")" ::: "memory")
#define PG8_WAIT_L(n) asm volatile("s_waitcnt lgkmcnt(" #n ")" ::: "memory")
#define PG8_BAR __builtin_amdgcn_s_barrier()
#define PG8_SCHED __builtin_amdgcn_sched_barrier(0)
    Unit cur, nxt; int ui = 0;
    if (!S.next(0, cur)) return;
    f32x4 acc[2][2][4][2];
#pragma unroll
    for (int a = 0; a < 2; ++a)
#pragma unroll
        for (int b = 0; b < 2; ++b)
#pragma unroll
            for (int m = 0; m < 4; ++m)
#pragma unroll
                for (int n = 0; n < 2; ++n) acc[a][b][m][n] = (f32x4){0.f, 0.f, 0.f, 0.f};
    bf16x8 At[4][2], B0[2][2], B1[2][2];
    const char* cA = cur.pa; const char* cB = cur.pb;
    PG8_STAGE(PG8_SB(0, 0), cB, voffB); PG8_STAGE(PG8_SA(0, 0), cA, voffA); PG8_STAGE(PG8_SB(0, 1), cB + hstep, voffB); PG8_STAGE(PG8_SA(0, 1), cA + hstep, voffA);
    if (wr == 1) PG8_BAR;
    PG8_WAIT_V(4); PG8_BAR;
    PG8_STAGE(PG8_SB(1, 0), cB + kstep, voffB); PG8_STAGE(PG8_SA(1, 0), cA + kstep, voffA); PG8_STAGE(PG8_SB(1, 1), cB + hstep + kstep, voffB);
    PG8_WAIT_V(6); PG8_BAR;
    for (;;) {
        const bool has_next = S.next(ui + 1, nxt);
        const char* nA = has_next ? nxt.pa : cA; const char* nB = has_next ? nxt.pb : cB;
        for (int t = 0; t < nt; t += 2) {
            const bool last = (t == nt - 2);
            const char* a1 = cA + (size_t)(t + 1) * kstep;
            const char* a2 = last ? nA : cA + (size_t)(t + 2) * kstep; const char* b2 = last ? nB : cB + (size_t)(t + 2) * kstep;
            const char* a3 = a2 + kstep; const char* b3 = b2 + kstep;
            PG8_LDB(B0, 0, 0); PG8_SCHED; PG8_LDA(At, 0, 0); PG8_STAGE(PG8_SA(1, 1), a1 + hstep, voffA);
            PG8_WAIT_L(8); PG8_BAR; PG8_WAIT_L(0); PG8_MMA(0, 0, At, B0); PG8_BAR; PG8_SCHED;
            PG8_LDB(B1, 0, 1); PG8_STAGE(PG8_SB(0, 0), b2, voffB);
            PG8_BAR; PG8_WAIT_L(0); PG8_MMA(0, 1, At, B1); PG8_BAR;
            PG8_LDA(At, 0, 1); PG8_STAGE(PG8_SA(0, 0), a2, voffA);
            PG8_BAR; PG8_WAIT_L(0); PG8_MMA(1, 0, At, B0); PG8_BAR; PG8_SCHED;
            PG8_STAGE(PG8_SB(0, 1), b2 + hstep, voffB);
            PG8_WAIT_V(6); PG8_BAR; PG8_MMA(1, 1, At, B1); PG8_BAR;
            PG8_LDB(B0, 1, 0); PG8_SCHED; PG8_LDA(At, 1, 0); PG8_STAGE(PG8_SA(0, 1), a2 + hstep, voffA);
            PG8_WAIT_L(8); PG8_BAR; PG8_WAIT_L(0); PG8_MMA(0, 0, At, B0); PG8_BAR; PG8_SCHED;
            PG8_LDB(B1, 1, 1); PG8_STAGE(PG8_SB(1, 0), b3, voffB);
            PG8_BAR; PG8_WAIT_L(0); PG8_MMA(0, 1, At, B1); PG8_BAR;
            PG8_LDA(At, 1, 1); PG8_STAGE(PG8_SA(1, 0), a3, voffA);
            PG8_BAR; PG8_WAIT_L(0); PG8_MMA(1, 0, At, B0); PG8_BAR; PG8_SCHED;
            PG8_STAGE(PG8_SB(1, 1), b3 + hstep, voffB);
            PG8_WAIT_V(6); PG8_BAR; PG8_MMA(1, 1, At, B1); PG8_BAR;
        }
        if constexpr (!Epi::AFTER_DRAIN) E(acc, cur, wr, wc, fr, fq);
        if (!has_next) break;
#pragma unroll
        for (int a = 0; a < 2; ++a)
#pragma unroll
            for (int b = 0; b < 2; ++b)
#pragma unroll
                for (int m = 0; m < 4; ++m)
#pragma unroll
                    for (int n = 0; n < 2; ++n) acc[a][b][m][n] = (f32x4){0.f, 0.f, 0.f, 0.f};
        cur = nxt; cA = nA; cB = nB; ++ui;
    }
    PG8_WAIT_V(0);
    if (wr == 0) PG8_BAR;
    PG8_BAR;
    if constexpr (Epi::AFTER_DRAIN) E.fused(acc, cur, wr, wc, fr, fq, lds, wid, lane);
#undef PG8_SA
#undef PG8_SB
#undef PG8_STAGE
#undef PG8_LDA
#undef PG8_LDB
#undef PG8_MMA
#undef PG8_WAIT_V
#undef PG8_WAIT_L
#undef PG8_BAR
#undef PG8_SCHED
}

struct EpiTileBf16 {
    static constexpr bool PERM = true, AFTER_DRAIN = false, APERM = false;
    __device__ __forceinline__ void operator()(const f32x4 (&acc)[2][2][4][2], const Unit& u, int wr, int wc, int fr, int fq) const {
        bf16_t* base = (bf16_t*)u.po + (size_t)wr * u.RS + (size_t)fr * u.rp + (size_t)(wc >> 1) * u.CS + (wc & 1) * 32 + 8 * fq;
#pragma unroll
        for (int ai = 0; ai < 2; ++ai)
#pragma unroll
            for (int m = 0; m < 4; ++m) { bf16_t* rowp = base + (size_t)(2 * ai) * u.RS + (size_t)(m * 16) * u.rp;
#pragma unroll
                for (int bj = 0; bj < 2; ++bj) { const f32x4 v0 = acc[ai][bj][m][0], v1 = acc[ai][bj][m][1];
                    u32x4 w; w.x = cvt_pk_bf16(v0[0], v0[1]); w.y = cvt_pk_bf16(v0[2], v0[3]); w.z = cvt_pk_bf16(v1[0], v1[1]); w.w = cvt_pk_bf16(v1[2], v1[3]);
                    *(u32x4*)(rowp + (size_t)(2 * bj) * u.CS) = w; } }
        if (u.sp) {
#pragma unroll
            for (int ai = 0; ai < 2; ++ai)
#pragma unroll
                for (int m = 0; m < 4; ++m) { float s = 0.f;
#pragma unroll
                    for (int bj = 0; bj < 2; ++bj)
#pragma unroll
                        for (int n = 0; n < 2; ++n) { const f32x4 v = acc[ai][bj][m][n]; s += (v[0] - v[1]) + (v[2] - v[3]); }
                    s += __shfl_xor(s, 16); s += __shfl_xor(s, 32);
                    if (fq == 0) u.sp[(size_t)(ai * HALF + wr * 64 + m * 16 + fr) * 32 + wc] = s; }
        }
    }
};
struct EpiResid {
    static constexpr bool PERM = false, AFTER_DRAIN = false, APERM = false;
    const float* base; float* out; const float* gate; float* ssq;
    __device__ __forceinline__ void operator()(const f32x4 (&acc)[2][2][4][2], const Unit& u, int wr, int wc, int fr, int fq) const {
        const int row0 = u.pm * BM + wr * 64 + fr, col0 = u.pn * BM + wc * 32 + 4 * fq, b = u.pm >> 3;
        f32x4 gv[2][2];
#pragma unroll
        for (int bj = 0; bj < 2; ++bj)
#pragma unroll
            for (int n = 0; n < 2; ++n) gv[bj][n] = *(const f32x4*)(gate + (size_t)b * NMOD + col0 + bj * HALF + n * 16);
#pragma unroll
        for (int ai = 0; ai < 2; ++ai)
#pragma unroll
            for (int m = 0; m < 4; ++m) { const int row = row0 + ai * HALF + m * 16; const size_t off = (size_t)row * DM + col0; float s = 0.f;
#pragma unroll
                for (int bj = 0; bj < 2; ++bj)
#pragma unroll
                    for (int n = 0; n < 2; ++n) { const f32x4 xv = *(const f32x4*)(base + off + bj * HALF + n * 16); const f32x4 o = xv + gv[bj][n] * acc[ai][bj][m][n];
                        *(f32x4*)(out + off + bj * HALF + n * 16) = o; s += (o[0] * o[0] + o[1] * o[1]) + (o[2] * o[2] + o[3] * o[3]); }
                s += __shfl_xor(s, 16); s += __shfl_xor(s, 32);
                if (fq == 0) ssq[(size_t)row * 16 + u.pn * 4 + wc] = s; }
    }
};
struct EpiUp {
    static constexpr bool PERM = true, AFTER_DRAIN = false, APERM = true;
    bf16_t* A; bf16_t* side; const float* cw; const float* cb;
    __device__ __forceinline__ void operator()(f32x4 (&acc)[2][2][4][2], const Unit& u, int wr, int wc, int fr, int fq) const {
        const int J0 = u.pn * 128 + wc * 32 + fq * 8;
        const bool f0 = (fr == 0), f15 = (fr == 15);
        if (f0 || f15) {
#pragma unroll
            for (int ai = 0; ai < 2; ++ai) { const int chunk = u.pm * 4 + ai * 2 + wr;
#pragma unroll
                for (int bj = 0; bj < 2; ++bj)
#pragma unroll
                    for (int q = 0; q < 2; ++q) { const f32x4 a0 = f0 ? acc[ai][bj][q][0] : acc[ai][bj][2 + q][0], a1 = f0 ? acc[ai][bj][q][1] : acc[ai][bj][2 + q][1];
                        u32x4 w; w.x = cvt_pk_bf16(a0[0], a0[1]); w.y = cvt_pk_bf16(a0[2], a0[3]); w.z = cvt_pk_bf16(a1[0], a1[1]); w.w = cvt_pk_bf16(a1[2], a1[3]);
                        *(u32x4*)(side + (size_t)(chunk * 4 + (f0 ? q : 2 + q)) * (2 * DFF) + bj * DFF + J0) = w; } }
        }
#pragma unroll
        for (int bj = 0; bj < 2; ++bj)
#pragma unroll
            for (int n = 0; n < 2; ++n) {
                const int col = bj * DFF + J0 + n * 4;
                const f32x4 k0 = *(const f32x4*)(cw + col), k1 = *(const f32x4*)(cw + 2 * DFF + col), k2 = *(const f32x4*)(cw + 4 * DFF + col), kb = *(const f32x4*)(cb + col);
#pragma unroll
                for (int ai = 0; ai < 2; ++ai) {
                    const f32x4 c0 = acc[ai][bj][0][n], c1 = acc[ai][bj][1][n], c2 = acc[ai][bj][2][n], c3 = acc[ai][bj][3][n];
                    f32x4 pv, nx;
#pragma unroll
                    for (int j = 0; j < 4; ++j) { pv[j] = dpp_f<0x111>(c3[j]); nx[j] = dpp_f<0x101>(c0[j]); }
                    f32x4 o0 = k0 * pv + k1 * c0 + k2 * c1 + kb, o1 = k0 * c0 + k1 * c1 + k2 * c2 + kb, o2 = k0 * c1 + k1 * c2 + k2 * c3 + kb, o3 = k0 * c2 + k1 * c3 + k2 * nx + kb;
                    asm volatile("" : "+v"(o0), "+v"(o1), "+v"(o2), "+v"(o3));
                    acc[ai][bj][0][n] = o0; acc[ai][bj][1][n] = o1; acc[ai][bj][2][n] = o2; acc[ai][bj][3][n] = o3;
                }
            }
#pragma unroll
        for (int ai = 0; ai < 2; ++ai) { const int chunk = u.pm * 4 + ai * 2 + wr;
#pragma unroll
            for (int m = 0; m < 4; ++m) {
                const f32x4 g0 = acc[ai][0][m][0], g1 = acc[ai][0][m][1], v0 = acc[ai][1][m][0], v1 = acc[ai][1][m][1];
                u32x4 w; w.x = cvt_pk_bf16(silu_f(g0[0]) * v0[0], silu_f(g0[1]) * v0[1]); w.y = cvt_pk_bf16(silu_f(g0[2]) * v0[2], silu_f(g0[3]) * v0[3]);
                w.z = cvt_pk_bf16(silu_f(g1[0]) * v1[0], silu_f(g1[1]) * v1[1]); w.w = cvt_pk_bf16(silu_f(g1[2]) * v1[2], silu_f(g1[3]) * v1[3]);
                const bool valid = !((m == 0 && f0) || (m == 3 && f15));
                if (valid) *(u32x4*)(A + (size_t)(chunk * 64 + 4 * fr + m) * DFF + J0) = w;
            } }
    }
};
struct PanelSsq {
    float* xbuf; unsigned* cnt;
    __device__ __forceinline__ void run(const f32x4 (&v)[2][2][4][2], const Unit& u, int wr, int wc, int fr, int fq, LAS unsigned char* lds, int wid, int lane) const {
        LAS float* P = (LAS float*)lds; LAS float* S = (LAS float*)(lds + 4096);
#pragma unroll
        for (int ai = 0; ai < 2; ++ai)
#pragma unroll
            for (int m = 0; m < 4; ++m) { float s = 0.f;
#pragma unroll
                for (int bj = 0; bj < 2; ++bj)
#pragma unroll
                    for (int n = 0; n < 2; ++n) { const f32x4 x = v[ai][bj][m][n]; s += (x[0] * x[0] + x[1] * x[1]) + (x[2] * x[2] + x[3] * x[3]); }
                s += __shfl_xor(s, 16); s += __shfl_xor(s, 32);
                if (fq == 0) P[(ai * HALF + wr * 64 + m * 16 + fr) * 4 + wc] = s; }
        asm volatile("s_waitcnt lgkmcnt(0)" ::: "memory"); __builtin_amdgcn_s_barrier(); asm volatile("" ::: "memory");
        const int row = wid * 32 + (lane & 31);
        if (lane < 32) { const f32x4 a = *(const LAS f32x4*)(P + row * 4);
            __hip_atomic_store(xbuf + ((size_t)(u.pm * BM + row) * 4 + u.pn), (a[0] + a[1]) + (a[2] + a[3]), __ATOMIC_RELAXED, __HIP_MEMORY_SCOPE_AGENT); }
        asm volatile("s_waitcnt vmcnt(0)" ::: "memory");
        if (lane == 0) __hip_atomic_fetch_add(cnt + 64 * u.pm, 1u, __ATOMIC_RELAXED, __HIP_MEMORY_SCOPE_AGENT);
        if (wid == 0) { unsigned sp = 0;
            while ((unsigned)__builtin_amdgcn_readfirstlane(__hip_atomic_load(cnt + 64 * u.pm, __ATOMIC_RELAXED, __HIP_MEMORY_SCOPE_AGENT)) < 32u) { __builtin_amdgcn_s_sleep(2); if (++sp > (1u << 22)) break; }
            __builtin_amdgcn_fence(__ATOMIC_ACQUIRE, "agent"); }
        asm volatile("s_waitcnt vmcnt(0) lgkmcnt(0)" ::: "memory"); __builtin_amdgcn_s_barrier(); asm volatile("" ::: "memory");
        if (lane < 32) { const float* slot = xbuf + (size_t)(u.pm * BM + row) * 4; float t = 0.f;
#pragma unroll
            for (int k = 0; k < 4; ++k) t += __hip_atomic_load(slot + k, __ATOMIC_RELAXED, __HIP_MEMORY_SCOPE_AGENT);
            S[row] = 1.0f / sqrtf(t * (1.0f / DM) + EPS); }
        asm volatile("s_waitcnt lgkmcnt(0)" ::: "memory"); __builtin_amdgcn_s_barrier(); asm volatile("" ::: "memory");
    }
};
struct EpiResidNormMod {
    static constexpr bool PERM = false, AFTER_DRAIN = true, APERM = false;
    const float* base; bf16_t* x1b; const float* mod; int gate_off, sh_off, sc_off; const float* g; bf16_t* hn; PanelSsq st;
    __device__ __forceinline__ void fused(f32x4 (&acc)[2][2][4][2], const Unit& u, int wr, int wc, int fr, int fq, LAS unsigned char* lds, int wid, int lane) const {
        const int row0 = u.pm * BM + wr * 64 + fr, col0 = u.pn * BM + wc * 32 + 4 * fq, b = u.pm >> 3;
        const float* modb = mod + (size_t)b * NMOD + col0;
        { f32x4 gv[2][2];
#pragma unroll
          for (int bj = 0; bj < 2; ++bj)
#pragma unroll
            for (int n = 0; n < 2; ++n) gv[bj][n] = *(const f32x4*)(modb + gate_off + bj * HALF + n * 16);
#pragma unroll
          for (int ai = 0; ai < 2; ++ai)
#pragma unroll
            for (int m = 0; m < 4; ++m) { const size_t off = (size_t)(row0 + ai * HALF + m * 16) * DM + col0;
#pragma unroll
                for (int bj = 0; bj < 2; ++bj)
#pragma unroll
                    for (int n = 0; n < 2; ++n) { const f32x4 xv = *(const f32x4*)(base + off + bj * HALF + n * 16); const f32x4 o = xv + gv[bj][n] * acc[ai][bj][m][n];
                        u32x2 w; w.x = cvt_pk_bf16(o[0], o[1]); w.y = cvt_pk_bf16(o[2], o[3]); *(u32x2*)(x1b + off + bj * HALF + n * 16) = w; acc[ai][bj][m][n] = o; }
                asm volatile("" ::: "memory"); } }
        st.run(acc, u, wr, wc, fr, fq, lds, wid, lane);
        const LAS float* S = (const LAS float*)(lds + 4096);
#pragma unroll
        for (int bj = 0; bj < 2; ++bj)
#pragma unroll
            for (int n = 0; n < 2; ++n) { const int co = bj * HALF + n * 16;
                const f32x4 gg = *(const f32x4*)(g + col0 + co), sh = *(const f32x4*)(modb + sh_off + co), sc = *(const f32x4*)(modb + sc_off + co);
                const f32x4 mul = gg * (1.0f + sc);
#pragma unroll
                for (int ai = 0; ai < 2; ++ai)
#pragma unroll
                    for (int m = 0; m < 4; ++m) { const int r = ai * HALF + wr * 64 + m * 16 + fr; const float rstd = S[r];
                        const f32x4 h = (acc[ai][bj][m][n] * rstd) * mul + sh;
                        u32x2 w; w.x = cvt_pk_bf16(h[0], h[1]); w.y = cvt_pk_bf16(h[2], h[3]);
                        *(u32x2*)(hn + (size_t)(u.pm * BM + r) * DM + col0 + co) = w; } }
    }
};
struct EpiResidNormOut {
    static constexpr bool PERM = false, AFTER_DRAIN = true, APERM = false;
    const bf16_t* x1b; float* out; const float* mod; int gate_off; const float* g; PanelSsq st;
    __device__ __forceinline__ void fused(f32x4 (&acc)[2][2][4][2], const Unit& u, int wr, int wc, int fr, int fq, LAS unsigned char* lds, int wid, int lane) const {
        const int row0 = u.pm * BM + wr * 64 + fr, col0 = u.pn * BM + wc * 32 + 4 * fq, b = u.pm >> 3;
        const float* modb = mod + (size_t)b * NMOD + col0;
        { f32x4 gv[2][2];
#pragma unroll
          for (int bj = 0; bj < 2; ++bj)
#pragma unroll
            for (int n = 0; n < 2; ++n) gv[bj][n] = *(const f32x4*)(modb + gate_off + bj * HALF + n * 16);
#pragma unroll
          for (int ai = 0; ai < 2; ++ai)
#pragma unroll
            for (int m = 0; m < 4; ++m) { const size_t off = (size_t)(row0 + ai * HALF + m * 16) * DM + col0;
#pragma unroll
                for (int bj = 0; bj < 2; ++bj)
#pragma unroll
                    for (int n = 0; n < 2; ++n) { const u32x2 xw = *(const u32x2*)(x1b + off + bj * HALF + n * 16); const f32x4 xv = (f32x4){bf_lo(xw.x), bf_hi(xw.x), bf_lo(xw.y), bf_hi(xw.y)};
                        acc[ai][bj][m][n] = xv + gv[bj][n] * acc[ai][bj][m][n]; }
                asm volatile("" : "+v"(acc[ai][0][m][0]), "+v"(acc[ai][0][m][1]), "+v"(acc[ai][1][m][0]), "+v"(acc[ai][1][m][1]));
                asm volatile("" ::: "memory"); } }
        st.run(acc, u, wr, wc, fr, fq, lds, wid, lane);
        const LAS float* S = (const LAS float*)(lds + 4096);
        f32x4 gg[2][2];
#pragma unroll
        for (int bj = 0; bj < 2; ++bj)
#pragma unroll
            for (int n = 0; n < 2; ++n) gg[bj][n] = *(const f32x4*)(g + col0 + bj * HALF + n * 16);
#pragma unroll
        for (int ai = 0; ai < 2; ++ai)
#pragma unroll
            for (int m = 0; m < 4; ++m) { const int r = ai * HALF + wr * 64 + m * 16 + fr; const float rstd = S[r]; float* rowp = out + (size_t)(u.pm * BM + r) * DM + col0;
#pragma unroll
                for (int bj = 0; bj < 2; ++bj)
#pragma unroll
                    for (int n = 0; n < 2; ++n) *(f32x4*)(rowp + bj * HALF + n * 16) = (acc[ai][bj][m][n] * rstd) * gg[bj][n];
                asm volatile("" ::: "memory"); }
    }
};
}

struct SchedP2 {
    const char *H, *HE, *HO, *WQK, *WA; char *QK, *VT, *VTA; float* SP; int G, c;
    __device__ __forceinline__ bool next(int i, pg8::Unit& u) const {
        const int L = i * G + c; if (L >= 512) return false;
        constexpr size_t tstep = (size_t)256 * DM * 2;
        u.sp = nullptr;
        if (L < 256) { int pm, pn; pg8::tile_map(L, 64, 4, pm, pn); u.pm = pm; u.pn = pn; u.pa = H + pm * tstep; u.pb = WQK + pn * tstep;
            const int b = pm >> 3, s0 = (pm & 7) * 256, head0 = (pn & 1) * 4;
            u.po = QK + (size_t)(pn >> 1) * (16u << 20) + ((size_t)((b * 8 + head0) * SEQ + s0) * 64) * 2; u.rp = 64; u.RS = 64 * 64; u.CS = SEQ * 64; }
        else if (L < 384) { int pm, pn; pg8::tile_map(L - 256, 2, 64, pm, pn); u.pm = 4 + pm; u.pn = pn; u.pa = WA + (size_t)(4 + pm) * tstep; u.pb = H + pn * tstep;
            const int b = pn >> 3;
            u.po = VTA + ((size_t)((b * 8 + 4 * pm) * 32 + 4 * (pn & 7)) * 4096) * 2; u.rp = 64; u.RS = 32 * 4096; u.CS = 4096; }
        else { const int which = (L - 384) >> 6; int pm, pn; pg8::tile_map((L - 384) & 63, 2, 32, pm, pn); u.pm = which * 2 + pm; u.pn = pn;
            u.pa = WA + (size_t)(which * 2 + pm) * tstep; u.pb = (which ? HO : HE) + pn * tstep;
            const int b = pn >> 2, st = pn & 3;
            u.po = VT + (size_t)which * (8u << 20) + ((size_t)(b * 512 + pm * 256) * 1024 + st * 256) * 2; u.rp = 1024; u.RS = 64 * 1024; u.CS = 64;
            if (!which) u.sp = SP + ((size_t)(b * 512 + pm * 256) * 32 + st * 4); }
        return true;
    }
};
struct SchedFourier {
    const char *CS, *VT; char* PQ; int G, c;
    __device__ __forceinline__ bool next(int i, pg8::Unit& u) const {
        const int L = i * G + c; if (L >= 128) return false;
        int pm, pn; pg8::tile_map(L, 8, 16, pm, pn); u.pm = pm; u.pn = pn;
        constexpr size_t tstep = (size_t)256 * 1024 * 2;
        u.pa = CS + pm * tstep; u.pb = VT + (size_t)(pm >> 2) * (8u << 20) + pn * tstep; u.po = PQ + ((size_t)pm * 256 * 4096 + pn * 256) * 2; u.rp = 4096; u.RS = 64 * 4096; u.CS = 64; u.sp = nullptr;
        return true;
    }
};
struct SchedPlain {
    const char *A, *B; int nM, nN, K, G, c;
    __device__ __forceinline__ bool next(int i, pg8::Unit& u) const {
        const int L = i * G + c; if (L >= nM * nN) return false;
        int pm, pn; pg8::tile_map(L, nM, nN, pm, pn); u.pm = pm; u.pn = pn;
        const size_t tstep = (size_t)256 * K * 2;
        u.pa = A + pm * tstep; u.pb = B + pn * tstep; u.po = nullptr; u.sp = nullptr; u.rp = 0; u.RS = 0; u.CS = 0;
        return true;
    }
};

__device__ __forceinline__ void p0_mod_item(const Params& p, LAS unsigned char* lds, int item) {
    LAS float* cs = (LAS float*)lds;
    LAS float* red = (LAS float*)(lds + 32768);
    const int tid = threadIdx.x;
    for (int u = tid; u < NBATCH * DM; u += NTHREADS) { const float v = p.c[u]; cs[u] = v / (1.0f + __expf(-v)); }
    __syncthreads();
    const int j0 = item * 64, l16 = tid & 15, rs = tid >> 4;
    f32x4 acc[8];
#pragma unroll
    for (int b = 0; b < 8; ++b) acc[b] = (f32x4){0.f, 0.f, 0.f, 0.f};
#pragma unroll 32
    for (int pass = 0; pass < 32; ++pass) { const int i = pass * 32 + rs; const f32x4 w = *(const f32x4*)(p.w_ada + (size_t)i * NMOD + j0 + 4 * l16);
#pragma unroll
        for (int b = 0; b < 8; ++b) acc[b] += cs[b * DM + i] * w; }
#pragma unroll
    for (int b = 0; b < 8; ++b) *(LAS f32x4*)(red + (rs * 8 + b) * 64 + 4 * l16) = acc[b];
    __syncthreads();
    { const int b = tid >> 6, col = tid & 63; float s = p.b_ada[j0 + col];
#pragma unroll 8
      for (int r = 0; r < 32; ++r) s += red[(r * 8 + b) * 64 + col];
      ((float*)(p.ws + WS_MOD))[(size_t)b * NMOD + j0 + col] = s; }
    asm volatile("s_waitcnt vmcnt(0)" ::: "memory");
    __syncthreads();
    if (tid == 0) {
        __builtin_amdgcn_fence(__ATOMIC_RELEASE, "agent");
        asm volatile("s_waitcnt vmcnt(0)" ::: "memory");
        __hip_atomic_fetch_add((unsigned*)(p.ws + WS_BAR) + 3712, 1u, __ATOMIC_RELAXED, __HIP_MEMORY_SCOPE_AGENT);
    }
}
typedef float f32x16 __attribute__((ext_vector_type(16)));
__device__ __forceinline__ void p0_fold_item(const Params& p, LAS unsigned char* lds, int item) {
    LAS float* Wf = (LAS float*)lds;
    LAS float* Gm = (LAS float*)(lds + 65536);
    LAS float* wt = (LAS float*)(lds + 131072);
    const int tid = threadIdx.x, lane = tid & 63, w = tid >> 6, which = item >> 6, g = (item >> 4) & 3, ib = (item & 15) * 64;
    for (int u = tid; u < 4096; u += NTHREADS) *(LAS f32x4*)(Wf + 4 * u) = *(const f32x4*)(p.w_four + (size_t)g * 16384 + 4 * u);
    __syncthreads();
    {
        const int mt = w >> 1, nt0 = (w & 1) * 2, li = lane & 31, lk = lane >> 5, c = mt * 32 + li;
        f32x16 acc0, acc1;
#pragma unroll
        for (int r = 0; r < 16; ++r) { acc0[r] = 0.f; acc1[r] = 0.f; }
#pragma unroll 4
        for (int ks = 0; ks < 64; ++ks) { const int e = 2 * ks + lk; const float ang = (float)((c * e) & 127) * (1.0f / 128.0f);
            const float a = (which ? __builtin_amdgcn_sinf(ang) : __builtin_amdgcn_cosf(ang)) * 0.08838834764831845f;
            const float b0 = Wf[e * 128 + nt0 * 32 + li], b1 = Wf[e * 128 + nt0 * 32 + 32 + li];
            acc0 = __builtin_amdgcn_mfma_f32_32x32x2f32(a, b0, acc0, 0, 0, 0); acc1 = __builtin_amdgcn_mfma_f32_32x32x2f32(a, b1, acc1, 0, 0, 0); }
#pragma unroll
        for (int r = 0; r < 16; ++r) { const int row = mt * 32 + (r & 3) + 8 * (r >> 2) + 4 * lk; Gm[row * 128 + nt0 * 32 + li] = acc0[r]; Gm[row * 128 + nt0 * 32 + 32 + li] = acc1[r]; }
    }
    for (int sub = 0; sub < 2; ++sub) { const int i0 = ib + sub * 32;
    for (int u = tid; u < 4096; u += NTHREADS) { const int il = u >> 7, c = u & 127; wt[il * 129 + c] = p.w_in[(size_t)(i0 + il) * 2048 + g * 128 + c]; }
    __syncthreads();
    {
        const int li = lane & 15, lk = lane >> 4;
        f32x4 acc0 = (f32x4){0.f, 0.f, 0.f, 0.f}, acc1 = (f32x4){0.f, 0.f, 0.f, 0.f};
#pragma unroll 4
        for (int ks = 0; ks < 32; ++ks) { const int c = 4 * ks + lk; const float a = Gm[c * 128 + 16 * w + li], b0 = wt[li * 129 + c], b1 = wt[(16 + li) * 129 + c];
            acc0 = __builtin_amdgcn_mfma_f32_16x16x4f32(a, b0, acc0, 0, 0, 0); acc1 = __builtin_amdgcn_mfma_f32_16x16x4f32(a, b1, acc1, 0, 0, 0); }
        bf16_t* WA = (bf16_t*)(p.ws + WS_WA);
#pragma unroll
        for (int r = 0; r < 4; ++r) { const int d = 16 * w + lk * 4 + r; bf16_t* rowp = WA + (size_t)(which * 512 + g * 128 + d) * DM + i0;
            rowp[li] = (bf16_t)(cvt_pk_bf16(acc0[r], 0.f) & 0xffffu); rowp[16 + li] = (bf16_t)(cvt_pk_bf16(acc1[r], 0.f) & 0xffffu); }
    }
    __syncthreads();
    }
}
__device__ __forceinline__ void p0_transpose_item(const float* W, int ldw, int ncol0, int K, bf16_t* WT, int orow, const float* gk, LAS float* scr, int kb, int lane) {
    const int k0 = 64 * kb;
    float v[32];
#pragma unroll
    for (int i = 0; i < 32; ++i) v[i] = W[(size_t)(k0 + 2 * i + (lane >> 5)) * ldw + ncol0 + (lane & 31)];
    if (gk) {
#pragma unroll
        for (int i = 0; i < 32; ++i) v[i] *= gk[k0 + 2 * i + (lane >> 5)]; }
#pragma unroll
    for (int i = 0; i < 32; ++i) scr[(2 * i + (lane >> 5)) * 33 + (lane & 31)] = v[i];
    asm volatile("s_waitcnt lgkmcnt(0)" ::: "memory");
    const int c = lane & 7;
#pragma unroll
    for (int j = 0; j < 4; ++j) { const int n = (lane >> 3) + 8 * j; const LAS float* s = scr + (8 * c) * 33 + n;
        u32x4 o; o.x = cvt_pk_bf16(s[0 * 33], s[1 * 33]); o.y = cvt_pk_bf16(s[2 * 33], s[3 * 33]); o.z = cvt_pk_bf16(s[4 * 33], s[5 * 33]); o.w = cvt_pk_bf16(s[6 * 33], s[7 * 33]);
        *(u32x4*)(WT + (size_t)(orow + n) * K + k0 + 8 * c) = o; }
    asm volatile("s_waitcnt lgkmcnt(0)" ::: "memory");
}
__device__ __forceinline__ void p0_prologue(const Params& p, LAS unsigned char* lds) {
    const int tid = threadIdx.x, lane = tid & 63, wave = tid >> 6, G = gridDim.x;
    if (G == 256) {
        if (blockIdx.x < 128) p0_fold_item(p, lds, blockIdx.x); else if (blockIdx.x < 224) p0_mod_item(p, lds, blockIdx.x - 128);
    } else { for (int it = blockIdx.x; it < 96; it += G) p0_mod_item(p, lds, it);
        for (int it = blockIdx.x; it < 128; it += G) p0_fold_item(p, lds, it); }
    LAS float* scr = (LAS float*)(lds + wave * 16384);
    const int gw = blockIdx.x * NWAVES + wave, NGW = G * NWAVES;
    constexpr int I_QK = 16 * 32, I_V = 16 * 16;
    for (int it = gw; it < I_QK + I_V; it += NGW) {
        int r = it;
        if (r < I_QK) { const int kb = r >> 5, nb = r & 31; p0_transpose_item(p.w_in, 2048, 512 + nb * 32, DM, (bf16_t*)(p.ws + WS_WQK), nb * 32, nullptr, scr, kb, lane); continue; } r -= I_QK;
        { const int kb = r >> 4, nb = r & 15; p0_transpose_item(p.w_in, 2048, 1536 + nb * 32, DM, (bf16_t*)(p.ws + WS_WA), 1024 + nb * 32, nullptr, scr, kb, lane); }
    }
}
__device__ __forceinline__ void late_work(const Params& p, LAS unsigned char* lds, int hidx, int nh, int what) {
    const int tid = threadIdx.x, lane = tid & 63, wave = tid >> 6;
    LAS float* scr = (LAS float*)(lds + wave * 16384);
    const int gw = hidx * NWAVES + wave, NGW = nh * NWAVES;
    constexpr int I_O = 16 * 32, I_UP = 16 * 176, I_DN = 44 * 32;
    const int it_lo = (what & 1) ? 0 : I_O + I_UP, it_hi = (what & 2) ? I_O + I_UP + I_DN : ((what & 1) ? I_O + I_UP : it_lo);
    for (int it = it_lo + gw; it < it_hi; it += NGW) {
        int r = it;
        if (r < I_O) { const int kb = r >> 5, nb = r & 31; p0_transpose_item(p.w_out, DM, nb * 32, DM, (bf16_t*)(p.ws + WS_WOUT), nb * 32, kb < 8 ? p.g_four_out : p.g_na_out - 512, scr, kb, lane); continue; } r -= I_O;
        if (r < I_UP) { const int kb = r / 176, nb = r % 176; const int n0 = nb * 32; const int isv = n0 >= DFF, j = isv ? n0 - DFF : n0;
            p0_transpose_item(p.w_up, 2 * DFF, n0, DM, (bf16_t*)(p.ws + WS_WUP), (j >> 7) * 256 + isv * 128 + (j & 127), nullptr, scr, kb, lane); continue; } r -= I_UP;
        { const int kb = r >> 5, nb = r & 31; p0_transpose_item(p.w_down, DM, nb * 32, DFF, (bf16_t*)(p.ws + WS_WDN), nb * 32, nullptr, scr, kb, lane); }
    }
    bf16_t* CS = (bf16_t*)(p.ws + WS_CS);
    if (what & 4) for (int u = hidx * NTHREADS + tid; u < 2048 * 128; u += nh * NTHREADS) { const int kp = u >> 7, s0 = (u & 127) * 8, k = kp & 1023; float v[8];
#pragma unroll
        for (int j = 0; j < 8; ++j) { const float ang = (float)((k * (s0 + j)) & 2047) * (1.0f / 2048.0f); v[j] = (kp >= 1024 ? __builtin_amdgcn_sinf(ang) : __builtin_amdgcn_cosf(ang)) * 0.022097086912079608f; }
        u32x4 o; o.x = cvt_pk_bf16(v[0], v[1]); o.y = cvt_pk_bf16(v[2], v[3]); o.z = cvt_pk_bf16(v[4], v[5]); o.w = cvt_pk_bf16(v[6], v[7]);
        *(u32x4*)(CS + (size_t)kp * 1024 + s0) = o; }
}

__device__ __forceinline__ void pass_norm_mod(const float* src, const float* ssq, const float* g, const float* mod, int sh_off, int sc_off, bf16_t* dst) {
    constexpr int RW = 4;
    const int lane = threadIdx.x & 63, gw = blockIdx.x * NWAVES + (threadIdx.x >> 6), NGW = gridDim.x * NWAVES;
    if (!ssq && NGW == 2048) {
        const int rowb = gw * 8, b = rowb >> 11;
        f32x4 mul[4], sh[4];
#pragma unroll
        for (int j = 0; j < 4; ++j) { const f32x4 gg = ((const f32x4*)g)[lane + 64 * j], sc = ((const f32x4*)(mod + (size_t)b * NMOD + sc_off))[lane + 64 * j];
            mul[j] = gg * (1.0f + sc); sh[j] = ((const f32x4*)(mod + (size_t)b * NMOD + sh_off))[lane + 64 * j]; }
#pragma unroll
        for (int half = 0; half < 2; ++half) {
            f32x4 v[RW][4];
#pragma unroll
            for (int q = 0; q < RW; ++q) { const f32x4* xr = (const f32x4*)(src + (size_t)(rowb + half * RW + q) * DM) + lane;
#pragma unroll
                for (int j = 0; j < 4; ++j) v[q][j] = xr[64 * j]; }
#pragma unroll
            for (int q = 0; q < RW; ++q) { float t = 0.f;
#pragma unroll
                for (int j = 0; j < 4; ++j) t += (v[q][j][0] * v[q][j][0] + v[q][j][1] * v[q][j][1]) + (v[q][j][2] * v[q][j][2] + v[q][j][3] * v[q][j][3]);
                t = wave_sum(t); const float rstd = 1.0f / sqrtf(t * (1.0f / DM) + EPS);
                u32x2* o8 = (u32x2*)(dst + (size_t)(rowb + half * RW + q) * DM) + lane;
#pragma unroll
                for (int j = 0; j < 4; ++j) { const f32x4 h = (v[q][j] * rstd) * mul[j] + sh[j]; u32x2 w; w.x = cvt_pk_bf16(h[0], h[1]); w.y = cvt_pk_bf16(h[2], h[3]); o8[64 * j] = w; } }
        }
        return;
    }
    for (int row0 = gw; row0 < NTOK; row0 += RW * NGW) {
        f32x4 v[RW][4]; float s[RW];
#pragma unroll
        for (int q = 0; q < RW; ++q) { const int row = min(row0 + q * NGW, NTOK - 1); const f32x4* xr = (const f32x4*)(src + (size_t)row * DM) + lane;
#pragma unroll
            for (int j = 0; j < 4; ++j) v[q][j] = xr[64 * j]; }
#pragma unroll
        for (int q = 0; q < RW; ++q) { const int row = min(row0 + q * NGW, NTOK - 1); float t = 0.f;
#pragma unroll
            for (int j = 0; j < 4; ++j) t += (v[q][j][0] * v[q][j][0] + v[q][j][1] * v[q][j][1]) + (v[q][j][2] * v[q][j][2] + v[q][j][3] * v[q][j][3]);
            if (ssq) { t = ssq[(size_t)row * 16 + (lane & 15)]; t += __shfl_xor(t, 1); t += __shfl_xor(t, 2); t += __shfl_xor(t, 4); t += __shfl_xor(t, 8); }
            else t = wave_sum(t);
            s[q] = 1.0f / sqrtf(t * (1.0f / DM) + EPS); }
#pragma unroll
        for (int q = 0; q < RW; ++q) { const int row = row0 + q * NGW; if (row < NTOK) { const int b = row >> 11;
            const f32x4* g4 = (const f32x4*)g + lane; const f32x4* sh4 = (const f32x4*)(mod + (size_t)b * NMOD + sh_off) + lane; const f32x4* sc4 = (const f32x4*)(mod + (size_t)b * NMOD + sc_off) + lane;
            u32x2* o8 = (u32x2*)(dst + (size_t)row * DM) + lane;
#pragma unroll
            for (int j = 0; j < 4; ++j) { const f32x4 gg = g4[64 * j], sh = sh4[64 * j], sc = sc4[64 * j]; const f32x4 h = (v[q][j] * s[q] * gg) * (1.0f + sc) + sh;
                u32x2 w; w.x = cvt_pk_bf16(h[0], h[1]); w.y = cvt_pk_bf16(h[2], h[3]); o8[64 * j] = w; } } }
    }
}
__device__ __forceinline__ void pass_h_fold(const float* src, const float* g, const float* mod, bf16_t* H, bf16_t* HE, bf16_t* HO) {
    const int vb = (gridDim.x & 7) ? (int)blockIdx.x : (int)((blockIdx.x & 7) * (gridDim.x >> 3) + (blockIdx.x >> 3));
    const int lane = threadIdx.x & 63, gw = vb * NWAVES + (threadIdx.x >> 6), NGW = gridDim.x * NWAVES;
    for (int ch = gw; ch < 2048; ch += NGW) {
        const int b = ch >> 8, sb = (ch & 255) * 4;
        f32x4 mul[4], sh[4];
#pragma unroll
        for (int j = 0; j < 4; ++j) { const f32x4 gg = ((const f32x4*)g)[lane + 64 * j], sc = ((const f32x4*)(mod + (size_t)b * NMOD + DM))[lane + 64 * j];
            mul[j] = gg * (1.0f + sc); sh[j] = ((const f32x4*)(mod + (size_t)b * NMOD))[lane + 64 * j]; }
#pragma unroll
        for (int half = 0; half < 2; ++half) {
            f32x4 v[2][2][4];
#pragma unroll
            for (int q = 0; q < 2; ++q) { const int s = sb + half * 2 + q, pr = (s == 0) ? SEQ / 2 : SEQ - s;
                const f32x4* x0 = (const f32x4*)(src + (size_t)(b * SEQ + s) * DM) + lane; const f32x4* x1 = (const f32x4*)(src + (size_t)(b * SEQ + pr) * DM) + lane;
#pragma unroll
                for (int j = 0; j < 4; ++j) { v[q][0][j] = x0[64 * j]; v[q][1][j] = x1[64 * j]; } }
#pragma unroll
            for (int q = 0; q < 2; ++q) { const int s = sb + half * 2 + q, pr = (s == 0) ? SEQ / 2 : SEQ - s;
                float t0 = 0.f, t1 = 0.f;
#pragma unroll
                for (int j = 0; j < 4; ++j) { const f32x4 a = v[q][0][j], c = v[q][1][j]; t0 += (a[0] * a[0] + a[1] * a[1]) + (a[2] * a[2] + a[3] * a[3]); t1 += (c[0] * c[0] + c[1] * c[1]) + (c[2] * c[2] + c[3] * c[3]); }
                t0 = wave_sum(t0); t1 = wave_sum(t1);
                const float r0 = 1.0f / sqrtf(t0 * (1.0f / DM) + EPS), r1 = 1.0f / sqrtf(t1 * (1.0f / DM) + EPS);
                u32x2* o0 = (u32x2*)(H + (size_t)(b * SEQ + s) * DM) + lane; u32x2* o1 = (u32x2*)(H + (size_t)(b * SEQ + pr) * DM) + lane;
                u32x2* oe = (u32x2*)(HE + (size_t)(b * 1024 + s) * DM) + lane; u32x2* oo = (u32x2*)(HO + (size_t)(b * 1024 + s) * DM) + lane;
#pragma unroll
                for (int j = 0; j < 4; ++j) { const f32x4 h0 = (v[q][0][j] * r0) * mul[j] + sh[j], h1 = (v[q][1][j] * r1) * mul[j] + sh[j];
                    u32x2 w; w.x = cvt_pk_bf16(h0[0], h0[1]); w.y = cvt_pk_bf16(h0[2], h0[3]); o0[64 * j] = w;
                    w.x = cvt_pk_bf16(h1[0], h1[1]); w.y = cvt_pk_bf16(h1[2], h1[3]); o1[64 * j] = w;
                    const f32x4 e = (s == 0) ? h0 : h0 + h1, o = (s == 0) ? (f32x4){0.f, 0.f, 0.f, 0.f} : h0 - h1;
                    w.x = cvt_pk_bf16(e[0], e[1]); w.y = cvt_pk_bf16(e[2], e[3]); oe[64 * j] = w;
                    w.x = cvt_pk_bf16(o[0], o[1]); w.y = cvt_pk_bf16(o[2], o[3]); oo[64 * j] = w; } }
        }
    }
}
__device__ __forceinline__ void pass_xmid(const bf16_t* H, const bf16_t* WA, float* X) {
    const int lane = threadIdx.x & 63, gw = blockIdx.x * NWAVES + (threadIdx.x >> 6), NGW = gridDim.x * NWAVES;
    for (int t = gw; t < NBATCH * 512; t += NGW) { const int b = t >> 9, c = t & 511;
        const u32x4* hp = (const u32x4*)(H + (size_t)(b * SEQ + SEQ / 2) * DM) + lane * 2; const u32x4* wp = (const u32x4*)(WA + (size_t)c * DM) + lane * 2;
        float s = 0.f;
#pragma unroll
        for (int q = 0; q < 2; ++q) { const u32x4 hv = hp[q], wv = wp[q];
#pragma unroll
            for (int j = 0; j < 4; ++j) s += bf_lo(hv[j]) * bf_lo(wv[j]) + bf_hi(hv[j]) * bf_hi(wv[j]); }
        s = wave_sum(s);
        if (lane == 0) X[t] = s; }
}
__device__ __forceinline__ void pass_final(float* xo, const float* ssq, const float* g) {
    const int lane = threadIdx.x & 63, gw = blockIdx.x * NWAVES + (threadIdx.x >> 6), NGW = gridDim.x * NWAVES;
    for (int row = gw; row < NTOK; row += NGW) {
        f32x4* xr = (f32x4*)(xo + (size_t)row * DM) + lane;
        float s = ssq[(size_t)row * 16 + (lane & 15)]; s += __shfl_xor(s, 1); s += __shfl_xor(s, 2); s += __shfl_xor(s, 4); s += __shfl_xor(s, 8);
        const float rstd = 1.0f / sqrtf(s * (1.0f / DM) + EPS);
        const f32x4* g4 = (const f32x4*)g + lane;
#pragma unroll
        for (int j = 0; j < 4; ++j) { const f32x4 v = xr[64 * j]; xr[64 * j] = v * rstd * g4[64 * j]; }
    }
}
__device__ __forceinline__ void combine_row(int row, const float (&y)[8], const float* SSQNA, bf16_t* YCAT, int lane) {
    float s = 0.f;
#pragma unroll
    for (int j = 0; j < 8; ++j) s += y[j] * y[j];
    s = wave_sum(s);
    const float rstd = 1.0f / sqrtf(s * (1.0f / 512.0f) + EPS);
    u32x4 o; o.x = cvt_pk_bf16(y[0] * rstd, y[1] * rstd); o.y = cvt_pk_bf16(y[2] * rstd, y[3] * rstd); o.z = cvt_pk_bf16(y[4] * rstd, y[5] * rstd); o.w = cvt_pk_bf16(y[6] * rstd, y[7] * rstd);
    *(u32x4*)(YCAT + (size_t)row * DM + lane * 8) = o;
    float t = SSQNA[(size_t)row * 8 + (lane & 7)]; t += __shfl_xor(t, 1); t += __shfl_xor(t, 2); t += __shfl_xor(t, 4);
    const float rn = 1.0f / sqrtf(t * (1.0f / 512.0f) + EPS);
    u32x4* ap = (u32x4*)(YCAT + (size_t)row * DM + 512 + lane * 8); const u32x4 aw = *ap; u32x4 ow;
#pragma unroll
    for (int j = 0; j < 4; ++j) ow[j] = cvt_pk_bf16(bf_lo(aw[j]) * rn, bf_hi(aw[j]) * rn);
    *ap = ow;
}
__device__ __forceinline__ void pass_combine(const bf16_t* PQ, const float* SP, const float* XM, const float* SSQNA, bf16_t* YCAT) {
    const int vb = (gridDim.x & 7) ? (int)blockIdx.x : (int)((blockIdx.x & 7) * (gridDim.x >> 3) + (blockIdx.x >> 3));
    const int lane = threadIdx.x & 63, gw = vb * NWAVES + (threadIdx.x >> 6), NGW = gridDim.x * NWAVES;
    for (int pi0 = gw; pi0 < NBATCH * 1024; pi0 += NGW) {
        const int pi = (NGW == 2048) ? gw * 4 + (pi0 - gw) / NGW : pi0;
        const int b = pi >> 10, kk = pi & 1023;
        const u32x4 pw = *(const u32x4*)(PQ + (size_t)kk * 4096 + b * 512 + lane * 8), qw = *(const u32x4*)(PQ + (size_t)(1024 + kk) * 4096 + b * 512 + lane * 8);
        float y1[8], y2[8];
        const f32x4 xa = *(const f32x4*)(XM + b * 512 + lane * 8), xb = *(const f32x4*)(XM + b * 512 + lane * 8 + 4); const float xs = (kk & 1) ? -0.022097086912079608f : 0.022097086912079608f;
        const float xm[8] = {xa[0] * xs, xa[1] * xs, xa[2] * xs, xa[3] * xs, xb[0] * xs, xb[1] * xs, xb[2] * xs, xb[3] * xs};
#pragma unroll
        for (int j = 0; j < 4; ++j) { const float pl = bf_lo(pw[j]) + xm[2 * j], ph = bf_hi(pw[j]) + xm[2 * j + 1], ql = bf_lo(qw[j]), qh = bf_hi(qw[j]); y1[2 * j] = pl - ql; y1[2 * j + 1] = ph - qh; y2[2 * j] = pl + ql; y2[2 * j + 1] = ph + qh; }
        if (kk == 0) {
#pragma unroll
            for (int j = 0; j < 8; ++j) { const f32x4* sp = (const f32x4*)(SP + (size_t)(b * 512 + lane * 8 + j) * 32); f32x4 a = sp[0];
#pragma unroll
                for (int i = 1; i < 4; ++i) a += sp[i];
                y2[j] = ((a[0] + a[1]) + (a[2] + a[3])) * 0.022097086912079608f + xm[j]; }
        }
        combine_row(b * SEQ + kk, y1, SSQNA, YCAT, lane);
        combine_row(b * SEQ + (kk == 0 ? 1024 : SEQ - kk), y2, SSQNA, YCAT, lane);
    }
}
__device__ __forceinline__ void pass_fixup(const bf16_t* side, const float* cw, const float* cb, bf16_t* A, int ri0, int nri, int widx, int nw) {
    const int total = nri * (DFF / 4);
    for (int u = widx * NTHREADS + threadIdx.x; u < total; u += nw * NTHREADS) {
        const int ri = ri0 + u / (DFF / 4), J = (u % (DFF / 4)) * 4, chunk = ri >> 1, bot = ri & 1;
        const bf16_t* sc = side + (size_t)chunk * 4 * (2 * DFF);
        const bf16_t *pp, *pc, *pn; bool hp = true, hn = true; int tok;
        if (!bot) { hp = (chunk & 31) != 0; pp = sc - (2 * DFF); pc = sc; pn = sc + (2 * DFF); tok = chunk * 64; }
        else { hn = (chunk & 31) != 31; pp = sc + 2 * (2 * DFF); pc = sc + 3 * (2 * DFF); pn = sc + 4 * (2 * DFF); tok = chunk * 64 + 63; }
        float up[2][4];
#pragma unroll
        for (int bj = 0; bj < 2; ++bj) {
            const int col = bj * DFF + J;
            u32x2 wp = (u32x2){0u, 0u}, wn = (u32x2){0u, 0u}; if (hp) wp = *(const u32x2*)(pp + col); if (hn) wn = *(const u32x2*)(pn + col); const u32x2 wc2 = *(const u32x2*)(pc + col);
            const f32x4 k0 = *(const f32x4*)(cw + col), k1 = *(const f32x4*)(cw + 2 * DFF + col), k2 = *(const f32x4*)(cw + 4 * DFF + col), kb = *(const f32x4*)(cb + col);
            const float pv[4] = {bf_lo(wp.x), bf_hi(wp.x), bf_lo(wp.y), bf_hi(wp.y)}, cv[4] = {bf_lo(wc2.x), bf_hi(wc2.x), bf_lo(wc2.y), bf_hi(wc2.y)}, nv[4] = {bf_lo(wn.x), bf_hi(wn.x), bf_lo(wn.y), bf_hi(wn.y)};
#pragma unroll
            for (int j = 0; j < 4; ++j) up[bj][j] = k0[j] * pv[j] + k1[j] * cv[j] + k2[j] * nv[j] + kb[j];
        }
        u32x2 w; w.x = cvt_pk_bf16(silu_f(up[0][0]) * up[1][0], silu_f(up[0][1]) * up[1][1]); w.y = cvt_pk_bf16(silu_f(up[0][2]) * up[1][2], silu_f(up[0][3]) * up[1][3]);
        *(u32x2*)(A + (size_t)tok * DFF + J) = w;
    }
}

__device__ __forceinline__ void attn_phase(const Params& p, LAS unsigned char* lds) {
    const int tid = threadIdx.x, lane = tid & 63, w = __builtin_amdgcn_readfirstlane(tid >> 6), fr = lane & 15, fq = lane >> 4;
    LAS unsigned char* Ks = lds;
    LAS unsigned char* Vs = lds + 73728;
    LAS float* rp = (LAS float*)(lds + 147456);
    volatile LAS unsigned* slot = (volatile LAS unsigned*)(lds + 147456 + 2048);
    const bf16_t* QH = (const bf16_t*)(p.ws + WS_QK); const bf16_t* KH = (const bf16_t*)(p.ws + WS_QK + (16u << 20)); const bf16_t* VTA = (const bf16_t*)(p.ws + WS_VTA);
    bf16_t* YCAT = (bf16_t*)(p.ws + WS_YCAT); float* SSQNA = (float*)(p.ws + WS_SSQ1 + 512 * 1024);
    const float sc2 = 0.125f * 1.4426950408889634f;
    unsigned* ctr = (unsigned*)(p.ws + WS_BAR) + 3584;
    const int ri = w >> 2, qb = w & 3, q0 = qb * 16, kc0 = min(max(q0 - 8, 0), 32);
    const int kperm = 8 * (fr >> 2) + (fr & 3);
    for (;;) {
        __syncthreads();
        if (tid == 0) slot[0] = __hip_atomic_fetch_add(ctr, 1u, __ATOMIC_RELAXED, __HIP_MEMORY_SCOPE_AGENT);
        __syncthreads();
        const int item = (int)slot[0];
        if (item >= 1024) break;
        const int b = item >> 7, h = (item >> 4) & 7, r0 = (item & 15) * 2, R0 = min(max(r0 - 4, 0), 24);
        const int r = r0 + ri, rs = min(max(r - 4, 0), 24), j0 = rs - R0;
        const int tq = b * SEQ + r * 64 + q0 + fr;
        const bf16_t* qp = QH + ((size_t)(b * 8 + h) * SEQ + r * 64 + q0 + fr) * 64 + fq * 8;
        const bf16x8 qf0 = *(const bf16x8*)qp, qf1 = *(const bf16x8*)(qp + 32);
        for (int u = tid; u < 465; u += NTHREADS) rp[u] = p.rpb[h * 465 + u] * 1.4426950408889634f;
        { const int t = tid >> 3, c = tid & 7; const unsigned dstk = (unsigned)(t * 128 + ((c ^ (((t >> 1) & 1) | (((t >> 3) & 3) << 1))) << 4)), dstv = (unsigned)(t * 128 + ((c ^ ((t >> 1) & 7)) << 4));
          u32x4 kv[9], vv[9];
#pragma unroll
          for (int j = 0; j < 9; ++j) { const int srow = min(R0 + j, 31);
              kv[j] = *(const u32x4*)(KH + ((size_t)(b * 8 + h) * SEQ + srow * 64 + t) * 64 + c * 8);
              vv[j] = *(const u32x4*)(VTA + ((size_t)((b * 8 + h) * 32 + srow) * 64 + t) * 64 + c * 8); }
#pragma unroll
          for (int j = 0; j < 9; ++j) { *(LAS u32x4*)(Ks + j * 8192 + dstk) = kv[j]; *(LAS u32x4*)(Vs + j * 8192 + dstv) = vv[j]; } }
        __syncthreads();
        f32x4 s[8][2];
#pragma unroll
        for (int i = 0; i < 8; ++i)
#pragma unroll
            for (int t = 0; t < 2; ++t) { const int tok = kc0 + kperm + 4 * t; const LAS unsigned char* kr = Ks + (j0 + i) * 8192 + tok * 128;
                const int fk = ((tok >> 1) & 1) | (((tok >> 3) & 3) << 1);
                const bf16x8 k0 = *(const LAS bf16x8*)(kr + ((fq ^ fk) << 4)), k1 = *(const LAS bf16x8*)(kr + (((4 + fq) ^ fk) << 4));
                f32x4 a = (f32x4){0.f, 0.f, 0.f, 0.f};
                a = __builtin_amdgcn_mfma_f32_16x16x32_bf16(k0, qf0, a, 0, 0, 0); a = __builtin_amdgcn_mfma_f32_16x16x32_bf16(k1, qf1, a, 0, 0, 0); s[i][t] = a; }
        const int qc = q0 + fr, cs0 = min(max(qc - 8, 0), 48);
        float madd[2][4]; int dco[2][4];
#pragma unroll
        for (int t = 0; t < 2; ++t)
#pragma unroll
            for (int j = 0; j < 4; ++j) { const int kc = kc0 + 8 * fq + 4 * t + j; madd[t][j] = ((kc >= cs0) && (kc < cs0 + 16)) ? 0.f : -1e30f; dco[t][j] = min(max(kc - qc, -15), 15); }
        float mx = -1e30f;
#pragma unroll
        for (int i = 0; i < 8; ++i) { const int dr = rs + i - r; const LAS float* rrow = rp + (dr + 7) * 31 + 15;
#pragma unroll
            for (int t = 0; t < 2; ++t)
#pragma unroll
                for (int j = 0; j < 4; ++j) { const float v = (s[i][t][j] * sc2 + rrow[dco[t][j]]) + madd[t][j]; s[i][t][j] = v; mx = fmaxf(mx, v); } }
        mx = fmaxf(mx, __shfl_xor(mx, 16)); mx = fmaxf(mx, __shfl_xor(mx, 32));
        float sum = 0.f;
#pragma unroll
        for (int i = 0; i < 8; ++i)
#pragma unroll
            for (int t = 0; t < 2; ++t)
#pragma unroll
                for (int j = 0; j < 4; ++j) { const float e = __builtin_amdgcn_exp2f(s[i][t][j] - mx); s[i][t][j] = e; sum += e; }
        sum += __shfl_xor(sum, 16); sum += __shfl_xor(sum, 32);
        const float inv = 1.0f / sum;
        f32x4 o[4];
#pragma unroll
        for (int nb = 0; nb < 4; ++nb) o[nb] = (f32x4){0.f, 0.f, 0.f, 0.f};
        const int vc = (kc0 >> 3) + fq;
#pragma unroll
        for (int i = 0; i < 8; ++i) {
            u32x4 pw; pw.x = cvt_pk_bf16(s[i][0][0], s[i][0][1]); pw.y = cvt_pk_bf16(s[i][0][2], s[i][0][3]); pw.z = cvt_pk_bf16(s[i][1][0], s[i][1][1]); pw.w = cvt_pk_bf16(s[i][1][2], s[i][1][3]);
            const bf16x8 pf = __builtin_bit_cast(bf16x8, pw);
#pragma unroll
            for (int nb = 0; nb < 4; ++nb) { const int d = nb * 16 + fr; const bf16x8 va = *(const LAS bf16x8*)(Vs + (j0 + i) * 8192 + d * 128 + ((vc ^ ((d >> 1) & 7)) << 4));
                o[nb] = __builtin_amdgcn_mfma_f32_16x16x32_bf16(va, pf, o[nb], 0, 0, 0); } }
        float q2 = 0.f;
#pragma unroll
        for (int nb = 0; nb < 4; ++nb) { o[nb] = o[nb] * inv; q2 += (o[nb][0] * o[nb][0] + o[nb][1] * o[nb][1]) + (o[nb][2] * o[nb][2] + o[nb][3] * o[nb][3]); }
        q2 += __shfl_xor(q2, 16); q2 += __shfl_xor(q2, 32);
        if (fq == 0) SSQNA[(size_t)tq * 8 + h] = q2;
        bf16_t* op = YCAT + (size_t)tq * DM + 512 + h * 64 + 4 * fq;
#pragma unroll
        for (int nb = 0; nb < 4; ++nb) { u32x2 wv; wv.x = cvt_pk_bf16(o[nb][0], o[nb][1]); wv.y = cvt_pk_bf16(o[nb][2], o[nb][3]); *(u32x2*)(op + nb * 16) = wv; }
    }
    __syncthreads();
}

constexpr int N_PHASES = 11;
__global__ void __launch_bounds__(NTHREADS, 2) fwd_megakernel(Params p) {
    extern __shared__ __attribute__((aligned(16))) unsigned char lds_raw[];
    LAS unsigned char* lds = (LAS unsigned char*)lds_raw;
    volatile LAS unsigned* bst = (volatile LAS unsigned*)(lds + LDS_BYTES - 16);
    const int lo = p.ph_lo, hi = p.ph_hi, G = gridDim.x, cid = blockIdx.x;
    if (threadIdx.x < 4) bst[threadIdx.x] = 0u;
    __syncthreads();
    XcdBarrier bar; bar.bar = (unsigned*)(p.ws + WS_BAR); bar.x = 0; bar.st = bst; bar.G = gridDim.x;
    if (!MK_PER_PHASE) bar = xcd_barrier_post((unsigned*)(p.ws + WS_BAR), bst, gridDim.x);
    XcdBarrier gbar; gbar.bar = (unsigned*)(p.ws + WS_BAR + 65536 + 16384 * (blockIdx.x & 7)); gbar.x = 0; gbar.st = bst + 2; gbar.G = gridDim.x >> 3;
    if (!MK_PER_PHASE && gridDim.x == 256) gbar = xcd_barrier_post(gbar.bar, bst + 2, gridDim.x >> 3);
    if (lo < 0) cg::this_grid().sync();
#define IN(k) (lo <= (k) && (k) < hi)
#define REP(k) for (int rep_ = 0; rep_ < 1 + ((REPEAT_MASK >> (k)) & 1); ++rep_)
#define SEAM(k) do { if (IN(k) && IN((k) + 1)) xcd_barrier(bar); } while (0)
    unsigned char* ws = p.ws;
    const float* mod = (const float*)(ws + WS_MOD);

    if (IN(0)) REP(0) p0_prologue(p, lds);
    if (IN(0) && IN(1)) {
        if (threadIdx.x < 64) { unsigned sp = 0; unsigned* mc = (unsigned*)(ws + WS_BAR) + 3712;
            while ((unsigned)__builtin_amdgcn_readfirstlane(__hip_atomic_load(mc, __ATOMIC_RELAXED, __HIP_MEMORY_SCOPE_AGENT)) < 96u) { __builtin_amdgcn_s_sleep(2); if (++sp > (1u << 22)) break; }
            __builtin_amdgcn_fence(__ATOMIC_ACQUIRE, "agent");
            asm volatile("s_waitcnt vmcnt(0)" ::: "memory"); }
        __syncthreads();
    }
    if (IN(1)) REP(1) pass_h_fold(p.x, p.g_mix, mod, (bf16_t*)(ws + WS_H), (bf16_t*)(ws + WS_HE), (bf16_t*)(ws + WS_HO));
    SEAM(1);
    if (IN(2)) { SchedP2 S{(const char*)(ws + WS_H), (const char*)(ws + WS_HE), (const char*)(ws + WS_HO), (const char*)(ws + WS_WQK), (const char*)(ws + WS_WA), (char*)(ws + WS_QK), (char*)(ws + WS_VT), (char*)(ws + WS_VTA), (float*)(ws + WS_SSQ2 + 512 * 1024), G, cid};
        pg8::EpiTileBf16 E; pg8::gemm_phase(lds, DM, S, E);
        late_work(p, lds, cid, G, 4); }
    SEAM(2);
    if (IN(3)) { pass_xmid((const bf16_t*)(ws + WS_H), (const bf16_t*)(ws + WS_WA), (float*)(ws + WS_SSQ2 + 256 * 1024));
        SchedFourier S{(const char*)(ws + WS_CS), (const char*)(ws + WS_VT), (char*)(ws + WS_PQ), G, cid};
        pg8::EpiTileBf16 E; pg8::gemm_phase(lds, 1024, S, E);
        if (G == 256) { if (cid >= 128) late_work(p, lds, cid - 128, 128, 3); } else late_work(p, lds, cid, G, 3);
        attn_phase(p, lds); }
    SEAM(3);
    if (IN(4)) REP(4) pass_combine((const bf16_t*)(ws + WS_PQ), (const float*)(ws + WS_SSQ2 + 512 * 1024), (const float*)(ws + WS_SSQ2 + 256 * 1024), (const float*)(ws + WS_SSQ1 + 512 * 1024), (bf16_t*)(ws + WS_YCAT));
    const bool fuse = (G == 256);
#define GSEAM(k, k2) do { if (IN(k) && IN(k2)) { if (fuse) xcd_barrier(gbar); else xcd_barrier(bar); } } while (0)
    GSEAM(4, 5);
    if (IN(5)) { SchedPlain S{(const char*)(ws + WS_YCAT), (const char*)(ws + WS_WOUT), 64, 4, DM, G, cid};
        if (fuse) { pg8::EpiResidNormMod E{p.x, (bf16_t*)(ws + WS_X1B), mod, 2 * DM, 3 * DM, 4 * DM, p.g_ffn, (bf16_t*)(ws + WS_H), pg8::PanelSsq{(float*)(ws + WS_SSQ1), (unsigned*)(ws + WS_BAR + 16384)}}; pg8::gemm_phase(lds, DM, S, E); }
        else { pg8::EpiResid E{p.x, p.out, mod + 2 * DM, (float*)(ws + WS_SSQ1)}; pg8::gemm_phase(lds, DM, S, E); } }
    if (!fuse) SEAM(5);
    if (IN(6) && !fuse) pass_norm_mod(p.out, (const float*)(ws + WS_SSQ1), p.g_ffn, mod, 3 * DM, 4 * DM, (bf16_t*)(ws + WS_H));
    if (fuse) GSEAM(5, 7); else SEAM(6);
    if (IN(7)) REP(7) { SchedPlain S{(const char*)(ws + WS_H), (const char*)(ws + WS_WUP), 64, 22, DM, G, cid};
        pg8::EpiUp E{(bf16_t*)(ws + WS_A), (bf16_t*)(ws + WS_SIDE), p.conv_w, p.conv_b}; pg8::gemm_phase(lds, DM, S, E);
        }
    GSEAM(7, 8);
    if (IN(8)) { if (fuse) pass_fixup((const bf16_t*)(ws + WS_SIDE), p.conv_w, p.conv_b, (bf16_t*)(ws + WS_A), 64 * (cid & 7), 64, cid >> 3, G >> 3);
        else pass_fixup((const bf16_t*)(ws + WS_SIDE), p.conv_w, p.conv_b, (bf16_t*)(ws + WS_A), 0, 512, cid, G); }
    GSEAM(8, 9);
    if (REPEAT_MASK & (1 << 20)) { for (int e_ = 0; e_ < 8; ++e_) xcd_barrier(bar); }
    if (IN(9)) { SchedPlain S{(const char*)(ws + WS_A), (const char*)(ws + WS_WDN), 64, 4, DFF, G, cid};
        if (fuse) { pg8::EpiResidNormOut E{(const bf16_t*)(ws + WS_X1B), p.out, mod, 5 * DM, p.g_final, pg8::PanelSsq{(float*)(ws + WS_SSQ2), (unsigned*)(ws + WS_BAR + 32768)}}; pg8::gemm_phase(lds, DFF, S, E); }
        else { pg8::EpiResid E{p.out, p.out, mod + 5 * DM, (float*)(ws + WS_SSQ2)}; pg8::gemm_phase(lds, DFF, S, E); } }
    if (!fuse) SEAM(9);
    if (IN(10) && !fuse) pass_final(p.out, (const float*)(ws + WS_SSQ2), p.g_final);
#undef IN
#undef SEAM
#undef GSEAM
}

extern "C" void kernel_launch(void* const* d_in, const int* in_sizes, int n_in, void* d_out, int out_size, void* d_ws, size_t ws_size, hipStream_t stream) {
    static int grid = 0;
    if (grid == 0) {
        int dev = 0, cus = 0, per_cu = 0;
        if (n_in != 17 || ws_size < WS_END) { fprintf(stderr, "kernel_launch: unexpected inputs (n_in %d, ws %zu)\n", n_in, ws_size); grid = -1; return; }
        hipGetDevice(&dev);
        hipDeviceGetAttribute(&cus, hipDeviceAttributeMultiprocessorCount, dev);
        if (hipFuncSetAttribute((const void*)fwd_megakernel, hipFuncAttributeMaxDynamicSharedMemorySize, LDS_BYTES) != hipSuccess) { fprintf(stderr, "kernel_launch: hipFuncSetAttribute failed\n"); grid = -1; return; }
        hipOccupancyMaxActiveBlocksPerMultiprocessor(&per_cu, (const void*)fwd_megakernel, NTHREADS, LDS_BYTES);
        if (per_cu < 1) { fprintf(stderr, "kernel_launch: occupancy query says %d blocks per CU\n", per_cu); per_cu = 1; }
        (void)hipGetLastError();
        grid = cus;
    }
    if (grid < 0) return;
    Params p{};
    const float** f = (const float**)&p;
    for (int i = 0; i < 17; ++i) f[i] = (const float*)d_in[i];
    p.out = (float*)d_out; p.ws = (unsigned char*)d_ws;
    hipMemsetAsync((char*)d_ws + WS_BAR, 0, 196608, stream);
#if MK_PER_PHASE
    for (int ph = 0; ph < N_PHASES; ++ph) { p.ph_lo = ph; p.ph_hi = ph + 1; hipLaunchKernelGGL(fwd_megakernel, dim3(grid), dim3(NTHREADS), LDS_BYTES, stream, p); }
#else
    p.ph_lo = 0; p.ph_hi = N_PHASES;
    void* args[] = {&p};
    hipError_t e = hipLaunchCooperativeKernel((const void*)fwd_megakernel, dim3(grid), dim3(NTHREADS), args, LDS_BYTES, stream);
    if (e != hipSuccess) fprintf(stderr, "cooperative launch failed: %s (grid %d)\n", hipGetErrorString(e), grid);
#endif
}
```

```cpp
#include <hip/hip_runtime.h>
#include <hip/hip_cooperative_groups.h>
#include <cstdio>
namespace cg = cooperative_groups;

#ifndef REPEAT_MASK
#define REPEAT_MASK 0
#endif
#ifndef MK_PER_PHASE
#define MK_PER_PHASE 0
#endif

#define LAS __attribute__((address_space(3)))
typedef unsigned short bf16_t;
typedef short bf16x8 __attribute__((ext_vector_type(8)));
typedef float f32x4 __attribute__((ext_vector_type(4)));
typedef float f32x2 __attribute__((ext_vector_type(2)));
typedef unsigned u32x4 __attribute__((ext_vector_type(4)));
typedef unsigned u32x2 __attribute__((ext_vector_type(2)));

constexpr int DM = 1024, NBATCH = 8, SEQ = 2048, NTOK = NBATCH * SEQ, DFF = 2816, NMOD = 6 * DM;
constexpr float EPS = 1e-6f;
constexpr int NTHREADS = 512, NWAVES = 8;
constexpr int LDS_STAGE = 131072, LDS_EXTRA = 20480, LDS_BYTES = LDS_STAGE + LDS_EXTRA;

constexpr size_t MiB = 1u << 20;
constexpr size_t WS_MOD = 0;
constexpr size_t WS_BAR = 512 * 1024;
constexpr size_t WS_SSQ1 = 1 * MiB;
constexpr size_t WS_SSQ2 = 2 * MiB;
constexpr size_t WS_WQK = 3 * MiB;
constexpr size_t WS_WA = 5 * MiB;
constexpr size_t WS_WOUT = 8 * MiB;
constexpr size_t WS_WUP = 10 * MiB;
constexpr size_t WS_WDN = 21 * MiB;
constexpr size_t WS_CS = 27 * MiB;
constexpr size_t WS_H = 47 * MiB;
constexpr size_t WS_VT = 79 * MiB;
constexpr size_t WS_QK = 95 * MiB;
constexpr size_t WS_VTA = 127 * MiB;
constexpr size_t WS_PQ = 31 * MiB;
constexpr size_t WS_YCAT = 178 * MiB;
constexpr size_t WS_A = 79 * MiB;
constexpr size_t WS_SIDE = 167 * MiB;
constexpr size_t WS_HE = 143 * MiB;
constexpr size_t WS_HO = 159 * MiB;
constexpr size_t WS_X1B = 210 * MiB;
constexpr size_t WS_END = 242 * MiB;

struct Params {
    const float *x, *c, *w_ada, *b_ada, *g_mix, *w_in, *w_four, *rpb, *g_four_out, *g_na_out, *w_out, *g_ffn, *w_up, *conv_w, *conv_b, *w_down, *g_final;
    float* out; unsigned char* ws;
    int ph_lo, ph_hi;
};

__device__ __forceinline__ unsigned cvt_pk_bf16(float lo, float hi) { unsigned r; asm volatile("v_cvt_pk_bf16_f32 %0, %1, %2" : "=v"(r) : "v"(lo), "v"(hi)); return r; }
__device__ __forceinline__ float bf_lo(unsigned w) { return __uint_as_float(w << 16); }
__device__ __forceinline__ float bf_hi(unsigned w) { return __uint_as_float(w & 0xffff0000u); }
__device__ __forceinline__ float wave_sum(float v) {
#pragma unroll
    for (int o = 1; o < 64; o <<= 1) v += __shfl_xor(v, o);
    return v;
}
__device__ __forceinline__ float silu_f(float v) { return v * __builtin_amdgcn_rcpf(1.0f + __expf(-v)); }
template <int CTRL> __device__ __forceinline__ float dpp_f(float v) {
    return __builtin_bit_cast(float, __builtin_amdgcn_mov_dpp(__builtin_bit_cast(int, v), CTRL, 0xF, 0xF, true));
}

#define XB_TMO      128
#define XB_XCNT(j)  (256  + 64 * (j))
#define XB_XSUB(j)  (1280 + 64 * (j))
#define XB_XGEN(j)  (2304 + 64 * (j))
#define XB_TOP      3328
#define XB_TOPGEN   3392
#define XCD_BAR_WORDS 3456
#define XB_SPIN_CAP (1u << 20)
__device__ __forceinline__ unsigned xb_ld(unsigned* p)              { return __hip_atomic_load(p, __ATOMIC_RELAXED, __HIP_MEMORY_SCOPE_AGENT); }
__device__ __forceinline__ unsigned xb_add(unsigned* p, unsigned v) { return __hip_atomic_fetch_add(p, v, __ATOMIC_RELAXED, __HIP_MEMORY_SCOPE_AGENT); }
__device__ __forceinline__ unsigned xb_xcc_id() { return (unsigned)__builtin_amdgcn_s_getreg((3 << 11) | 20) & 0xFu; }
#define XB_SPIN(cond, bar) do { unsigned _sp = 0; while (cond) { __builtin_amdgcn_s_sleep(1); \
    if ((++_sp & 255u) == 0u) { if (xb_ld(&(bar)[XB_TMO])) break; if (_sp > XB_SPIN_CAP) { atomicAdd(&(bar)[XB_TMO], 1u); break; } } } } while (0)
struct XcdBarrier { unsigned* bar; unsigned x; volatile LAS unsigned* st; unsigned G; };
__device__ __forceinline__ XcdBarrier xcd_barrier_post(unsigned* bar, volatile LAS unsigned* st, unsigned G) {
    XcdBarrier b; b.bar = bar; b.x = xb_xcc_id(); b.st = st; b.G = G;
    if (threadIdx.x == 0) (void)xb_add(&bar[XB_XCNT(b.x)], 1u);
    return b;
}
__device__ __forceinline__ void xcd_barrier_complete(unsigned* bar, unsigned x, unsigned& nloc, unsigned& nx, const unsigned G) {
    unsigned sum, cnt, mine, sp = 0u;
    for (;;) {
        sum = 0u; cnt = 0u; mine = 0u;
#pragma unroll
        for (unsigned j = 0; j < 16; ++j) { const unsigned c = xb_ld(&bar[XB_XCNT(j)]); sum += c; cnt += (c > 0u) ? 1u : 0u; mine = (j == x) ? c : mine; }
        if (sum == G) break;
        __builtin_amdgcn_s_sleep(1);
        if ((++sp & 255u) == 0u) { if (xb_ld(&bar[XB_TMO])) break; if (sp > XB_SPIN_CAP) { atomicAdd(&bar[XB_TMO], 1u); break; } }
    }
    nloc = mine > 0u ? mine : 1u; nx = cnt > 0u ? cnt : 1u;
}
__device__ __forceinline__ void xcd_barrier(const XcdBarrier& b) {
    asm volatile("s_waitcnt vmcnt(0)" ::: "memory");
    __syncthreads();
    if (threadIdx.x == 0) {
        unsigned* bar = b.bar;
        __builtin_amdgcn_s_waitcnt(0);
        unsigned nloc = b.st[0], nx = b.st[1];
        if (nloc == 0u) { xcd_barrier_complete(bar, b.x, nloc, nx, b.G); b.st[0] = nloc; b.st[1] = nx; }
        const unsigned old = xb_add(&bar[XB_XSUB(b.x)], 1u);
        const unsigned gen = old / nloc;
        if (old + 1u == (gen + 1u) * nloc) {
            __builtin_amdgcn_fence(__ATOMIC_RELEASE, "agent");
            asm volatile("s_waitcnt vmcnt(0)" ::: "memory");
            const unsigned og = xb_add(&bar[XB_TOP], 1u);
            const unsigned tg = og / nx;
            if (og + 1u == (tg + 1u) * nx) xb_add(&bar[XB_TOPGEN], 1u);
            else XB_SPIN(xb_ld(&bar[XB_TOPGEN]) == tg, bar);
            __builtin_amdgcn_fence(__ATOMIC_ACQUIRE, "agent");
            xb_add(&bar[XB_XGEN(b.x)], 1u);
            asm volatile("s_waitcnt vmcnt(0)" ::: "memory");
        } else {
            XB_SPIN(xb_ld(&bar[XB_XGEN(b.x)]) == gen, bar);
            __builtin_amdgcn_fence(__ATOMIC_ACQUIRE, "agent");
            asm volatile("s_waitcnt vmcnt(0)" ::: "memory");
        }
    }
    __syncthreads();
}

__device__ __forceinline__ void group_barrier(unsigned* ctr, unsigned& gen, unsigned nmemb) {
    asm volatile("s_waitcnt vmcnt(0)" ::: "memory");
    __syncthreads();
    ++gen;
    if (threadIdx.x == 0) {
        __builtin_amdgcn_fence(__ATOMIC_RELEASE, "agent");
        asm volatile("s_waitcnt vmcnt(0)" ::: "memory");
        (void)xb_add(ctr, 1u);
        const unsigned target = gen * nmemb; unsigned sp = 0;
        while (xb_ld(ctr) < target) { __builtin_amdgcn_s_sleep(1); if (++sp > (1u << 22)) break; }
        __builtin_amdgcn_fence(__ATOMIC_ACQUIRE, "agent");
        asm volatile("s_waitcnt vmcnt(0)" ::: "memory");
    }
    __syncthreads();
}

namespace pg8 {
constexpr int BM = 256, BK = 64, HALF = 128, HTB = HALF * BK * 2, NXCD = 8, WGM = 8;
__device__ __forceinline__ int lds_byte(int r, int c) { const int st = (r >> 4) * 2 + (c >> 5), rr = r & 15, cc = c & 31, ob = rr * 64 + cc * 2; return st * 1024 + (ob ^ (((ob >> 9) & 1) << 5)); }
__device__ __forceinline__ void stage_rc(int b, int& R, int& C) { const int st = b / 1024, sb = b % 1024, swz = sb ^ (((sb >> 9) & 1) << 5); R = (st >> 1) * 16 + swz / 64; C = (st & 1) * 32 + (swz % 64) / 2; }
__device__ __forceinline__ int perm32(int rho) { const int n = rho >> 4, i = rho & 15; return 8 * (i >> 2) + 4 * n + (i & 3); }

struct Unit { const char* pa; const char* pb; char* po; float* sp; int rp, RS, CS; int pm, pn; };

__device__ __forceinline__ void tile_map(int wgid, int nM, int nN, int& pm, int& pn) {
    const int nwg = nM * nN;
    { const int q = nwg / NXCD, r = nwg % NXCD, xcd = wgid % NXCD, off = wgid / NXCD; wgid = (xcd < r ? xcd * (q + 1) : r * (q + 1) + (xcd - r) * q) + off; }
    const int nig = WGM * nN, gid = wgid / nig, fm = gid * WGM, gsz = (nM - fm) < WGM ? (nM - fm) : WGM;
    pm = fm + ((wgid % nig) % gsz); pn = (wgid % nig) / gsz;
}

template <class Epi, class Sched>
__device__ __forceinline__ void gemm_phase(LAS unsigned char* lds, const int K, const Sched& S, const Epi& E) {
    const int tid = threadIdx.x, wid = __builtin_amdgcn_readfirstlane(tid >> 6), lane = tid & 63, wr = wid >> 2, wc = wid & 3, fr = lane & 15, fq = lane >> 4;
    const int nt = K / BK;
    unsigned voffA[2], voffB[2];
#pragma unroll
    for (int i = 0; i < 2; ++i) { int R, C; stage_rc(tid * 16 + i * 8192, R, C); const int Rb = Epi::PERM ? ((R & ~31) + perm32(R & 31)) : R;
        const int Ra = Epi::APERM ? (2 * (R & 64) + 4 * (R & 15) + ((R >> 4) & 3)) : R;
        voffA[i] = (unsigned)(Ra * K + C) * 2u; voffB[i] = (unsigned)(Rb * K + C) * 2u; }
    const size_t kstep = (size_t)(BK * 2);
    const size_t hstep = (size_t)HALF * K * 2;
    const size_t hstepA = Epi::APERM ? (size_t)64 * K * 2 : hstep;
    const unsigned ldsw = (unsigned)wid * 1024u;
    const int aoff = lds_byte(wr * 64 + fr, fq * 8), boff = lds_byte(wc * 32 + fr, fq * 8);
#define PG8_SA(b, h) (((b) * 2 + (h)) * HTB)
#define PG8_SB(b, h) ((4 + (b) * 2 + (h)) * HTB)
#define PG8_STAGE(bufoff, gbase, voff) do { _Pragma("unroll") for (int _i = 0; _i < 2; ++_i) \
        __builtin_amdgcn_global_load_lds((const unsigned*)((const char*)(gbase) + (voff)[_i]), (LAS unsigned*)(lds + (bufoff) + ldsw + _i * 8192), 16, 0, 0); } while (0)
#define PG8_LDA(dst, b, h) do { _Pragma("unroll") for (int m = 0; m < 4; ++m) _Pragma("unroll") for (int k = 0; k < 2; ++k) dst[m][k] = *(const LAS bf16x8*)(lds + PG8_SA(b, h) + aoff + m * 2048 + k * 1024); } while (0)
#define PG8_LDB(dst, b, h) do { _Pragma("unroll") for (int n = 0; n < 2; ++n) _Pragma("unroll") for (int k = 0; k < 2; ++k) dst[n][k] = *(const LAS bf16x8*)(lds + PG8_SB(b, h) + boff + n * 2048 + k * 1024); } while (0)
#define PG8_MMA(ai, bj, At, Bt) do { __builtin_amdgcn_s_setprio(1); _Pragma("unroll") for (int m = 0; m < 4; ++m) _Pragma("unroll") for (int n = 0; n < 2; ++n) _Pragma("unroll") for (int k = 0; k < 2; ++k) \
        acc[ai][bj][m][n] = __builtin_amdgcn_mfma_f32_16x16x32_bf16(Bt[n][k], At[m][k], acc[ai][bj][m][n], 0, 0, 0); __builtin_amdgcn_s_setprio(0); } while (0)
#define PG8_WAIT_V(n) asm volatile("s_waitcnt vmcnt(" #n ")" ::: "memory")
#define PG8_WAIT_L(n) asm volatile("s_waitcnt lgkmcnt(" #n ")" ::: "memory")
#define PG8_BAR __builtin_amdgcn_s_barrier()
#define PG8_SCHED __builtin_amdgcn_sched_barrier(0)
    Unit cur, nxt; int ui = 0;
    if (!S.next(0, cur)) return;
    f32x4 acc[2][2][4][2];
#pragma unroll
    for (int a = 0; a < 2; ++a)
#pragma unroll
        for (int b = 0; b < 2; ++b)
#pragma unroll
            for (int m = 0; m < 4; ++m)
#pragma unroll
                for (int n = 0; n < 2; ++n) acc[a][b][m][n] = (f32x4){0.f, 0.f, 0.f, 0.f};
    bf16x8 At[4][2], B0[2][2], B1[2][2];
    const char* cA = cur.pa; const char* cB = cur.pb;
    PG8_STAGE(PG8_SB(0, 0), cB, voffB); PG8_STAGE(PG8_SA(0, 0), cA, voffA); PG8_STAGE(PG8_SB(0, 1), cB + hstep, voffB); PG8_STAGE(PG8_SA(0, 1), cA + hstepA, voffA);
    if (wr == 1) PG8_BAR;
    PG8_WAIT_V(4); PG8_BAR;
    PG8_STAGE(PG8_SB(1, 0), cB + kstep, voffB); PG8_STAGE(PG8_SA(1, 0), cA + kstep, voffA); PG8_STAGE(PG8_SB(1, 1), cB + hstep + kstep, voffB);
    PG8_WAIT_V(6); PG8_BAR;
    for (;;) {
        const bool has_next = S.next(ui + 1, nxt);
        const char* nA = has_next ? nxt.pa : cA; const char* nB = has_next ? nxt.pb : cB;
        for (int t = 0; t < nt; t += 2) {
            const bool last = (t == nt - 2);
            const char* a1 = cA + (size_t)(t + 1) * kstep;
            const char* a2 = last ? nA : cA + (size_t)(t + 2) * kstep; const char* b2 = last ? nB : cB + (size_t)(t + 2) * kstep;
            const char* a3 = a2 + kstep; const char* b3 = b2 + kstep;
            PG8_LDB(B0, 0, 0); PG8_SCHED; PG8_LDA(At, 0, 0); PG8_STAGE(PG8_SA(1, 1), a1 + hstepA, voffA);
            PG8_WAIT_L(8); PG8_BAR; PG8_WAIT_L(0); PG8_MMA(0, 0, At, B0); PG8_BAR; PG8_SCHED;
            PG8_LDB(B1, 0, 1); PG8_STAGE(PG8_SB(0, 0), b2, voffB);
            PG8_BAR; PG8_WAIT_L(0); PG8_MMA(0, 1, At, B1); PG8_BAR;
            PG8_LDA(At, 0, 1); PG8_STAGE(PG8_SA(0, 0), a2, voffA);
            PG8_BAR; PG8_WAIT_L(0); PG8_MMA(1, 0, At, B0); PG8_BAR; PG8_SCHED;
            PG8_STAGE(PG8_SB(0, 1), b2 + hstep, voffB);
            PG8_WAIT_V(6); PG8_BAR; PG8_MMA(1, 1, At, B1); PG8_BAR;
            PG8_LDB(B0, 1, 0); PG8_SCHED; PG8_LDA(At, 1, 0); PG8_STAGE(PG8_SA(0, 1), a2 + hstepA, voffA);
            PG8_WAIT_L(8); PG8_BAR; PG8_WAIT_L(0); PG8_MMA(0, 0, At, B0); PG8_BAR; PG8_SCHED;
            PG8_LDB(B1, 1, 1); PG8_STAGE(PG8_SB(1, 0), b3, voffB);
            PG8_BAR; PG8_WAIT_L(0); PG8_MMA(0, 1, At, B1); PG8_BAR;
            PG8_LDA(At, 1, 1); PG8_STAGE(PG8_SA(1, 0), a3, voffA);
            PG8_BAR; PG8_WAIT_L(0); PG8_MMA(1, 0, At, B0); PG8_BAR; PG8_SCHED;
            PG8_STAGE(PG8_SB(1, 1), b3 + hstep, voffB);
            PG8_WAIT_V(6); PG8_BAR; PG8_MMA(1, 1, At, B1); PG8_BAR;
        }
        if constexpr (!Epi::AFTER_DRAIN) E(acc, cur, wr, wc, fr, fq);
        if (!has_next) break;
#pragma unroll
        for (int a = 0; a < 2; ++a)
#pragma unroll
            for (int b = 0; b < 2; ++b)
#pragma unroll
                for (int m = 0; m < 4; ++m)
#pragma unroll
                    for (int n = 0; n < 2; ++n) acc[a][b][m][n] = (f32x4){0.f, 0.f, 0.f, 0.f};
        cur = nxt; cA = nA; cB = nB; ++ui;
    }
    PG8_WAIT_V(0);
    if (wr == 0) PG8_BAR;
    PG8_BAR;
    if constexpr (Epi::AFTER_DRAIN) E.fused(acc, cur, wr, wc, fr, fq, lds, wid, lane);
#undef PG8_SA
#undef PG8_SB
#undef PG8_STAGE
#undef PG8_LDA
#undef PG8_LDB
#undef PG8_MMA
#undef PG8_WAIT_V
#undef PG8_WAIT_L
#undef PG8_BAR
#undef PG8_SCHED
}

struct EpiTileBf16 {
    static constexpr bool PERM = true, AFTER_DRAIN = false, APERM = false;
    __device__ __forceinline__ void operator()(const f32x4 (&acc)[2][2][4][2], const Unit& u, int wr, int wc, int fr, int fq) const {
        bf16_t* base = (bf16_t*)u.po + (size_t)wr * u.RS + (size_t)fr * u.rp + (size_t)(wc >> 1) * u.CS + (wc & 1) * 32 + 8 * fq;
#pragma unroll
        for (int ai = 0; ai < 2; ++ai)
#pragma unroll
            for (int m = 0; m < 4; ++m) { bf16_t* rowp = base + (size_t)(2 * ai) * u.RS + (size_t)(m * 16) * u.rp;
#pragma unroll
                for (int bj = 0; bj < 2; ++bj) { const f32x4 v0 = acc[ai][bj][m][0], v1 = acc[ai][bj][m][1];
                    u32x4 w; w.x = cvt_pk_bf16(v0[0], v0[1]); w.y = cvt_pk_bf16(v0[2], v0[3]); w.z = cvt_pk_bf16(v1[0], v1[1]); w.w = cvt_pk_bf16(v1[2], v1[3]);
                    *(u32x4*)(rowp + (size_t)(2 * bj) * u.CS) = w; } }
        if (u.sp) {
#pragma unroll
            for (int ai = 0; ai < 2; ++ai)
#pragma unroll
                for (int m = 0; m < 4; ++m) { float s = 0.f;
#pragma unroll
                    for (int bj = 0; bj < 2; ++bj)
#pragma unroll
                        for (int n = 0; n < 2; ++n) { const f32x4 v = acc[ai][bj][m][n]; s += (v[0] - v[1]) + (v[2] - v[3]); }
                    s += __shfl_xor(s, 16); s += __shfl_xor(s, 32);
                    if (fq == 0) u.sp[(size_t)(ai * HALF + wr * 64 + m * 16 + fr) * 32 + wc] = s; }
        }
    }
};
struct EpiResid {
    static constexpr bool PERM = false, AFTER_DRAIN = false, APERM = false;
    const float* base; float* out; const float* gate; float* ssq;
    __device__ __forceinline__ void operator()(const f32x4 (&acc)[2][2][4][2], const Unit& u, int wr, int wc, int fr, int fq) const {
        const int row0 = u.pm * BM + wr * 64 + fr, col0 = u.pn * BM + wc * 32 + 4 * fq, b = u.pm >> 3;
        f32x4 gv[2][2];
#pragma unroll
        for (int bj = 0; bj < 2; ++bj)
#pragma unroll
            for (int n = 0; n < 2; ++n) gv[bj][n] = *(const f32x4*)(gate + (size_t)b * NMOD + col0 + bj * HALF + n * 16);
#pragma unroll
        for (int ai = 0; ai < 2; ++ai)
#pragma unroll
            for (int m = 0; m < 4; ++m) { const int row = row0 + ai * HALF + m * 16; const size_t off = (size_t)row * DM + col0; float s = 0.f;
#pragma unroll
                for (int bj = 0; bj < 2; ++bj)
#pragma unroll
                    for (int n = 0; n < 2; ++n) { const f32x4 xv = *(const f32x4*)(base + off + bj * HALF + n * 16); const f32x4 o = xv + gv[bj][n] * acc[ai][bj][m][n];
                        *(f32x4*)(out + off + bj * HALF + n * 16) = o; s += (o[0] * o[0] + o[1] * o[1]) + (o[2] * o[2] + o[3] * o[3]); }
                s += __shfl_xor(s, 16); s += __shfl_xor(s, 32);
                if (fq == 0) ssq[(size_t)row * 16 + u.pn * 4 + wc] = s; }
    }
};
struct EpiUp {
    static constexpr bool PERM = true, AFTER_DRAIN = false, APERM = true;
    bf16_t* A; bf16_t* side; const float* cw; const float* cb;
    __device__ __forceinline__ void operator()(f32x4 (&acc)[2][2][4][2], const Unit& u, int wr, int wc, int fr, int fq) const {
        const int J0 = u.pn * 128 + wc * 32 + fq * 8, sc = u.pm * 2 + wr;
        const bool f0 = (fr == 0), f15 = (fr == 15);
        if (f0 || f15) {
#pragma unroll
            for (int bj = 0; bj < 2; ++bj)
#pragma unroll
                for (int q = 0; q < 2; ++q) { const f32x4 a0 = f0 ? acc[0][bj][q][0] : acc[1][bj][2 + q][0], a1 = f0 ? acc[0][bj][q][1] : acc[1][bj][2 + q][1];
                    u32x4 w; w.x = cvt_pk_bf16(a0[0], a0[1]); w.y = cvt_pk_bf16(a0[2], a0[3]); w.z = cvt_pk_bf16(a1[0], a1[1]); w.w = cvt_pk_bf16(a1[2], a1[3]);
                    *(u32x4*)(side + (size_t)(sc * 4 + (f0 ? q : 2 + q)) * (2 * DFF) + bj * DFF + J0) = w; }
        }
#pragma unroll
        for (int bj = 0; bj < 2; ++bj)
#pragma unroll
            for (int n = 0; n < 2; ++n) {
                const int col = bj * DFF + J0 + n * 4;
                const f32x4 k0 = *(const f32x4*)(cw + col), k1 = *(const f32x4*)(cw + 2 * DFF + col), k2 = *(const f32x4*)(cw + 4 * DFF + col), kb = *(const f32x4*)(cb + col);
                const f32x4 a0 = acc[0][bj][0][n], a1 = acc[0][bj][1][n], a2 = acc[0][bj][2][n], a3 = acc[0][bj][3][n];
                const f32x4 b0 = acc[1][bj][0][n], b1 = acc[1][bj][1][n], b2 = acc[1][bj][2][n], b3 = acc[1][bj][3][n];
                f32x4 pa, pb, na, nb;
#pragma unroll
                for (int j = 0; j < 4; ++j) {
                    const float t = dpp_f<0x121>(a3[j]);
                    const float s1 = dpp_f<0x111>(b3[j]);
                    const float un = dpp_f<0x12F>(b0[j]);
                    const float s0 = dpp_f<0x101>(a0[j]);
                    pa[j] = t; pb[j] = f0 ? t : s1; na[j] = f15 ? un : s0; nb[j] = un; }
                f32x4 o0 = k0 * pa + k1 * a0 + k2 * a1 + kb, o1 = k0 * a0 + k1 * a1 + k2 * a2 + kb, o2 = k0 * a1 + k1 * a2 + k2 * a3 + kb, o3 = k0 * a2 + k1 * a3 + k2 * na + kb;
                f32x4 q0 = k0 * pb + k1 * b0 + k2 * b1 + kb, q1 = k0 * b0 + k1 * b1 + k2 * b2 + kb, q2 = k0 * b1 + k1 * b2 + k2 * b3 + kb, q3 = k0 * b2 + k1 * b3 + k2 * nb + kb;
                asm volatile("" : "+v"(o0), "+v"(o1), "+v"(o2), "+v"(o3), "+v"(q0), "+v"(q1), "+v"(q2), "+v"(q3));
                acc[0][bj][0][n] = o0; acc[0][bj][1][n] = o1; acc[0][bj][2][n] = o2; acc[0][bj][3][n] = o3;
                acc[1][bj][0][n] = q0; acc[1][bj][1][n] = q1; acc[1][bj][2][n] = q2; acc[1][bj][3][n] = q3;
            }
#pragma unroll
        for (int ai = 0; ai < 2; ++ai)
#pragma unroll
            for (int m = 0; m < 4; ++m) {
                const f32x4 g0 = acc[ai][0][m][0], g1 = acc[ai][0][m][1], v0 = acc[ai][1][m][0], v1 = acc[ai][1][m][1];
                u32x4 w; w.x = cvt_pk_bf16(silu_f(g0[0]) * v0[0], silu_f(g0[1]) * v0[1]); w.y = cvt_pk_bf16(silu_f(g0[2]) * v0[2], silu_f(g0[3]) * v0[3]);
                w.z = cvt_pk_bf16(silu_f(g1[0]) * v1[0], silu_f(g1[1]) * v1[1]); w.w = cvt_pk_bf16(silu_f(g1[2]) * v1[2], silu_f(g1[3]) * v1[3]);
                const bool valid = !((ai == 0 && m == 0 && f0) || (ai == 1 && m == 3 && f15));
                if (valid) *(u32x4*)(A + (size_t)(sc * 128 + ai * 64 + 4 * fr + m) * DFF + J0) = w;
            }
    }
};
struct PanelSsq {
    float* xbuf; unsigned* cnt;
    __device__ __forceinline__ void run(const f32x4 (&v)[2][2][4][2], const Unit& u, int wr, int wc, int fr, int fq, LAS unsigned char* lds, int wid, int lane) const {
        LAS float* P = (LAS float*)lds; LAS float* S = (LAS float*)(lds + 4096);
#pragma unroll
        for (int ai = 0; ai < 2; ++ai)
#pragma unroll
            for (int m = 0; m < 4; ++m) { float s = 0.f;
#pragma unroll
                for (int bj = 0; bj < 2; ++bj)
#pragma unroll
                    for (int n = 0; n < 2; ++n) { const f32x4 x = v[ai][bj][m][n]; s += (x[0] * x[0] + x[1] * x[1]) + (x[2] * x[2] + x[3] * x[3]); }
                s += __shfl_xor(s, 16); s += __shfl_xor(s, 32);
                if (fq == 0) P[(ai * HALF + wr * 64 + m * 16 + fr) * 4 + wc] = s; }
        asm volatile("s_waitcnt lgkmcnt(0)" ::: "memory"); __builtin_amdgcn_s_barrier(); asm volatile("" ::: "memory");
        const int row = wid * 32 + (lane & 31);
        if (lane < 32) { const f32x4 a = *(const LAS f32x4*)(P + row * 4);
            __hip_atomic_store(xbuf + ((size_t)(u.pm * BM + row) * 4 + u.pn), (a[0] + a[1]) + (a[2] + a[3]), __ATOMIC_RELAXED, __HIP_MEMORY_SCOPE_AGENT); }
        asm volatile("s_waitcnt vmcnt(0)" ::: "memory");
        if (lane == 0) __hip_atomic_fetch_add(cnt + 64 * u.pm, 1u, __ATOMIC_RELAXED, __HIP_MEMORY_SCOPE_AGENT);
        if (wid == 0) { unsigned sp = 0;
            while ((unsigned)__builtin_amdgcn_readfirstlane(__hip_atomic_load(cnt + 64 * u.pm, __ATOMIC_RELAXED, __HIP_MEMORY_SCOPE_AGENT)) < 32u) { __builtin_amdgcn_s_sleep(2); if (++sp > (1u << 22)) break; }
            __builtin_amdgcn_fence(__ATOMIC_ACQUIRE, "agent"); }
        asm volatile("s_waitcnt vmcnt(0) lgkmcnt(0)" ::: "memory"); __builtin_amdgcn_s_barrier(); asm volatile("" ::: "memory");
        if (lane < 32) { const float* slot = xbuf + (size_t)(u.pm * BM + row) * 4; float t = 0.f;
#pragma unroll
            for (int k = 0; k < 4; ++k) t += __hip_atomic_load(slot + k, __ATOMIC_RELAXED, __HIP_MEMORY_SCOPE_AGENT);
            S[row] = 1.0f / sqrtf(t * (1.0f / DM) + EPS); }
        asm volatile("s_waitcnt lgkmcnt(0)" ::: "memory"); __builtin_amdgcn_s_barrier(); asm volatile("" ::: "memory");
    }
};
struct EpiResidNormMod {
    static constexpr bool PERM = false, AFTER_DRAIN = true, APERM = false;
    const float* base; bf16_t* x1b; const float* mod; int gate_off, sh_off, sc_off; const float* g; bf16_t* hn; PanelSsq st;
    __device__ __forceinline__ void fused(f32x4 (&acc)[2][2][4][2], const Unit& u, int wr, int wc, int fr, int fq, LAS unsigned char* lds, int wid, int lane) const {
        const int row0 = u.pm * BM + wr * 64 + fr, col0 = u.pn * BM + wc * 32 + 4 * fq, b = u.pm >> 3;
        const float* modb = mod + (size_t)b * NMOD + col0;
        { f32x4 gv[2][2];
#pragma unroll
          for (int bj = 0; bj < 2; ++bj)
#pragma unroll
            for (int n = 0; n < 2; ++n) gv[bj][n] = *(const f32x4*)(modb + gate_off + bj * HALF + n * 16);
#pragma unroll
          for (int ai = 0; ai < 2; ++ai)
#pragma unroll
            for (int m = 0; m < 4; ++m) { const size_t off = (size_t)(row0 + ai * HALF + m * 16) * DM + col0;
#pragma unroll
                for (int bj = 0; bj < 2; ++bj)
#pragma unroll
                    for (int n = 0; n < 2; ++n) { const f32x4 xv = *(const f32x4*)(base + off + bj * HALF + n * 16); const f32x4 o = xv + gv[bj][n] * acc[ai][bj][m][n];
                        u32x2 w; w.x = cvt_pk_bf16(o[0], o[1]); w.y = cvt_pk_bf16(o[2], o[3]); *(u32x2*)(x1b + off + bj * HALF + n * 16) = w; acc[ai][bj][m][n] = o; }
                asm volatile("" ::: "memory"); } }
        st.run(acc, u, wr, wc, fr, fq, lds, wid, lane);
        const LAS float* S = (const LAS float*)(lds + 4096);
#pragma unroll
        for (int bj = 0; bj < 2; ++bj)
#pragma unroll
            for (int n = 0; n < 2; ++n) { const int co = bj * HALF + n * 16;
                const f32x4 gg = *(const f32x4*)(g + col0 + co), sh = *(const f32x4*)(modb + sh_off + co), sc = *(const f32x4*)(modb + sc_off + co);
                const f32x4 mul = gg * (1.0f + sc);
#pragma unroll
                for (int ai = 0; ai < 2; ++ai)
#pragma unroll
                    for (int m = 0; m < 4; ++m) { const int r = ai * HALF + wr * 64 + m * 16 + fr; const float rstd = S[r];
                        const f32x4 h = (acc[ai][bj][m][n] * rstd) * mul + sh;
                        u32x2 w; w.x = cvt_pk_bf16(h[0], h[1]); w.y = cvt_pk_bf16(h[2], h[3]);
                        *(u32x2*)(hn + (size_t)(u.pm * BM + r) * DM + col0 + co) = w; } }
    }
};
struct EpiResidNormOut {
    static constexpr bool PERM = false, AFTER_DRAIN = true, APERM = false;
    const bf16_t* x1b; float* out; const float* mod; int gate_off; const float* g; PanelSsq st;
    __device__ __forceinline__ void fused(f32x4 (&acc)[2][2][4][2], const Unit& u, int wr, int wc, int fr, int fq, LAS unsigned char* lds, int wid, int lane) const {
        const int row0 = u.pm * BM + wr * 64 + fr, col0 = u.pn * BM + wc * 32 + 4 * fq, b = u.pm >> 3;
        const float* modb = mod + (size_t)b * NMOD + col0;
        { f32x4 gv[2][2];
#pragma unroll
          for (int bj = 0; bj < 2; ++bj)
#pragma unroll
            for (int n = 0; n < 2; ++n) gv[bj][n] = *(const f32x4*)(modb + gate_off + bj * HALF + n * 16);
#pragma unroll
          for (int ai = 0; ai < 2; ++ai)
#pragma unroll
            for (int m = 0; m < 4; ++m) { const size_t off = (size_t)(row0 + ai * HALF + m * 16) * DM + col0;
#pragma unroll
                for (int bj = 0; bj < 2; ++bj)
#pragma unroll
                    for (int n = 0; n < 2; ++n) { const u32x2 xw = *(const u32x2*)(x1b + off + bj * HALF + n * 16); const f32x4 xv = (f32x4){bf_lo(xw.x), bf_hi(xw.x), bf_lo(xw.y), bf_hi(xw.y)};
                        acc[ai][bj][m][n] = xv + gv[bj][n] * acc[ai][bj][m][n]; }
                asm volatile("" : "+v"(acc[ai][0][m][0]), "+v"(acc[ai][0][m][1]), "+v"(acc[ai][1][m][0]), "+v"(acc[ai][1][m][1]));
                asm volatile("" ::: "memory"); } }
        st.run(acc, u, wr, wc, fr, fq, lds, wid, lane);
        const LAS float* S = (const LAS float*)(lds + 4096);
        f32x4 gg[2][2];
#pragma unroll
        for (int bj = 0; bj < 2; ++bj)
#pragma unroll
            for (int n = 0; n < 2; ++n) gg[bj][n] = *(const f32x4*)(g + col0 + bj * HALF + n * 16);
#pragma unroll
        for (int ai = 0; ai < 2; ++ai)
#pragma unroll
            for (int m = 0; m < 4; ++m) { const int r = ai * HALF + wr * 64 + m * 16 + fr; const float rstd = S[r]; float* rowp = out + (size_t)(u.pm * BM + r) * DM + col0;
#pragma unroll
                for (int bj = 0; bj < 2; ++bj)
#pragma unroll
                    for (int n = 0; n < 2; ++n) *(f32x4*)(rowp + bj * HALF + n * 16) = (acc[ai][bj][m][n] * rstd) * gg[bj][n];
                asm volatile("" ::: "memory"); }
    }
};
}

struct SchedP2 {
    const char *H, *HE, *HO, *WQK, *WA; char *QK, *VT, *VTA; float* SP; int G, c;
    __device__ __forceinline__ bool next(int i, pg8::Unit& u) const {
        const int L = i * G + c; if (L >= 512) return false;
        constexpr size_t tstep = (size_t)256 * DM * 2;
        u.sp = nullptr;
        if (L < 256) { int pm, pn; pg8::tile_map(L, 64, 4, pm, pn); u.pm = pm; u.pn = pn; u.pa = H + pm * tstep; u.pb = WQK + pn * tstep;
            const int b = pm >> 3, s0 = (pm & 7) * 256, head0 = (pn & 1) * 4;
            u.po = QK + (size_t)(pn >> 1) * (16u << 20) + ((size_t)((b * 8 + head0) * SEQ + s0) * 64) * 2; u.rp = 64; u.RS = 64 * 64; u.CS = SEQ * 64; }
        else if (L < 384) { int pm, pn; pg8::tile_map(L - 256, 2, 64, pm, pn); u.pm = 4 + pm; u.pn = pn; u.pa = WA + (size_t)(4 + pm) * tstep; u.pb = H + pn * tstep;
            const int b = pn >> 3;
            u.po = VTA + ((size_t)((b * 8 + 4 * pm) * 32 + 4 * (pn & 7)) * 4096) * 2; u.rp = 64; u.RS = 32 * 4096; u.CS = 4096; }
        else { const int which = (L - 384) >> 6; int pm, pn; pg8::tile_map((L - 384) & 63, 2, 32, pm, pn); u.pm = which * 2 + pm; u.pn = pn;
            u.pa = WA + (size_t)(which * 2 + pm) * tstep; u.pb = (which ? HO : HE) + pn * tstep;
            const int b = pn >> 2, st = pn & 3;
            u.po = VT + (size_t)which * (8u << 20) + ((size_t)(b * 512 + pm * 256) * 1024 + st * 256) * 2; u.rp = 1024; u.RS = 64 * 1024; u.CS = 64;
            if (!which) u.sp = SP + ((size_t)(b * 512 + pm * 256) * 32 + st * 4); }
        return true;
    }
};
struct SchedFourier {
    const char *CS, *VT; char* PQ; int G, c;
    __device__ __forceinline__ bool next(int i, pg8::Unit& u) const {
        const int L = i * G + c; if (L >= 128) return false;
        int pm, pn; pg8::tile_map(L, 8, 16, pm, pn); u.pm = pm; u.pn = pn;
        constexpr size_t tstep = (size_t)256 * 1024 * 2;
        u.pa = CS + pm * tstep; u.pb = VT + (size_t)(pm >> 2) * (8u << 20) + pn * tstep; u.po = PQ + ((size_t)pm * 256 * 4096 + pn * 256) * 2; u.rp = 4096; u.RS = 64 * 4096; u.CS = 64; u.sp = nullptr;
        return true;
    }
};
struct SchedPlain {
    const char *A, *B; int nM, nN, K, G, c;
    __device__ __forceinline__ bool next(int i, pg8::Unit& u) const {
        const int L = i * G + c; if (L >= nM * nN) return false;
        int pm, pn; pg8::tile_map(L, nM, nN, pm, pn); u.pm = pm; u.pn = pn;
        const size_t tstep = (size_t)256 * K * 2;
        u.pa = A + pm * tstep; u.pb = B + pn * tstep; u.po = nullptr; u.sp = nullptr; u.rp = 0; u.RS = 0; u.CS = 0;
        return true;
    }
};

__device__ __forceinline__ void p0_mod_item(const Params& p, LAS unsigned char* lds, int item) {
    LAS float* cs = (LAS float*)lds;
    LAS float* red = (LAS float*)(lds + 32768);
    const int tid = threadIdx.x;
    for (int u = tid; u < NBATCH * DM; u += NTHREADS) { const float v = p.c[u]; cs[u] = v / (1.0f + __expf(-v)); }
    __syncthreads();
    const int j0 = item * 64, l16 = tid & 15, rs = tid >> 4;
    f32x4 acc[8];
#pragma unroll
    for (int b = 0; b < 8; ++b) acc[b] = (f32x4){0.f, 0.f, 0.f, 0.f};
#pragma unroll 32
    for (int pass = 0; pass < 32; ++pass) { const int i = pass * 32 + rs; const f32x4 w = *(const f32x4*)(p.w_ada + (size_t)i * NMOD + j0 + 4 * l16);
#pragma unroll
        for (int b = 0; b < 8; ++b) acc[b] += cs[b * DM + i] * w; }
#pragma unroll
    for (int b = 0; b < 8; ++b) *(LAS f32x4*)(red + (rs * 8 + b) * 64 + 4 * l16) = acc[b];
    __syncthreads();
    { const int b = tid >> 6, col = tid & 63; float s = p.b_ada[j0 + col];
#pragma unroll 8
      for (int r = 0; r < 32; ++r) s += red[(r * 8 + b) * 64 + col];
      ((float*)(p.ws + WS_MOD))[(size_t)b * NMOD + j0 + col] = s; }
    asm volatile("s_waitcnt vmcnt(0)" ::: "memory");
    __syncthreads();
    if (tid == 0) {
        __builtin_amdgcn_fence(__ATOMIC_RELEASE, "agent");
        asm volatile("s_waitcnt vmcnt(0)" ::: "memory");
        __hip_atomic_fetch_add((unsigned*)(p.ws + WS_BAR) + 3712, 1u, __ATOMIC_RELAXED, __HIP_MEMORY_SCOPE_AGENT);
    }
}
typedef float f32x16 __attribute__((ext_vector_type(16)));
__device__ __forceinline__ void p0_fold_item(const Params& p, LAS unsigned char* lds, int item) {
    LAS float* Wf = (LAS float*)lds;
    LAS float* Gm = (LAS float*)(lds + 65536);
    LAS float* wt = (LAS float*)(lds + 131072);
    const int tid = threadIdx.x, lane = tid & 63, w = tid >> 6, which = item >> 6, g = (item >> 4) & 3, ib = (item & 15) * 64;
    for (int u = tid; u < 4096; u += NTHREADS) *(LAS f32x4*)(Wf + 4 * u) = *(const f32x4*)(p.w_four + (size_t)g * 16384 + 4 * u);
    __syncthreads();
    {
        const int mt = w >> 1, nt0 = (w & 1) * 2, li = lane & 31, lk = lane >> 5, c = mt * 32 + li;
        f32x16 acc0, acc1;
#pragma unroll
        for (int r = 0; r < 16; ++r) { acc0[r] = 0.f; acc1[r] = 0.f; }
#pragma unroll 4
        for (int ks = 0; ks < 64; ++ks) { const int e = 2 * ks + lk; const float ang = (float)((c * e) & 127) * (1.0f / 128.0f);
            const float a = (which ? __builtin_amdgcn_sinf(ang) : __builtin_amdgcn_cosf(ang)) * 0.08838834764831845f;
            const float b0 = Wf[e * 128 + nt0 * 32 + li], b1 = Wf[e * 128 + nt0 * 32 + 32 + li];
            acc0 = __builtin_amdgcn_mfma_f32_32x32x2f32(a, b0, acc0, 0, 0, 0); acc1 = __builtin_amdgcn_mfma_f32_32x32x2f32(a, b1, acc1, 0, 0, 0); }
#pragma unroll
        for (int r = 0; r < 16; ++r) { const int row = mt * 32 + (r & 3) + 8 * (r >> 2) + 4 * lk; Gm[row * 128 + nt0 * 32 + li] = acc0[r]; Gm[row * 128 + nt0 * 32 + 32 + li] = acc1[r]; }
    }
    for (int sub = 0; sub < 2; ++sub) { const int i0 = ib + sub * 32;
    for (int u = tid; u < 4096; u += NTHREADS) { const int il = u >> 7, c = u & 127; wt[il * 129 + c] = p.w_in[(size_t)(i0 + il) * 2048 + g * 128 + c]; }
    __syncthreads();
    {
        const int li = lane & 15, lk = lane >> 4;
        f32x4 acc0 = (f32x4){0.f, 0.f, 0.f, 0.f}, acc1 = (f32x4){0.f, 0.f, 0.f, 0.f};
#pragma unroll 4
        for (int ks = 0; ks < 32; ++ks) { const int c = 4 * ks + lk; const float a = Gm[c * 128 + 16 * w + li], b0 = wt[li * 129 + c], b1 = wt[(16 + li) * 129 + c];
            acc0 = __builtin_amdgcn_mfma_f32_16x16x4f32(a, b0, acc0, 0, 0, 0); acc1 = __builtin_amdgcn_mfma_f32_16x16x4f32(a, b1, acc1, 0, 0, 0); }
        bf16_t* WA = (bf16_t*)(p.ws + WS_WA);
#pragma unroll
        for (int r = 0; r < 4; ++r) { const int d = 16 * w + lk * 4 + r; bf16_t* rowp = WA + (size_t)(which * 512 + g * 128 + d) * DM + i0;
            rowp[li] = (bf16_t)(cvt_pk_bf16(acc0[r], 0.f) & 0xffffu); rowp[16 + li] = (bf16_t)(cvt_pk_bf16(acc1[r], 0.f) & 0xffffu); }
    }
    __syncthreads();
    }
}
__device__ __forceinline__ void p0_transpose_item(const float* W, int ldw, int ncol0, int K, bf16_t* WT, int orow, const float* gk, LAS float* scr, int kb, int lane) {
    const int k0 = 64 * kb;
    float v[32];
#pragma unroll
    for (int i = 0; i < 32; ++i) v[i] = W[(size_t)(k0 + 2 * i + (lane >> 5)) * ldw + ncol0 + (lane & 31)];
    if (gk) {
#pragma unroll
        for (int i = 0; i < 32; ++i) v[i] *= gk[k0 + 2 * i + (lane >> 5)]; }
#pragma unroll
    for (int i = 0; i < 32; ++i) scr[(2 * i + (lane >> 5)) * 33 + (lane & 31)] = v[i];
    asm volatile("s_waitcnt lgkmcnt(0)" ::: "memory");
    const int c = lane & 7;
#pragma unroll
    for (int j = 0; j < 4; ++j) { const int n = (lane >> 3) + 8 * j; const LAS float* s = scr + (8 * c) * 33 + n;
        u32x4 o; o.x = cvt_pk_bf16(s[0 * 33], s[1 * 33]); o.y = cvt_pk_bf16(s[2 * 33], s[3 * 33]); o.z = cvt_pk_bf16(s[4 * 33], s[5 * 33]); o.w = cvt_pk_bf16(s[6 * 33], s[7 * 33]);
        *(u32x4*)(WT + (size_t)(orow + n) * K + k0 + 8 * c) = o; }
    asm volatile("s_waitcnt lgkmcnt(0)" ::: "memory");
}
__device__ __forceinline__ void p0_prologue(const Params& p, LAS unsigned char* lds) {
    const int tid = threadIdx.x, lane = tid & 63, wave = tid >> 6, G = gridDim.x;
    if (G == 256) {
        if (blockIdx.x < 128) p0_fold_item(p, lds, blockIdx.x); else if (blockIdx.x < 224) p0_mod_item(p, lds, blockIdx.x - 128);
    } else { for (int it = blockIdx.x; it < 96; it += G) p0_mod_item(p, lds, it);
        for (int it = blockIdx.x; it < 128; it += G) p0_fold_item(p, lds, it); }
    LAS float* scr = (LAS float*)(lds + wave * 16384);
    const int gw = blockIdx.x * NWAVES + wave, NGW = G * NWAVES;
    constexpr int I_QK = 16 * 32, I_V = 16 * 16;
    for (int it = gw; it < I_QK + I_V; it += NGW) {
        int r = it;
        if (r < I_QK) { const int kb = r >> 5, nb = r & 31; p0_transpose_item(p.w_in, 2048, 512 + nb * 32, DM, (bf16_t*)(p.ws + WS_WQK), nb * 32, nullptr, scr, kb, lane); continue; } r -= I_QK;
        { const int kb = r >> 4, nb = r & 15; p0_transpose_item(p.w_in, 2048, 1536 + nb * 32, DM, (bf16_t*)(p.ws + WS_WA), 1024 + nb * 32, nullptr, scr, kb, lane); }
    }
}
__device__ __forceinline__ void late_work(const Params& p, LAS unsigned char* lds, int hidx, int nh, int what) {
    const int tid = threadIdx.x, lane = tid & 63, wave = tid >> 6;
    LAS float* scr = (LAS float*)(lds + wave * 16384);
    const int gw = hidx * NWAVES + wave, NGW = nh * NWAVES;
    constexpr int I_O = 16 * 32, I_UP = 16 * 176, I_DN = 44 * 32;
    const int it_lo = (what & 1) ? 0 : I_O + I_UP, it_hi = (what & 2) ? I_O + I_UP + I_DN : ((what & 1) ? I_O + I_UP : it_lo);
    for (int it = it_lo + gw; it < it_hi; it += NGW) {
        int r = it;
        if (r < I_O) { const int kb = r >> 5, nb = r & 31; p0_transpose_item(p.w_out, DM, nb * 32, DM, (bf16_t*)(p.ws + WS_WOUT), nb * 32, kb < 8 ? p.g_four_out : p.g_na_out - 512, scr, kb, lane); continue; } r -= I_O;
        if (r < I_UP) { const int kb = r / 176, nb = r % 176; const int n0 = nb * 32; const int isv = n0 >= DFF, j = isv ? n0 - DFF : n0;
            p0_transpose_item(p.w_up, 2 * DFF, n0, DM, (bf16_t*)(p.ws + WS_WUP), (j >> 7) * 256 + isv * 128 + (j & 127), nullptr, scr, kb, lane); continue; } r -= I_UP;
        { const int kb = r >> 5, nb = r & 31; p0_transpose_item(p.w_down, DM, nb * 32, DFF, (bf16_t*)(p.ws + WS_WDN), nb * 32, nullptr, scr, kb, lane); }
    }
    bf16_t* CS = (bf16_t*)(p.ws + WS_CS);
    if (what & 4) for (int u = hidx * NTHREADS + tid; u < 2048 * 128; u += nh * NTHREADS) { const int kp = u >> 7, s0 = (u & 127) * 8, k = kp & 1023; float v[8];
#pragma unroll
        for (int j = 0; j < 8; ++j) { const float ang = (float)((k * (s0 + j)) & 2047) * (1.0f / 2048.0f); v[j] = (kp >= 1024 ? __builtin_amdgcn_sinf(ang) : __builtin_amdgcn_cosf(ang)) * 0.022097086912079608f; }
        u32x4 o; o.x = cvt_pk_bf16(v[0], v[1]); o.y = cvt_pk_bf16(v[2], v[3]); o.z = cvt_pk_bf16(v[4], v[5]); o.w = cvt_pk_bf16(v[6], v[7]);
        *(u32x4*)(CS + (size_t)kp * 1024 + s0) = o; }
}

__device__ __forceinline__ void pass_norm_mod(const float* src, const float* ssq, const float* g, const float* mod, int sh_off, int sc_off, bf16_t* dst) {
    constexpr int RW = 4;
    const int lane = threadIdx.x & 63, gw = blockIdx.x * NWAVES + (threadIdx.x >> 6), NGW = gridDim.x * NWAVES;
    if (!ssq && NGW == 2048) {
        const int rowb = gw * 8, b = rowb >> 11;
        f32x4 mul[4], sh[4];
#pragma unroll
        for (int j = 0; j < 4; ++j) { const f32x4 gg = ((const f32x4*)g)[lane + 64 * j], sc = ((const f32x4*)(mod + (size_t)b * NMOD + sc_off))[lane + 64 * j];
            mul[j] = gg * (1.0f + sc); sh[j] = ((const f32x4*)(mod + (size_t)b * NMOD + sh_off))[lane + 64 * j]; }
#pragma unroll
        for (int half = 0; half < 2; ++half) {
            f32x4 v[RW][4];
#pragma unroll
            for (int q = 0; q < RW; ++q) { const f32x4* xr = (const f32x4*)(src + (size_t)(rowb + half * RW + q) * DM) + lane;
#pragma unroll
                for (int j = 0; j < 4; ++j) v[q][j] = xr[64 * j]; }
#pragma unroll
            for (int q = 0; q < RW; ++q) { float t = 0.f;
#pragma unroll
                for (int j = 0; j < 4; ++j) t += (v[q][j][0] * v[q][j][0] + v[q][j][1] * v[q][j][1]) + (v[q][j][2] * v[q][j][2] + v[q][j][3] * v[q][j][3]);
                t = wave_sum(t); const float rstd = 1.0f / sqrtf(t * (1.0f / DM) + EPS);
                u32x2* o8 = (u32x2*)(dst + (size_t)(rowb + half * RW + q) * DM) + lane;
#pragma unroll
                for (int j = 0; j < 4; ++j) { const f32x4 h = (v[q][j] * rstd) * mul[j] + sh[j]; u32x2 w; w.x = cvt_pk_bf16(h[0], h[1]); w.y = cvt_pk_bf16(h[2], h[3]); o8[64 * j] = w; } }
        }
        return;
    }
    for (int row0 = gw; row0 < NTOK; row0 += RW * NGW) {
        f32x4 v[RW][4]; float s[RW];
#pragma unroll
        for (int q = 0; q < RW; ++q) { const int row = min(row0 + q * NGW, NTOK - 1); const f32x4* xr = (const f32x4*)(src + (size_t)row * DM) + lane;
#pragma unroll
            for (int j = 0; j < 4; ++j) v[q][j] = xr[64 * j]; }
#pragma unroll
        for (int q = 0; q < RW; ++q) { const int row = min(row0 + q * NGW, NTOK - 1); float t = 0.f;
#pragma unroll
            for (int j = 0; j < 4; ++j) t += (v[q][j][0] * v[q][j][0] + v[q][j][1] * v[q][j][1]) + (v[q][j][2] * v[q][j][2] + v[q][j][3] * v[q][j][3]);
            if (ssq) { t = ssq[(size_t)row * 16 + (lane & 15)]; t += __shfl_xor(t, 1); t += __shfl_xor(t, 2); t += __shfl_xor(t, 4); t += __shfl_xor(t, 8); }
            else t = wave_sum(t);
            s[q] = 1.0f / sqrtf(t * (1.0f / DM) + EPS); }
#pragma unroll
        for (int q = 0; q < RW; ++q) { const int row = row0 + q * NGW; if (row < NTOK) { const int b = row >> 11;
            const f32x4* g4 = (const f32x4*)g + lane; const f32x4* sh4 = (const f32x4*)(mod + (size_t)b * NMOD + sh_off) + lane; const f32x4* sc4 = (const f32x4*)(mod + (size_t)b * NMOD + sc_off) + lane;
            u32x2* o8 = (u32x2*)(dst + (size_t)row * DM) + lane;
#pragma unroll
            for (int j = 0; j < 4; ++j) { const f32x4 gg = g4[64 * j], sh = sh4[64 * j], sc = sc4[64 * j]; const f32x4 h = (v[q][j] * s[q] * gg) * (1.0f + sc) + sh;
                u32x2 w; w.x = cvt_pk_bf16(h[0], h[1]); w.y = cvt_pk_bf16(h[2], h[3]); o8[64 * j] = w; } } }
    }
}
__device__ __forceinline__ void pass_h_fold(const float* src, const float* g, const float* mod, bf16_t* H, bf16_t* HE, bf16_t* HO) {
    const int vb = (gridDim.x & 7) ? (int)blockIdx.x : (int)((blockIdx.x & 7) * (gridDim.x >> 3) + (blockIdx.x >> 3));
    const int lane = threadIdx.x & 63, gw = vb * NWAVES + (threadIdx.x >> 6), NGW = gridDim.x * NWAVES;
    for (int ch = gw; ch < 2048; ch += NGW) {
        const int b = ch >> 8, sb = (ch & 255) * 4;
        f32x4 mul[4], sh[4];
#pragma unroll
        for (int j = 0; j < 4; ++j) { const f32x4 gg = ((const f32x4*)g)[lane + 64 * j], sc = ((const f32x4*)(mod + (size_t)b * NMOD + DM))[lane + 64 * j];
            mul[j] = gg * (1.0f + sc); sh[j] = ((const f32x4*)(mod + (size_t)b * NMOD))[lane + 64 * j]; }
#pragma unroll
        for (int half = 0; half < 2; ++half) {
            f32x4 v[2][2][4];
#pragma unroll
            for (int q = 0; q < 2; ++q) { const int s = sb + half * 2 + q, pr = (s == 0) ? SEQ / 2 : SEQ - s;
                const f32x4* x0 = (const f32x4*)(src + (size_t)(b * SEQ + s) * DM) + lane; const f32x4* x1 = (const f32x4*)(src + (size_t)(b * SEQ + pr) * DM) + lane;
#pragma unroll
                for (int j = 0; j < 4; ++j) { v[q][0][j] = x0[64 * j]; v[q][1][j] = x1[64 * j]; } }
#pragma unroll
            for (int q = 0; q < 2; ++q) { const int s = sb + half * 2 + q, pr = (s == 0) ? SEQ / 2 : SEQ - s;
                float t0 = 0.f, t1 = 0.f;
#pragma unroll
                for (int j = 0; j < 4; ++j) { const f32x4 a = v[q][0][j], c = v[q][1][j]; t0 += (a[0] * a[0] + a[1] * a[1]) + (a[2] * a[2] + a[3] * a[3]); t1 += (c[0] * c[0] + c[1] * c[1]) + (c[2] * c[2] + c[3] * c[3]); }
                t0 = wave_sum(t0); t1 = wave_sum(t1);
                const float r0 = 1.0f / sqrtf(t0 * (1.0f / DM) + EPS), r1 = 1.0f / sqrtf(t1 * (1.0f / DM) + EPS);
                u32x2* o0 = (u32x2*)(H + (size_t)(b * SEQ + s) * DM) + lane; u32x2* o1 = (u32x2*)(H + (size_t)(b * SEQ + pr) * DM) + lane;
                u32x2* oe = (u32x2*)(HE + (size_t)(b * 1024 + s) * DM) + lane; u32x2* oo = (u32x2*)(HO + (size_t)(b * 1024 + s) * DM) + lane;
#pragma unroll
                for (int j = 0; j < 4; ++j) { const f32x4 h0 = (v[q][0][j] * r0) * mul[j] + sh[j], h1 = (v[q][1][j] * r1) * mul[j] + sh[j];
                    u32x2 w; w.x = cvt_pk_bf16(h0[0], h0[1]); w.y = cvt_pk_bf16(h0[2], h0[3]); o0[64 * j] = w;
                    w.x = cvt_pk_bf16(h1[0], h1[1]); w.y = cvt_pk_bf16(h1[2], h1[3]); o1[64 * j] = w;
                    const f32x4 e = (s == 0) ? h0 : h0 + h1, o = (s == 0) ? (f32x4){0.f, 0.f, 0.f, 0.f} : h0 - h1;
                    w.x = cvt_pk_bf16(e[0], e[1]); w.y = cvt_pk_bf16(e[2], e[3]); oe[64 * j] = w;
                    w.x = cvt_pk_bf16(o[0], o[1]); w.y = cvt_pk_bf16(o[2], o[3]); oo[64 * j] = w; } }
        }
    }
}
__device__ __forceinline__ void pass_xmid(const bf16_t* H, const bf16_t* WA, float* X) {
    const int lane = threadIdx.x & 63, gw = blockIdx.x * NWAVES + (threadIdx.x >> 6), NGW = gridDim.x * NWAVES;
    for (int t = gw; t < NBATCH * 512; t += NGW) { const int b = t >> 9, c = t & 511;
        const u32x4* hp = (const u32x4*)(H + (size_t)(b * SEQ + SEQ / 2) * DM) + lane * 2; const u32x4* wp = (const u32x4*)(WA + (size_t)c * DM) + lane * 2;
        float s = 0.f;
#pragma unroll
        for (int q = 0; q < 2; ++q) { const u32x4 hv = hp[q], wv = wp[q];
#pragma unroll
            for (int j = 0; j < 4; ++j) s += bf_lo(hv[j]) * bf_lo(wv[j]) + bf_hi(hv[j]) * bf_hi(wv[j]); }
        s = wave_sum(s);
        if (lane == 0) X[t] = s; }
}
__device__ __forceinline__ void pass_final(float* xo, const float* ssq, const float* g) {
    const int lane = threadIdx.x & 63, gw = blockIdx.x * NWAVES + (threadIdx.x >> 6), NGW = gridDim.x * NWAVES;
    for (int row = gw; row < NTOK; row += NGW) {
        f32x4* xr = (f32x4*)(xo + (size_t)row * DM) + lane;
        float s = ssq[(size_t)row * 16 + (lane & 15)]; s += __shfl_xor(s, 1); s += __shfl_xor(s, 2); s += __shfl_xor(s, 4); s += __shfl_xor(s, 8);
        const float rstd = 1.0f / sqrtf(s * (1.0f / DM) + EPS);
        const f32x4* g4 = (const f32x4*)g + lane;
#pragma unroll
        for (int j = 0; j < 4; ++j) { const f32x4 v = xr[64 * j]; xr[64 * j] = v * rstd * g4[64 * j]; }
    }
}
__device__ __forceinline__ void combine_row(int row, const float (&y)[8], const float* SSQNA, bf16_t* YCAT, int lane) {
    float s = 0.f;
#pragma unroll
    for (int j = 0; j < 8; ++j) s += y[j] * y[j];
    s = wave_sum(s);
    const float rstd = 1.0f / sqrtf(s * (1.0f / 512.0f) + EPS);
    u32x4 o; o.x = cvt_pk_bf16(y[0] * rstd, y[1] * rstd); o.y = cvt_pk_bf16(y[2] * rstd, y[3] * rstd); o.z = cvt_pk_bf16(y[4] * rstd, y[5] * rstd); o.w = cvt_pk_bf16(y[6] * rstd, y[7] * rstd);
    *(u32x4*)(YCAT + (size_t)row * DM + lane * 8) = o;
    float t = SSQNA[(size_t)row * 8 + (lane & 7)]; t += __shfl_xor(t, 1); t += __shfl_xor(t, 2); t += __shfl_xor(t, 4);
    const float rn = 1.0f / sqrtf(t * (1.0f / 512.0f) + EPS);
    u32x4* ap = (u32x4*)(YCAT + (size_t)row * DM + 512 + lane * 8); const u32x4 aw = *ap; u32x4 ow;
#pragma unroll
    for (int j = 0; j < 4; ++j) ow[j] = cvt_pk_bf16(bf_lo(aw[j]) * rn, bf_hi(aw[j]) * rn);
    *ap = ow;
}
__device__ __forceinline__ void pass_combine(const bf16_t* PQ, const float* SP, const float* XM, const float* SSQNA, bf16_t* YCAT) {
    const int vb = (gridDim.x & 7) ? (int)blockIdx.x : (int)((blockIdx.x & 7) * (gridDim.x >> 3) + (blockIdx.x >> 3));
    const int lane = threadIdx.x & 63, gw = vb * NWAVES + (threadIdx.x >> 6), NGW = gridDim.x * NWAVES;
    for (int pi0 = gw; pi0 < NBATCH * 1024; pi0 += NGW) {
        const int pi = (NGW == 2048) ? gw * 4 + (pi0 - gw) / NGW : pi0;
        const int b = pi >> 10, kk = pi & 1023;
        const u32x4 pw = *(const u32x4*)(PQ + (size_t)kk * 4096 + b * 512 + lane * 8), qw = *(const u32x4*)(PQ + (size_t)(1024 + kk) * 4096 + b * 512 + lane * 8);
        float y1[8], y2[8];
        const f32x4 xa = *(const f32x4*)(XM + b * 512 + lane * 8), xb = *(const f32x4*)(XM + b * 512 + lane * 8 + 4); const float xs = (kk & 1) ? -0.022097086912079608f : 0.022097086912079608f;
        const float xm[8] = {xa[0] * xs, xa[1] * xs, xa[2] * xs, xa[3] * xs, xb[0] * xs, xb[1] * xs, xb[2] * xs, xb[3] * xs};
#pragma unroll
        for (int j = 0; j < 4; ++j) { const float pl = bf_lo(pw[j]) + xm[2 * j], ph = bf_hi(pw[j]) + xm[2 * j + 1], ql = bf_lo(qw[j]), qh = bf_hi(qw[j]); y1[2 * j] = pl - ql; y1[2 * j + 1] = ph - qh; y2[2 * j] = pl + ql; y2[2 * j + 1] = ph + qh; }
        if (kk == 0) {
#pragma unroll
            for (int j = 0; j < 8; ++j) { const f32x4* sp = (const f32x4*)(SP + (size_t)(b * 512 + lane * 8 + j) * 32); f32x4 a = sp[0];
#pragma unroll
                for (int i = 1; i < 4; ++i) a += sp[i];
                y2[j] = ((a[0] + a[1]) + (a[2] + a[3])) * 0.022097086912079608f + xm[j]; }
        }
        combine_row(b * SEQ + kk, y1, SSQNA, YCAT, lane);
        combine_row(b * SEQ + (kk == 0 ? 1024 : SEQ - kk), y2, SSQNA, YCAT, lane);
    }
}
__device__ __forceinline__ void pass_fixup(const bf16_t* side, const float* cw, const float* cb, bf16_t* A, int ri0, int nri, int widx, int nw) {
    const int total = nri * (DFF / 4);
    for (int u = widx * NTHREADS + threadIdx.x; u < total; u += nw * NTHREADS) {
        const int ri = ri0 + u / (DFF / 4), J = (u % (DFF / 4)) * 4, chunk = ri >> 1, bot = ri & 1;
        const bf16_t* sc = side + (size_t)chunk * 4 * (2 * DFF);
        const bf16_t *pp, *pc, *pn; bool hp = true, hn = true; int tok;
        if (!bot) { hp = (chunk & 15) != 0; pp = sc - (2 * DFF); pc = sc; pn = sc + (2 * DFF); tok = chunk * 128; }
        else { hn = (chunk & 15) != 15; pp = sc + 2 * (2 * DFF); pc = sc + 3 * (2 * DFF); pn = sc + 4 * (2 * DFF); tok = chunk * 128 + 127; }
        float up[2][4];
#pragma unroll
        for (int bj = 0; bj < 2; ++bj) {
            const int col = bj * DFF + J;
            u32x2 wp = (u32x2){0u, 0u}, wn = (u32x2){0u, 0u}; if (hp) wp = *(const u32x2*)(pp + col); if (hn) wn = *(const u32x2*)(pn + col); const u32x2 wc2 = *(const u32x2*)(pc + col);
            const f32x4 k0 = *(const f32x4*)(cw + col), k1 = *(const f32x4*)(cw + 2 * DFF + col), k2 = *(const f32x4*)(cw + 4 * DFF + col), kb = *(const f32x4*)(cb + col);
            const float pv[4] = {bf_lo(wp.x), bf_hi(wp.x), bf_lo(wp.y), bf_hi(wp.y)}, cv[4] = {bf_lo(wc2.x), bf_hi(wc2.x), bf_lo(wc2.y), bf_hi(wc2.y)}, nv[4] = {bf_lo(wn.x), bf_hi(wn.x), bf_lo(wn.y), bf_hi(wn.y)};
#pragma unroll
            for (int j = 0; j < 4; ++j) up[bj][j] = k0[j] * pv[j] + k1[j] * cv[j] + k2[j] * nv[j] + kb[j];
        }
        u32x2 w; w.x = cvt_pk_bf16(silu_f(up[0][0]) * up[1][0], silu_f(up[0][1]) * up[1][1]); w.y = cvt_pk_bf16(silu_f(up[0][2]) * up[1][2], silu_f(up[0][3]) * up[1][3]);
        *(u32x2*)(A + (size_t)tok * DFF + J) = w;
    }
}

__device__ __forceinline__ void attn_phase(const Params& p, LAS unsigned char* lds) {
    const int tid = threadIdx.x, lane = tid & 63, w = __builtin_amdgcn_readfirstlane(tid >> 6), fr = lane & 15, fq = lane >> 4;
    LAS unsigned char* Ks = lds;
    LAS unsigned char* Vs = lds + 73728;
    LAS float* rp = (LAS float*)(lds + 147456);
    volatile LAS unsigned* slot = (volatile LAS unsigned*)(lds + 147456 + 2048);
    const bf16_t* QH = (const bf16_t*)(p.ws + WS_QK); const bf16_t* KH = (const bf16_t*)(p.ws + WS_QK + (16u << 20)); const bf16_t* VTA = (const bf16_t*)(p.ws + WS_VTA);
    bf16_t* YCAT = (bf16_t*)(p.ws + WS_YCAT); float* SSQNA = (float*)(p.ws + WS_SSQ1 + 512 * 1024);
    const float sc2 = 0.125f * 1.4426950408889634f;
    unsigned* ctr = (unsigned*)(p.ws + WS_BAR) + 3584;
    const int ri = w >> 2, qb = w & 3, q0 = qb * 16, kc0 = min(max(q0 - 8, 0), 32);
    const int kperm = 8 * (fr >> 2) + (fr & 3);
    for (;;) {
        __syncthreads();
        if (tid == 0) slot[0] = __hip_atomic_fetch_add(ctr, 1u, __ATOMIC_RELAXED, __HIP_MEMORY_SCOPE_AGENT);
        __syncthreads();
        const int item = (int)slot[0];
        if (item >= 1024) break;
        const int b = item >> 7, h = (item >> 4) & 7, r0 = (item & 15) * 2, R0 = min(max(r0 - 4, 0), 24);
        const int r = r0 + ri, rs = min(max(r - 4, 0), 24), j0 = rs - R0;
        const int tq = b * SEQ + r * 64 + q0 + fr;
        const bf16_t* qp = QH + ((size_t)(b * 8 + h) * SEQ + r * 64 + q0 + fr) * 64 + fq * 8;
        const bf16x8 qf0 = *(const bf16x8*)qp, qf1 = *(const bf16x8*)(qp + 32);
        for (int u = tid; u < 465; u += NTHREADS) rp[u] = p.rpb[h * 465 + u] * 1.4426950408889634f;
        { const int t = tid >> 3, c = tid & 7; const unsigned dstk = (unsigned)(t * 128 + ((c ^ (((t >> 1) & 1) | (((t >> 3) & 3) << 1))) << 4)), dstv = (unsigned)(t * 128 + ((c ^ ((t >> 1) & 7)) << 4));
          u32x4 kv[9], vv[9];
#pragma unroll
          for (int j = 0; j < 9; ++j) { const int srow = min(R0 + j, 31);
              kv[j] = *(const u32x4*)(KH + ((size_t)(b * 8 + h) * SEQ + srow * 64 + t) * 64 + c * 8);
              vv[j] = *(const u32x4*)(VTA + ((size_t)((b * 8 + h) * 32 + srow) * 64 + t) * 64 + c * 8); }
#pragma unroll
          for (int j = 0; j < 9; ++j) { *(LAS u32x4*)(Ks + j * 8192 + dstk) = kv[j]; *(LAS u32x4*)(Vs + j * 8192 + dstv) = vv[j]; } }
        __syncthreads();
        f32x4 s[8][2];
#pragma unroll
        for (int i = 0; i < 8; ++i)
#pragma unroll
            for (int t = 0; t < 2; ++t) { const int tok = kc0 + kperm + 4 * t; const LAS unsigned char* kr = Ks + (j0 + i) * 8192 + tok * 128;
                const int fk = ((tok >> 1) & 1) | (((tok >> 3) & 3) << 1);
                const bf16x8 k0 = *(const LAS bf16x8*)(kr + ((fq ^ fk) << 4)), k1 = *(const LAS bf16x8*)(kr + (((4 + fq) ^ fk) << 4));
                f32x4 a = (f32x4){0.f, 0.f, 0.f, 0.f};
                a = __builtin_amdgcn_mfma_f32_16x16x32_bf16(k0, qf0, a, 0, 0, 0); a = __builtin_amdgcn_mfma_f32_16x16x32_bf16(k1, qf1, a, 0, 0, 0); s[i][t] = a; }
        const int qc = q0 + fr, cs0 = min(max(qc - 8, 0), 48);
        float madd[2][4]; int dco[2][4];
#pragma unroll
        for (int t = 0; t < 2; ++t)
#pragma unroll
            for (int j = 0; j < 4; ++j) { const int kc = kc0 + 8 * fq + 4 * t + j; madd[t][j] = ((kc >= cs0) && (kc < cs0 + 16)) ? 0.f : -1e30f; dco[t][j] = min(max(kc - qc, -15), 15); }
        float mx = -1e30f;
#pragma unroll
        for (int i = 0; i < 8; ++i) { const int dr = rs + i - r; const LAS float* rrow = rp + (dr + 7) * 31 + 15;
#pragma unroll
            for (int t = 0; t < 2; ++t)
#pragma unroll
                for (int j = 0; j < 4; ++j) { const float v = (s[i][t][j] * sc2 + rrow[dco[t][j]]) + madd[t][j]; s[i][t][j] = v; mx = fmaxf(mx, v); } }
        mx = fmaxf(mx, __shfl_xor(mx, 16)); mx = fmaxf(mx, __shfl_xor(mx, 32));
        float sum = 0.f;
#pragma unroll
        for (int i = 0; i < 8; ++i)
#pragma unroll
            for (int t = 0; t < 2; ++t)
#pragma unroll
                for (int j = 0; j < 4; ++j) { const float e = __builtin_amdgcn_exp2f(s[i][t][j] - mx); s[i][t][j] = e; sum += e; }
        sum += __shfl_xor(sum, 16); sum += __shfl_xor(sum, 32);
        const float inv = 1.0f / sum;
        f32x4 o[4];
#pragma unroll
        for (int nb = 0; nb < 4; ++nb) o[nb] = (f32x4){0.f, 0.f, 0.f, 0.f};
        const int vc = (kc0 >> 3) + fq;
#pragma unroll
        for (int i = 0; i < 8; ++i) {
            u32x4 pw; pw.x = cvt_pk_bf16(s[i][0][0], s[i][0][1]); pw.y = cvt_pk_bf16(s[i][0][2], s[i][0][3]); pw.z = cvt_pk_bf16(s[i][1][0], s[i][1][1]); pw.w = cvt_pk_bf16(s[i][1][2], s[i][1][3]);
            const bf16x8 pf = __builtin_bit_cast(bf16x8, pw);
#pragma unroll
            for (int nb = 0; nb < 4; ++nb) { const int d = nb * 16 + fr; const bf16x8 va = *(const LAS bf16x8*)(Vs + (j0 + i) * 8192 + d * 128 + ((vc ^ ((d >> 1) & 7)) << 4));
                o[nb] = __builtin_amdgcn_mfma_f32_16x16x32_bf16(va, pf, o[nb], 0, 0, 0); } }
        float q2 = 0.f;
#pragma unroll
        for (int nb = 0; nb < 4; ++nb) { o[nb] = o[nb] * inv; q2 += (o[nb][0] * o[nb][0] + o[nb][1] * o[nb][1]) + (o[nb][2] * o[nb][2] + o[nb][3] * o[nb][3]); }
        q2 += __shfl_xor(q2, 16); q2 += __shfl_xor(q2, 32);
        if (fq == 0) SSQNA[(size_t)tq * 8 + h] = q2;
        bf16_t* op = YCAT + (size_t)tq * DM + 512 + h * 64 + 4 * fq;
#pragma unroll
        for (int nb = 0; nb < 4; ++nb) { u32x2 wv; wv.x = cvt_pk_bf16(o[nb][0], o[nb][1]); wv.y = cvt_pk_bf16(o[nb][2], o[nb][3]); *(u32x2*)(op + nb * 16) = wv; }
    }
    __syncthreads();
}

constexpr int N_PHASES = 11;
__global__ void __launch_bounds__(NTHREADS, 2) fwd_megakernel(Params p) {
    extern __shared__ __attribute__((aligned(16))) unsigned char lds_raw[];
    LAS unsigned char* lds = (LAS unsigned char*)lds_raw;
    volatile LAS unsigned* bst = (volatile LAS unsigned*)(lds + LDS_BYTES - 16);
    const int lo = p.ph_lo, hi = p.ph_hi, G = gridDim.x, cid = blockIdx.x;
    if (threadIdx.x < 4) bst[threadIdx.x] = 0u;
    __syncthreads();
    XcdBarrier bar; bar.bar = (unsigned*)(p.ws + WS_BAR); bar.x = 0; bar.st = bst; bar.G = gridDim.x;
    if (!MK_PER_PHASE) bar = xcd_barrier_post((unsigned*)(p.ws + WS_BAR), bst, gridDim.x);
    XcdBarrier gbar; gbar.bar = (unsigned*)(p.ws + WS_BAR + 65536 + 16384 * (blockIdx.x & 7)); gbar.x = 0; gbar.st = bst + 2; gbar.G = gridDim.x >> 3;
    if (!MK_PER_PHASE && gridDim.x == 256) gbar = xcd_barrier_post(gbar.bar, bst + 2, gridDim.x >> 3);
    if (lo < 0) cg::this_grid().sync();
#define IN(k) (lo <= (k) && (k) < hi)
#define REP(k) for (int rep_ = 0; rep_ < 1 + ((REPEAT_MASK >> (k)) & 1); ++rep_)
#define SEAM(k) do { if (IN(k) && IN((k) + 1)) xcd_barrier(bar); } while (0)
    unsigned char* ws = p.ws;
    const float* mod = (const float*)(ws + WS_MOD);

    if (IN(0)) REP(0) p0_prologue(p, lds);
    if (IN(0) && IN(1)) {
        if (threadIdx.x < 64) { unsigned sp = 0; unsigned* mc = (unsigned*)(ws + WS_BAR) + 3712;
            while ((unsigned)__builtin_amdgcn_readfirstlane(__hip_atomic_load(mc, __ATOMIC_RELAXED, __HIP_MEMORY_SCOPE_AGENT)) < 96u) { __builtin_amdgcn_s_sleep(2); if (++sp > (1u << 22)) break; }
            __builtin_amdgcn_fence(__ATOMIC_ACQUIRE, "agent");
            asm volatile("s_waitcnt vmcnt(0)" ::: "memory"); }
        __syncthreads();
    }
    if (IN(1)) REP(1) pass_h_fold(p.x, p.g_mix, mod, (bf16_t*)(ws + WS_H), (bf16_t*)(ws + WS_HE), (bf16_t*)(ws + WS_HO));
    SEAM(1);
    if (IN(2)) { SchedP2 S{(const char*)(ws + WS_H), (const char*)(ws + WS_HE), (const char*)(ws + WS_HO), (const char*)(ws + WS_WQK), (const char*)(ws + WS_WA), (char*)(ws + WS_QK), (char*)(ws + WS_VT), (char*)(ws + WS_VTA), (float*)(ws + WS_SSQ2 + 512 * 1024), G, cid};
        pg8::EpiTileBf16 E; pg8::gemm_phase(lds, DM, S, E);
        late_work(p, lds, cid, G, 4); }
    SEAM(2);
    if (IN(3)) { pass_xmid((const bf16_t*)(ws + WS_H), (const bf16_t*)(ws + WS_WA), (float*)(ws + WS_SSQ2 + 256 * 1024));
        SchedFourier S{(const char*)(ws + WS_CS), (const char*)(ws + WS_VT), (char*)(ws + WS_PQ), G, cid};
        pg8::EpiTileBf16 E; pg8::gemm_phase(lds, 1024, S, E);
        if (G == 256) { if (cid >= 128) late_work(p, lds, cid - 128, 128, 3); } else late_work(p, lds, cid, G, 3);
        attn_phase(p, lds); }
    SEAM(3);
    if (IN(4)) REP(4) pass_combine((const bf16_t*)(ws + WS_PQ), (const float*)(ws + WS_SSQ2 + 512 * 1024), (const float*)(ws + WS_SSQ2 + 256 * 1024), (const float*)(ws + WS_SSQ1 + 512 * 1024), (bf16_t*)(ws + WS_YCAT));
    const bool fuse = (G == 256);
#define GSEAM(k, k2) do { if (IN(k) && IN(k2)) { if (fuse) xcd_barrier(gbar); else xcd_barrier(bar); } } while (0)
    GSEAM(4, 5);
    if (IN(5)) { SchedPlain S{(const char*)(ws + WS_YCAT), (const char*)(ws + WS_WOUT), 64, 4, DM, G, cid};
        if (fuse) { pg8::EpiResidNormMod E{p.x, (bf16_t*)(ws + WS_X1B), mod, 2 * DM, 3 * DM, 4 * DM, p.g_ffn, (bf16_t*)(ws + WS_H), pg8::PanelSsq{(float*)(ws + WS_SSQ1), (unsigned*)(ws + WS_BAR + 16384)}}; pg8::gemm_phase(lds, DM, S, E); }
        else { pg8::EpiResid E{p.x, p.out, mod + 2 * DM, (float*)(ws + WS_SSQ1)}; pg8::gemm_phase(lds, DM, S, E); } }
    if (!fuse) SEAM(5);
    if (IN(6) && !fuse) pass_norm_mod(p.out, (const float*)(ws + WS_SSQ1), p.g_ffn, mod, 3 * DM, 4 * DM, (bf16_t*)(ws + WS_H));
    if (fuse) GSEAM(5, 7); else SEAM(6);
    if (IN(7)) REP(7) { SchedPlain S{(const char*)(ws + WS_H), (const char*)(ws + WS_WUP), 64, 22, DM, G, cid};
        pg8::EpiUp E{(bf16_t*)(ws + WS_A), (bf16_t*)(ws + WS_SIDE), p.conv_w, p.conv_b}; pg8::gemm_phase(lds, DM, S, E);
        }
    GSEAM(7, 8);
    if (IN(8)) { if (fuse) pass_fixup((const bf16_t*)(ws + WS_SIDE), p.conv_w, p.conv_b, (bf16_t*)(ws + WS_A), 32 * (cid & 7), 32, cid >> 3, G >> 3);
        else pass_fixup((const bf16_t*)(ws + WS_SIDE), p.conv_w, p.conv_b, (bf16_t*)(ws + WS_A), 0, 256, cid, G); }
    GSEAM(8, 9);
    if (REPEAT_MASK & (1 << 20)) { for (int e_ = 0; e_ < 8; ++e_) xcd_barrier(bar); }
    if (IN(9)) { SchedPlain S{(const char*)(ws + WS_A), (const char*)(ws + WS_WDN), 64, 4, DFF, G, cid};
        if (fuse) { pg8::EpiResidNormOut E{(const bf16_t*)(ws + WS_X1B), p.out, mod, 5 * DM, p.g_final, pg8::PanelSsq{(float*)(ws + WS_SSQ2), (unsigned*)(ws + WS_BAR + 32768)}}; pg8::gemm_phase(lds, DFF, S, E); }
        else { pg8::EpiResid E{p.out, p.out, mod + 5 * DM, (float*)(ws + WS_SSQ2)}; pg8::gemm_phase(lds, DFF, S, E); } }
    if (!fuse) SEAM(9);
    if (IN(10) && !fuse) pass_final(p.out, (const float*)(ws + WS_SSQ2), p.g_final);
#undef IN
#undef SEAM
#undef GSEAM
}

extern "C" void kernel_launch(void* const* d_in, const int* in_sizes, int n_in, void* d_out, int out_size, void* d_ws, size_t ws_size, hipStream_t stream) {
    static int grid = 0;
    if (grid == 0) {
        int dev = 0, cus = 0, per_cu = 0;
        if (n_in != 17 || ws_size < WS_END) { fprintf(stderr, "kernel_launch: unexpected inputs (n_in %d, ws %zu)\n", n_in, ws_size); grid = -1; return; }
        hipGetDevice(&dev);
        hipDeviceGetAttribute(&cus, hipDeviceAttributeMultiprocessorCount, dev);
        if (hipFuncSetAttribute((const void*)fwd_megakernel, hipFuncAttributeMaxDynamicSharedMemorySize, LDS_BYTES) != hipSuccess) { fprintf(stderr, "kernel_launch: hipFuncSetAttribute failed\n"); grid = -1; return; }
        hipOccupancyMaxActiveBlocksPerMultiprocessor(&per_cu, (const void*)fwd_megakernel, NTHREADS, LDS_BYTES);
        if (per_cu < 1) { fprintf(stderr, "kernel_launch: occupancy query says %d blocks per CU\n", per_cu); per_cu = 1; }
        (void)hipGetLastError();
        grid = cus;
    }
    if (grid < 0) return;
    Params p{};
    const float** f = (const float**)&p;
    for (int i = 0; i < 17; ++i) f[i] = (const float*)d_in[i];
    p.out = (float*)d_out; p.ws = (unsigned char*)d_ws;
    hipMemsetAsync((char*)d_ws + WS_BAR, 0, 196608, stream);
#if MK_PER_PHASE
    for (int ph = 0; ph < N_PHASES; ++ph) { p.ph_lo = ph; p.ph_hi = ph + 1; hipLaunchKernelGGL(fwd_megakernel, dim3(grid), dim3(NTHREADS), LDS_BYTES, stream, p); }
#else
    p.ph_lo = 0; p.ph_hi = N_PHASES;
    void* args[] = {&p};
    hipError_t e = hipLaunchCooperativeKernel((const void*)fwd_megakernel, dim3(grid), dim3(NTHREADS), args, LDS_BYTES, stream);
    if (e != hipSuccess) fprintf(stderr, "cooperative launch failed: %s (grid %d)\n", hipGetErrorString(e), grid);
#endif
}
```
